# Optimizing an MI355X kernel written in HIP

```python
import jax
import jax.numpy as jnp
from jax import lax
import numpy as np

D_MODEL = 1024
BATCH = 16
SEQ = 2048
DEPTH = 2

GRID_W = 64
CTX_LEN = 256
HEAD_DIM = 64
GLA_HEADS = 4
GLA_DK = 32
GLA_DV = 64
GLA_QK = GLA_HEADS * GLA_DK
GLA_V = GLA_HEADS * GLA_DV
GLA_GATE_RANK = 16
GLA_GATE_TAU = 16.0
GLA_CHUNK = 64
GMLP_GROUPS = 4
GMLP_GDIM = 64
GMLP_WIDTH = GMLP_GROUPS * GMLP_GDIM
GMLP_CHUNK = 128
SWA_HEADS = 8
SWA_KV_HEADS = 2
SWA_REP = SWA_HEADS // SWA_KV_HEADS
SWA_Q = SWA_HEADS * HEAD_DIM
SWA_KV = SWA_KV_HEADS * HEAD_DIM
SWA_WINDOW = 128
ROPE_AXIS_DIM = HEAD_DIM // 2
ROPE_THETA = 10000.0
MIX_WIDTH = GLA_V + GMLP_WIDTH + SWA_Q
IN_SPLITS = (GLA_QK, GLA_QK, GLA_V, GLA_V, 2 * GLA_GATE_RANK, 2 * GMLP_WIDTH, SWA_Q, SWA_KV, SWA_KV)
IN_COLS = 2 * GLA_QK + 2 * GLA_V + 2 * GLA_GATE_RANK + 2 * GMLP_WIDTH + SWA_Q + 2 * SWA_KV
D_FF = -(-8 * D_MODEL // (3 * 256)) * 256

kernel_name = 'hybrid_dit_gla_gmlp_swa'


def rmsnorm(x, g, eps=1e-6):
    xf = x.astype(jnp.float32)
    y = xf * lax.rsqrt(jnp.mean(xf * xf, axis=-1, keepdims=True) + eps)
    return (y * g.astype(jnp.float32)).astype(x.dtype)


def layernorm(x, g, b, eps=1e-5):
    xf = x.astype(jnp.float32)
    mu = jnp.mean(xf, axis=-1, keepdims=True)
    xc = xf - mu
    y = xc * lax.rsqrt(jnp.mean(xc * xc, axis=-1, keepdims=True) + eps)
    return y * g.astype(jnp.float32) + b.astype(jnp.float32)


def modulate(h, shift, scale):
    return h * (1.0 + scale) + shift


def split_cols(z):
    offsets = np.cumsum(np.array(IN_SPLITS))[:-1].tolist()
    return jnp.split(z, offsets, axis=-1)


def rope_axis(x, ang):
    half = x.shape[-1] // 2
    cos = jnp.cos(ang)[:, None, :]
    sin = jnp.sin(ang)[:, None, :]
    x1, x2 = x[..., :half], x[..., half:]
    return jnp.concatenate([x1 * cos - x2 * sin, x2 * cos + x1 * sin], axis=-1)


def rope_2d(x, ang_row, ang_col):
    return jnp.concatenate([rope_axis(x[..., :ROPE_AXIS_DIM], ang_row),
                            rope_axis(x[..., ROPE_AXIS_DIM:], ang_col)], axis=-1)


def gla_heads(a, d):
    b, t = a.shape[:2]
    return a.astype(jnp.float32).reshape(b, t, GLA_HEADS, d).transpose(0, 2, 1, 3)


def gla_log_gates(code, wa2, ba):
    z = code @ wa2.astype(jnp.float32) + ba.astype(jnp.float32)
    return gla_heads(jax.nn.log_sigmoid(z) / GLA_GATE_TAU, GLA_DK)


def gla_chunk_scan(q, k, v, logg, s0):
    b, h, t, _ = q.shape
    n = t // GLA_CHUNK

    def chunks(a):
        return a.reshape(b, h, n, GLA_CHUNK, a.shape[-1]).transpose(2, 0, 1, 3, 4)

    causal = jnp.tril(jnp.ones((GLA_CHUNK, GLA_CHUNK), dtype=bool))[:, :, None]

    def step(s, inp):
        qc, kc, vc, gc = inp
        cum = jnp.cumsum(gc, axis=2)
        diff = cum[:, :, :, None, :] - cum[:, :, None, :, :]
        decay = jnp.exp(jnp.where(causal, diff, -jnp.inf))
        att = jnp.einsum('bhtd,bhsd,bhtsd->bhts', qc, kc, decay)
        o = att @ vc + jnp.einsum('bhtd,bhde->bhte', qc * jnp.exp(cum), s)
        cum_end = cum[:, :, -1:, :]
        s = jnp.exp(cum_end[:, :, 0, :])[..., None] * s + jnp.einsum(
            'bhsd,bhse->bhde', kc * jnp.exp(cum_end - cum), vc)
        return s, o

    s, o = lax.scan(step, s0, (chunks(q), chunks(k), chunks(v), chunks(logg)))
    return o.transpose(1, 2, 0, 3, 4).reshape(b, h, t, v.shape[-1]), s


def gla_mixer(zl, zc, wa2, ba, norm_g, need_ctx):
    def prep(q, k, v, code):
        cf, cb = jnp.split(code.astype(jnp.float32), 2, axis=-1)
        return (gla_heads(q, GLA_DK) * GLA_DK ** -0.5, gla_heads(k, GLA_DK), gla_heads(v, GLA_DV),
                gla_log_gates(cf, wa2[0], ba[0]), gla_log_gates(cb, wa2[1], ba[1]))

    lq, lk, lv, lgf, lgb = prep(zl[0], zl[1], zl[2], zl[4])
    cq, ck, cv, cgf, cgb = prep(zc[0], zc[1], zc[2], zc[4])
    s0 = jnp.zeros((lq.shape[0], GLA_HEADS, GLA_DK, GLA_DV), jnp.float32)
    flip = lambda a: a[:, :, ::-1]
    oc_f, s_f = gla_chunk_scan(cq, ck, cv, cgf, s0)
    oc_b, s_b = gla_chunk_scan(flip(cq), flip(ck), flip(cv), flip(cgb), s0)
    ol_f, _ = gla_chunk_scan(lq, lk, lv, lgf, s_f)
    ol_b, _ = gla_chunk_scan(flip(lq), flip(lk), flip(lv), flip(lgb), s_b)

    def finish(o, g):
        bb, _, t, _ = o.shape
        o = rmsnorm(o.transpose(0, 2, 1, 3), norm_g)
        g = g.astype(jnp.float32).reshape(bb, t, GLA_HEADS, GLA_DV)
        return (o * jax.nn.silu(g)).reshape(bb, t, GLA_V)

    y_lat = finish(ol_f + flip(ol_b), zl[3])
    y_ctx = finish(oc_f + flip(oc_b), zc[3]) if need_ctx else None
    return y_lat, y_ctx


def gmlp_mixer(z, ln_g, ln_b, ws, bs):
    zf = jax.nn.gelu(z.astype(jnp.float32), approximate=False)
    u, v = jnp.split(zf, 2, axis=-1)
    v = layernorm(v, ln_g, ln_b)
    b, t, _ = v.shape
    vb = v.reshape(b, t // GMLP_CHUNK, GMLP_CHUNK, GMLP_GROUPS, GMLP_GDIM)
    mixed = jnp.einsum('gpq,bnqgc->bnpgc', ws.astype(jnp.float32), vb) + bs.astype(jnp.float32).T[:, :, None]
    return u * mixed.reshape(b, t, GMLP_WIDTH)


def band_blocks(a):
    b, t = a.shape[:2]
    w = SWA_WINDOW
    ap = jnp.pad(a, ((0, 0), (w, w), (0, 0), (0, 0)))
    blk = ap.reshape(b, t // w + 2, w, *a.shape[2:])
    return jnp.concatenate([blk[:, :-2], blk[:, 1:-1], blk[:, 2:]], axis=2)


def swa_mixer(zl, zc, ang_row, ang_col, sink, need_ctx):
    f32 = jnp.float32
    w = SWA_WINDOW
    scale = HEAD_DIM ** -0.5
    q_l, k_l, v_l = [a.astype(f32) for a in zl]
    b, t = q_l.shape[:2]
    nb = t // w
    q_l = rope_2d(q_l.reshape(b, t, SWA_HEADS, HEAD_DIM), ang_row, ang_col) * scale
    k_l = rope_2d(k_l.reshape(b, t, SWA_KV_HEADS, HEAD_DIM), ang_row, ang_col)
    v_l = v_l.reshape(b, t, SWA_KV_HEADS, HEAD_DIM)
    n_ctx = zc[0].shape[1]
    k_c = zc[1].astype(f32).reshape(b, n_ctx, SWA_KV_HEADS, HEAD_DIM)
    v_c = zc[2].astype(f32).reshape(b, n_ctx, SWA_KV_HEADS, HEAD_DIM)
    sink = sink.astype(f32).reshape(SWA_KV_HEADS, SWA_REP)

    qb = q_l.reshape(b, nb, w, SWA_KV_HEADS, SWA_REP, HEAD_DIM)
    kb, vb = band_blocks(k_l), band_blocks(v_l)
    blk = jnp.arange(nb)[:, None, None]
    t_pos = blk * w + jnp.arange(w)[None, :, None]
    s_pos = blk * w + jnp.arange(3 * w)[None, None, :] - w
    valid = (s_pos >= 0) & (s_pos < t) & (jnp.abs(t_pos - s_pos) <= w)
    s_loc = jnp.where(valid[None, :, None, None], jnp.einsum('bnqgrd,bnkgd->bngrqk', qb, kb), -jnp.inf)
    s_ctx = jnp.einsum('bnqgrd,bkgd->bngrqk', qb, k_c)
    sink_l = sink[None, None, :, :, None, None]
    m = jnp.maximum(jnp.maximum(s_loc.max(-1, keepdims=True), s_ctx.max(-1, keepdims=True)), sink_l)
    p_loc = jnp.exp(s_loc - m)
    p_ctx = jnp.exp(s_ctx - m)
    inv = 1.0 / (p_loc.sum(-1, keepdims=True) + p_ctx.sum(-1, keepdims=True) + jnp.exp(sink_l - m))
    o = (jnp.einsum('bngrqk,bnkgd->bnqgrd', p_loc * inv, vb)
         + jnp.einsum('bngrqk,bkgd->bnqgrd', p_ctx * inv, v_c))
    y_lat = o.reshape(b, t, SWA_Q)
    if not need_ctx:
        return y_lat, None
    q_c = zc[0].astype(f32).reshape(b, n_ctx, SWA_KV_HEADS, SWA_REP, HEAD_DIM) * scale
    s = jnp.einsum('bqgrd,bkgd->bgrqk', q_c, k_c)
    sink_c = sink[None, :, :, None, None]
    mc = jnp.maximum(s.max(-1, keepdims=True), sink_c)
    p = jnp.exp(s - mc)
    p = p / (p.sum(-1, keepdims=True) + jnp.exp(sink_c - mc))
    y_ctx = jnp.einsum('bgrqk,bkgd->bqgrd', p, v_c).reshape(b, n_ctx, SWA_Q)
    return y_lat, y_ctx


def hybrid_mixer(h_lat, h_ctx, ang_row, ang_col, w_in, w_out, gla_wa2, gla_ba, gla_norm,
                 gmlp_ln_g, gmlp_ln_b, gmlp_ws, gmlp_bs, gmlp_out_g, swa_sink, swa_out_g, need_ctx):
    zl = split_cols(h_lat @ w_in)
    zc = split_cols(h_ctx @ w_in)
    a_lat, a_ctx = gla_mixer(zl[0:5], zc[0:5], gla_wa2, gla_ba, gla_norm, need_ctx)
    c_lat, c_ctx = swa_mixer(zl[6:9], zc[6:9], ang_row, ang_col, swa_sink, need_ctx)

    def merge(a_out, z_gm, c_out, dtype):
        b_out = rmsnorm(gmlp_mixer(z_gm, gmlp_ln_g, gmlp_ln_b, gmlp_ws, gmlp_bs), gmlp_out_g)
        cat = jnp.concatenate([a_out, b_out, rmsnorm(c_out, swa_out_g)], axis=-1)
        return cat.astype(dtype) @ w_out

    y_lat = merge(a_lat, zl[5], c_lat, h_lat.dtype)
    y_ctx = merge(a_ctx, zc[5], c_ctx, h_ctx.dtype) if need_ctx else None
    return y_lat, y_ctx


def swiglu(h, w_gu, w_down):
    g, u = jnp.split(h @ w_gu, 2, axis=-1)
    return (jax.nn.silu(g) * u) @ w_down


def setup_inputs(seed: int = 0) -> dict:
    key = jax.random.key(seed)
    ks = jax.random.split(key, 32)
    f32 = jnp.float32

    def nrm(k, shape, scale):
        return jax.random.normal(k, shape, f32) * scale

    def gain(k, shape):
        return 1.0 + 0.05 * jax.random.normal(k, shape, f32)

    d = D_MODEL
    return {
        'x': nrm(ks[0], (BATCH, SEQ, d), 1.0),
        'c': nrm(ks[1], (BATCH, d), 1.0),
        'ctx': nrm(ks[2], (BATCH, CTX_LEN, d), 1.0),
        'c_ctx': nrm(ks[3], (d,), 1.0),
        'mod_w': nrm(ks[4], (DEPTH, d, 6 * d), 0.5 * d ** -0.5),
        'mod_b': nrm(ks[5], (DEPTH, 6 * d), 0.01),
        'n1_pre': gain(ks[6], (DEPTH, d)),
        'n1_post': gain(ks[7], (DEPTH, d)),
        'n2_pre': gain(ks[8], (DEPTH, d)),
        'n2_post': gain(ks[9], (DEPTH, d)),
        'w_in': nrm(ks[10], (DEPTH, d, IN_COLS), d ** -0.5),
        'w_out': nrm(ks[11], (DEPTH, MIX_WIDTH, d), MIX_WIDTH ** -0.5),
        'gla_wa2': nrm(ks[12], (DEPTH, 2, GLA_GATE_RANK, GLA_QK), GLA_GATE_RANK ** -0.5),
        'gla_ba': nrm(ks[13], (DEPTH, 2, GLA_QK), 0.1),
        'gla_norm': gain(ks[14], (DEPTH, GLA_DV)),
        'gmlp_ln_g': gain(ks[15], (DEPTH, GMLP_WIDTH)),
        'gmlp_ln_b': nrm(ks[16], (DEPTH, GMLP_WIDTH), 0.02),
        'gmlp_ws': nrm(ks[17], (DEPTH, GMLP_GROUPS, GMLP_CHUNK, GMLP_CHUNK), GMLP_CHUNK ** -0.5),
        'gmlp_bs': 1.0 + nrm(ks[18], (DEPTH, GMLP_GROUPS, GMLP_CHUNK), 0.02),
        'gmlp_out_g': gain(ks[19], (DEPTH, GMLP_WIDTH)),
        'swa_sink': nrm(ks[20], (DEPTH, SWA_HEADS), 0.5),
        'swa_out_g': gain(ks[21], (DEPTH, SWA_Q)),
        'ffn_w_gu': nrm(ks[22], (DEPTH, d, 2 * D_FF), d ** -0.5),
        'ffn_w_down': nrm(ks[23], (DEPTH, D_FF, d), D_FF ** -0.5),
    }


def reference(x, c, ctx, c_ctx, mod_w, mod_b, n1_pre, n1_post, n2_pre, n2_post, w_in, w_out,
              gla_wa2, gla_ba, gla_norm, gmlp_ln_g, gmlp_ln_b, gmlp_ws, gmlp_bs, gmlp_out_g,
              swa_sink, swa_out_g, ffn_w_gu, ffn_w_down):
    n_lat = x.shape[1]
    rows = n_lat // GRID_W
    row = jnp.repeat(jnp.arange(rows), GRID_W).astype(jnp.float32)
    col = jnp.tile(jnp.arange(GRID_W), rows).astype(jnp.float32)
    inv_freq = jnp.power(ROPE_THETA, -jnp.arange(0, ROPE_AXIS_DIM, 2, dtype=jnp.float32) / ROPE_AXIS_DIM)
    ang_row = row[:, None] * inv_freq[None, :]
    ang_col = col[:, None] * inv_freq[None, :]

    x_lat, x_ctx = x, ctx
    for l in range(DEPTH):
        need_ctx = l < DEPTH - 1
        mod_l = [m[:, None, :] for m in jnp.split(jax.nn.silu(c) @ mod_w[l] + mod_b[l], 6, axis=-1)]
        mod_c = jnp.split(jax.nn.silu(c_ctx) @ mod_w[l] + mod_b[l], 6, axis=-1)

        h_lat = modulate(rmsnorm(x_lat, n1_pre[l]), mod_l[0], mod_l[1])
        h_ctx = modulate(rmsnorm(x_ctx, n1_pre[l]), mod_c[0], mod_c[1])
        y_lat, y_ctx = hybrid_mixer(h_lat, h_ctx, ang_row, ang_col, w_in[l], w_out[l],
                                    gla_wa2[l], gla_ba[l], gla_norm[l], gmlp_ln_g[l], gmlp_ln_b[l],
                                    gmlp_ws[l], gmlp_bs[l], gmlp_out_g[l], swa_sink[l], swa_out_g[l],
                                    need_ctx)
        x_lat = x_lat + mod_l[2] * rmsnorm(y_lat, n1_post[l])

        f_lat = swiglu(modulate(rmsnorm(x_lat, n2_pre[l]), mod_l[3], mod_l[4]), ffn_w_gu[l], ffn_w_down[l])
        x_lat = x_lat + mod_l[5] * rmsnorm(f_lat, n2_post[l])

        if need_ctx:
            x_ctx = x_ctx + mod_c[2] * rmsnorm(y_ctx, n1_post[l])
            f_ctx = swiglu(modulate(rmsnorm(x_ctx, n2_pre[l]), mod_c[3], mod_c[4]), ffn_w_gu[l], ffn_w_down[l])
            x_ctx = x_ctx + mod_c[5] * rmsnorm(f_ctx, n2_post[l])
    return x_lat
```

```cpp
#include <hip/hip_runtime.h>
#include <hip/hip_cooperative_groups.h>
#include <cstdio>
namespace cg = cooperative_groups;

#ifndef MK_ONE_LAUNCH
#define MK_ONE_LAUNCH 0
#endif

#define DI __device__ __forceinline__
typedef unsigned short u16;
using bf16x8 = __attribute__((ext_vector_type(8))) short;
using f32x4 = __attribute__((ext_vector_type(4))) float;
#define MFMA16(a, b, c) __builtin_amdgcn_mfma_f32_16x16x32_bf16((a), (b), (c), 0, 0, 0)

constexpr int NT = 256;
constexpr int DM = 1024;
constexpr int NB = 16;
constexpr int TL = 2048;
constexpr int TC = 256;
constexpr int M_LAT = NB * TL;
constexpr int M_CTX = NB * TC;
constexpr int M_ALL = M_LAT + M_CTX;
constexpr int ZW = 2304;
constexpr int IN_COLS = 2080;
constexpr int DFF = 2816;
constexpr int ZQ = 0, ZK = 128, ZV = 256, ZOG = 512, ZGU = 768, ZGV = 1024, ZSQ = 1280, ZSK = 1792, ZSV = 1920, ZGF = 2048, ZGB = 2176;
constexpr int NSLOT = 36;
constexpr int SMEM_BYTES = 73728;

struct Params {
  const float *x, *c, *ctx, *c_ctx, *mod_w, *mod_b, *n1_pre, *n1_post, *n2_pre, *n2_post, *w_in, *w_out,
      *gla_wa2, *gla_ba, *gla_norm, *gmlp_ln_g, *gmlp_ln_b, *gmlp_ws, *gmlp_bs, *gmlp_out_g, *swa_sink, *swa_out_g,
      *ffn_w_gu, *ffn_w_down;
  float* out;
  u16 *WinT, *WoutT, *WguT, *WdT;
  float *mod, *rope;
  u16 *h, *z, *cat, *y, *act;
  float *xc, *L, *Dd;
};

DI u16 f2bf(float f) { unsigned u = __float_as_uint(f); u += 0x7fffu + ((u >> 16) & 1u); return (u16)(u >> 16); }
DI float bf2f(u16 h) { return __uint_as_float(((unsigned)h) << 16); }
DI unsigned pack2(float a, float b) { return (unsigned)f2bf(a) | ((unsigned)f2bf(b) << 16); }
DI float wave_sum(float v) {
#pragma unroll
  for (int o = 32; o >= 1; o >>= 1) v += __shfl_xor(v, o);
  return v;
}
DI float silu_f(float x) { return x / (1.f + __expf(-x)); }
DI float gelu_f(float x) { return 0.5f * x * (1.f + erff(x * 0.70710678118654752f)); }
DI float logsigmoid_f(float z) { return fminf(z, 0.f) - log1pf(__expf(-fabsf(z))); }
DI void unpack8(const uint4& v, float* f) {
  f[0] = __uint_as_float(v.x << 16); f[1] = __uint_as_float(v.x & 0xffff0000u);
  f[2] = __uint_as_float(v.y << 16); f[3] = __uint_as_float(v.y & 0xffff0000u);
  f[4] = __uint_as_float(v.z << 16); f[5] = __uint_as_float(v.z & 0xffff0000u);
  f[6] = __uint_as_float(v.w << 16); f[7] = __uint_as_float(v.w & 0xffff0000u);
}

DI int colmap_win(int n) { return n < 768 ? n : n + 32; }
DI int colmap_gu(int n) { int blk = n >> 4, w = n & 15; return (blk >> 1) * 16 + w + ((blk & 1) ? DFF : 0); }

template <int CM>
DI void transpose_tile(const float* __restrict__ src, int ld_src, int k0, int n0, u16* __restrict__ dst, int K, float* tile) {
  const int tid = threadIdx.x;
  {
    const int j = tid & 63, i0 = tid >> 6;
    const int n = n0 + j;
    const int col = CM == 1 ? colmap_win(n) : (CM == 2 ? colmap_gu(n) : n);
#pragma unroll
    for (int ii = 0; ii < 16; ++ii) {
      const int k = i0 + 4 * ii;
      tile[k * 65 + j] = src[(size_t)(k0 + k) * ld_src + col];
    }
  }
  __syncthreads();
  {
    const int kk = tid & 63, nn0 = tid >> 6;
#pragma unroll
    for (int ii = 0; ii < 16; ++ii) {
      const int n = nn0 + 4 * ii;
      dst[(size_t)(n0 + n) * K + k0 + kk] = f2bf(tile[kk * 65 + n]);
    }
  }
  __syncthreads();
}

DI void phase_prep(const Params& p, char* smem) {
  float* sf = (float*)smem;
  const int tid = threadIdx.x, lane = tid & 63, wave = tid >> 6;
  constexpr int N_TR_L = 512 + 256 + 1408 + 704;
  constexpr int N_TR = 2 * N_TR_L;
  constexpr int N_FOLD = 64, N_MOD = 192, N_ROPE = 256;
  constexpr int N_ALL = N_TR + N_FOLD + N_MOD + N_ROPE;
  for (int item = blockIdx.x; item < N_ALL; item += gridDim.x) {
    if (item < N_TR) {
      const int l = item / N_TR_L;
      int r = item - l * N_TR_L;
      if (r < 512) {
        transpose_tile<1>(p.w_in + (size_t)l * DM * IN_COLS, IN_COLS, (r >> 5) * 64, (r & 31) * 64, p.WinT + (size_t)l * ZW * DM, DM, sf);
      } else if (r < 768) {
        r -= 512;
        transpose_tile<0>(p.w_out + (size_t)l * DM * DM, DM, (r >> 4) * 64, (r & 15) * 64, p.WoutT + (size_t)l * DM * DM, DM, sf);
      } else if (r < 2176) {
        r -= 768;
        transpose_tile<2>(p.ffn_w_gu + (size_t)l * DM * 2 * DFF, 2 * DFF, (r / 88) * 64, (r % 88) * 64, p.WguT + (size_t)l * 2 * DFF * DM, DM, sf);
      } else {
        r -= 2176;
        transpose_tile<0>(p.ffn_w_down + (size_t)l * DFF * DM, DM, (r >> 4) * 64, (r & 15) * 64, p.WdT + (size_t)l * DM * DFF, DFF, sf);
      }
    } else if (item < N_TR + N_FOLD) {
      const int idx = item - N_TR;
      const int l = idx >> 5, dir = (idx >> 4) & 1, k0 = (idx & 15) * 64;
      float* wa = sf;
      float* cd = sf + 2048;
      const float* wa2 = p.gla_wa2 + (size_t)(l * 2 + dir) * 16 * 128;
      for (int i = tid; i < 2048; i += NT) wa[i] = wa2[i];
      for (int i = tid; i < 1024; i += NT) {
        const int kk = i >> 4, r = i & 15;
        cd[kk * 17 + r] = p.w_in[(size_t)l * DM * IN_COLS + (size_t)(k0 + kk) * IN_COLS + 768 + dir * 16 + r];
      }
      __syncthreads();
      const int kk = tid & 63, jg = tid >> 6;
      u16* dst = p.WinT + (size_t)l * ZW * DM;
      for (int jj = 0; jj < 32; ++jj) {
        const int j = jg * 32 + jj;
        float s = 0.f;
#pragma unroll
        for (int r = 0; r < 16; ++r) s += cd[kk * 17 + r] * wa[r * 128 + j];
        dst[(size_t)(ZGF + dir * 128 + j) * DM + k0 + kk] = f2bf(s);
      }
      __syncthreads();
    } else if (item < N_TR + N_FOLD + N_MOD) {
      const int cgi = item - N_TR - N_FOLD;
      const int gc = cgi * 64 + lane;
      const int l = gc / 6144, n = gc - l * 6144;
      for (int i = tid; i < 17 * 1024; i += NT) {
        const float v = i < 16 * 1024 ? p.c[i] : p.c_ctx[i - 16 * 1024];
        sf[i] = silu_f(v);
      }
      __syncthreads();
      float acc[17];
#pragma unroll
      for (int r = 0; r < 17; ++r) acc[r] = 0.f;
      const float* W = p.mod_w + (size_t)l * DM * 6144 + n;
      const int kb = wave * 256;
#pragma unroll 4
      for (int k = kb; k < kb + 256; ++k) {
        const float wv = W[(size_t)k * 6144];
#pragma unroll
        for (int r = 0; r < 17; ++r) acc[r] += sf[r * 1024 + k] * wv;
      }
      __syncthreads();
#pragma unroll
      for (int r = 0; r < 17; ++r) sf[(wave * 17 + r) * 64 + lane] = acc[r];
      __syncthreads();
      for (int o = tid; o < 17 * 64; o += NT) {
        const int r = o >> 6, ln = o & 63;
        const float s = sf[(0 * 17 + r) * 64 + ln] + sf[(1 * 17 + r) * 64 + ln] + sf[(2 * 17 + r) * 64 + ln] + sf[(3 * 17 + r) * 64 + ln];
        const int nn = cgi * 64 + ln - l * 6144;
        p.mod[(size_t)(l * 17 + r) * 6144 + nn] = s + p.mod_b[l * 6144 + nn];
      }
      __syncthreads();
    } else {
      const int idx = item - N_TR - N_FOLD - N_MOD;
      const int e = idx * 256 + tid;
      const int t = e >> 5, f = e & 31;
      const int fi = f & 15;
      const float inv = powf(10000.f, -(float)(2 * fi) / 32.f);
      const float pos = f < 16 ? (float)(t >> 6) : (float)(t & 63);
      const float ang = pos * inv;
      p.rope[e * 2 + 0] = cosf(ang);
      p.rope[e * 2 + 1] = sinf(ang);
    }
  }
}

DI void phase_rows(const Params& p, int mode, int Mrows, bool first_layer_input, int l_in, int gate_idx, const float* gpost,
                   bool write_h, int l_out, int sh_idx, const float* gpre) {
  const int tid = threadIdx.x, lane = tid & 63, wave = tid >> 6;
  for (int row = blockIdx.x * 4 + wave; row < Mrows; row += gridDim.x * 4) {
    const bool lat = row < M_LAT;
    const int mrow = lat ? (row >> 11) : 16;
    const float* xin;
    float* xout;
    if (lat) {
      xin = (first_layer_input ? p.x : p.out) + (size_t)row * DM;
      xout = p.out + (size_t)row * DM;
    } else {
      xin = (first_layer_input ? p.ctx : p.xc) + (size_t)(row - M_LAT) * DM;
      xout = p.xc + (size_t)(row - M_LAT) * DM;
    }
    float4 xv[4];
#pragma unroll
    for (int i = 0; i < 4; ++i) xv[i] = *(const float4*)(xin + lane * 4 + 256 * i);
    if (mode == 1) {
      const u16* yr = p.y + (size_t)row * DM;
      float4 yv[4];
      float ss = 0.f;
#pragma unroll
      for (int i = 0; i < 4; ++i) {
        const uint2 u = *(const uint2*)(yr + lane * 4 + 256 * i);
        yv[i].x = __uint_as_float(u.x << 16); yv[i].y = __uint_as_float(u.x & 0xffff0000u);
        yv[i].z = __uint_as_float(u.y << 16); yv[i].w = __uint_as_float(u.y & 0xffff0000u);
        ss += yv[i].x * yv[i].x + yv[i].y * yv[i].y + yv[i].z * yv[i].z + yv[i].w * yv[i].w;
      }
      ss = wave_sum(ss);
      const float rstd = rsqrtf(ss * (1.f / DM) + 1e-6f);
      const float* gate = p.mod + (size_t)(l_in * 17 + mrow) * 6144 + gate_idx * 1024;
#pragma unroll
      for (int i = 0; i < 4; ++i) {
        const int c0 = lane * 4 + 256 * i;
        const float4 g = *(const float4*)(gpost + c0);
        const float4 gt = *(const float4*)(gate + c0);
        xv[i].x += gt.x * (yv[i].x * rstd * g.x);
        xv[i].y += gt.y * (yv[i].y * rstd * g.y);
        xv[i].z += gt.z * (yv[i].z * rstd * g.z);
        xv[i].w += gt.w * (yv[i].w * rstd * g.w);
        *(float4*)(xout + c0) = xv[i];
      }
    }
    if (write_h) {
      float ss = 0.f;
#pragma unroll
      for (int i = 0; i < 4; ++i) ss += xv[i].x * xv[i].x + xv[i].y * xv[i].y + xv[i].z * xv[i].z + xv[i].w * xv[i].w;
      ss = wave_sum(ss);
      const float rstd = rsqrtf(ss * (1.f / DM) + 1e-6f);
      const float* sh = p.mod + (size_t)(l_out * 17 + mrow) * 6144 + sh_idx * 1024;
      const float* sc = sh + 1024;
      u16* hr = p.h + (size_t)row * DM;
#pragma unroll
      for (int i = 0; i < 4; ++i) {
        const int c0 = lane * 4 + 256 * i;
        const float4 g = *(const float4*)(gpre + c0);
        const float4 a = *(const float4*)(sh + c0);
        const float4 s = *(const float4*)(sc + c0);
        uint2 o;
        o.x = pack2(xv[i].x * rstd * g.x * (1.f + s.x) + a.x, xv[i].y * rstd * g.y * (1.f + s.y) + a.y);
        o.y = pack2(xv[i].z * rstd * g.z * (1.f + s.z) + a.z, xv[i].w * rstd * g.w * (1.f + s.w) + a.w);
        *(uint2*)(hr + c0) = o;
      }
    }
  }
}

template <int EPI>
DI void phase_gemm(const u16* __restrict__ A, const u16* __restrict__ Bt, int M, int N, int K, u16* __restrict__ C, int ldc, char* smem) {
  const int tid = threadIdx.x, lane = tid & 63, wave = tid >> 6;
  const int wm = wave >> 1, wn = wave & 1;
  const int l15 = lane & 15, lq = lane >> 4;
  constexpr int LDS_ROW = 72;
  u16* sA = (u16*)smem;
  u16* sB = sA + 2 * 128 * LDS_ROW;
  const int tiles_n = N >> 7;
  const int ntiles = (M >> 7) * tiles_n;
  const int nk = K >> 6;
  for (int tile = blockIdx.x; tile < ntiles; tile += gridDim.x) {
    const int tm = tile / tiles_n, tn = tile - tm * tiles_n;
    const u16* Ag = A + (size_t)(tm * 128) * K;
    const u16* Bg = Bt + (size_t)(tn * 128) * K;
    uint4 ra[4], rb[4];
#pragma unroll
    for (int i = 0; i < 4; ++i) {
      const int c = tid + 256 * i, r = c >> 3, kc = c & 7;
      ra[i] = *(const uint4*)(Ag + (size_t)r * K + kc * 8);
      rb[i] = *(const uint4*)(Bg + (size_t)r * K + kc * 8);
    }
#pragma unroll
    for (int i = 0; i < 4; ++i) {
      const int c = tid + 256 * i, r = c >> 3, kc = c & 7;
      *(uint4*)(sA + r * LDS_ROW + kc * 8) = ra[i];
      *(uint4*)(sB + r * LDS_ROW + kc * 8) = rb[i];
    }
    __syncthreads();
    f32x4 acc[4][4];
#pragma unroll
    for (int i = 0; i < 4; ++i)
#pragma unroll
      for (int j = 0; j < 4; ++j) acc[i][j] = f32x4{0.f, 0.f, 0.f, 0.f};
    for (int kt = 0; kt < nk; ++kt) {
      const bool more = kt + 1 < nk;
      if (more) {
        const int ko = (kt + 1) * 64;
#pragma unroll
        for (int i = 0; i < 4; ++i) {
          const int c = tid + 256 * i, r = c >> 3, kc = c & 7;
          ra[i] = *(const uint4*)(Ag + (size_t)r * K + ko + kc * 8);
          rb[i] = *(const uint4*)(Bg + (size_t)r * K + ko + kc * 8);
        }
      }
      const u16* a_s = sA + (kt & 1) * 128 * LDS_ROW + (wm * 64 + l15) * LDS_ROW + lq * 8;
      const u16* b_s = sB + (kt & 1) * 128 * LDS_ROW + (wn * 64 + l15) * LDS_ROW + lq * 8;
#pragma unroll
      for (int ks = 0; ks < 2; ++ks) {
        bf16x8 af[4], bfr[4];
#pragma unroll
        for (int i = 0; i < 4; ++i) af[i] = *(const bf16x8*)(a_s + i * 16 * LDS_ROW + ks * 32);
#pragma unroll
        for (int j = 0; j < 4; ++j) bfr[j] = *(const bf16x8*)(b_s + j * 16 * LDS_ROW + ks * 32);
#pragma unroll
        for (int i = 0; i < 4; ++i)
#pragma unroll
          for (int j = 0; j < 4; ++j) acc[i][j] = MFMA16(af[i], bfr[j], acc[i][j]);
      }
      if (more) {
        u16* dA = sA + ((kt + 1) & 1) * 128 * LDS_ROW;
        u16* dB = sB + ((kt + 1) & 1) * 128 * LDS_ROW;
#pragma unroll
        for (int i = 0; i < 4; ++i) {
          const int c = tid + 256 * i, r = c >> 3, kc = c & 7;
          *(uint4*)(dA + r * LDS_ROW + kc * 8) = ra[i];
          *(uint4*)(dB + r * LDS_ROW + kc * 8) = rb[i];
        }
      }
      __syncthreads();
    }
    const int row0 = tm * 128 + wm * 64 + lq * 4;
    if (EPI == 0) {
      const int col0 = tn * 128 + wn * 64 + l15;
#pragma unroll
      for (int i = 0; i < 4; ++i)
#pragma unroll
        for (int j = 0; j < 4; ++j)
#pragma unroll
          for (int r = 0; r < 4; ++r)
            C[(size_t)(row0 + i * 16 + r) * ldc + col0 + j * 16] = f2bf(acc[i][j][r]);
    } else {
      const int col0 = tn * 64 + wn * 32 + l15;
#pragma unroll
      for (int i = 0; i < 4; ++i)
#pragma unroll
        for (int jj = 0; jj < 2; ++jj)
#pragma unroll
          for (int r = 0; r < 4; ++r) {
            const float g = acc[i][2 * jj][r], u = acc[i][2 * jj + 1][r];
            C[(size_t)(row0 + i * 16 + r) * ldc + col0 + jj * 16] = f2bf(silu_f(g) * u);
          }
    }
  }
}

DI void swa_item(const Params& p, int layer, int item, bool ctxq, char* smem) {
  const int tid = threadIdx.x, lane = tid & 63, wave = tid >> 6;
  const int l15 = lane & 15, lq = lane >> 4;
  u16* Ks = (u16*)smem;
  u16* Vt = Ks + 128 * 72;
  u16* Ps = Vt + 64 * 136;
  u16* Pw = Ps + wave * 32 * 136;
  const int hq = item & 7;
  const int g = hq >> 2;
  int b, n;
  if (!ctxq) { n = (item >> 3) & 15; b = item >> 7; } else { n = (item >> 3) & 1; b = item >> 4; }
  const int qrow0 = (ctxq ? (M_LAT + b * TC + n * 128) : (b * TL + n * 128)) + wave * 32;
  const int ctxrow0 = M_LAT + b * TC;
  bf16x8 Q[2][2];
#pragma unroll
  for (int rt = 0; rt < 2; ++rt)
#pragma unroll
    for (int ks = 0; ks < 2; ++ks) {
      const int row = qrow0 + rt * 16 + l15;
      const int sub = lq * 8;
      const u16* zr = p.z + (size_t)row * ZW + ZSQ + hq * 64 + ks * 32;
      float own[8], par[8], o[8];
      unpack8(*(const uint4*)(zr + sub), own);
      if (!ctxq) {
        unpack8(*(const uint4*)(zr + (sub ^ 16)), par);
        const int t = n * 128 + wave * 32 + rt * 16 + l15;
        const float* rp = p.rope + ((size_t)t * 32 + ks * 16 + (sub & 8)) * 2;
#pragma unroll
        for (int e = 0; e < 8; ++e) {
          const float cs = rp[e * 2], sn = rp[e * 2 + 1];
          o[e] = (sub < 16) ? (own[e] * cs - par[e] * sn) : (own[e] * cs + par[e] * sn);
        }
      } else {
#pragma unroll
        for (int e = 0; e < 8; ++e) o[e] = own[e];
      }
      uint4 pk;
      pk.x = pack2(o[0] * 0.125f, o[1] * 0.125f); pk.y = pack2(o[2] * 0.125f, o[3] * 0.125f);
      pk.z = pack2(o[4] * 0.125f, o[5] * 0.125f); pk.w = pack2(o[6] * 0.125f, o[7] * 0.125f);
      Q[rt][ks] = __builtin_bit_cast(bf16x8, pk);
    }
  const float sink = p.swa_sink[layer * 8 + hq];
  float mrun[2][4], lrun[2][4];
  f32x4 O[2][4];
#pragma unroll
  for (int rt = 0; rt < 2; ++rt) {
#pragma unroll
    for (int j = 0; j < 4; ++j) { mrun[rt][j] = sink; lrun[rt][j] = 1.f; }
#pragma unroll
    for (int dt = 0; dt < 4; ++dt) O[rt][dt] = f32x4{0.f, 0.f, 0.f, 0.f};
  }
  for (int kt = (ctxq ? 3 : 0); kt < 5; ++kt) {
    int krow0; bool latk = kt < 3; int nk = 0;
    if (latk) {
      nk = n + kt - 1;
      if (nk < 0 || nk > 15) continue;
      krow0 = b * TL + nk * 128;
    } else {
      krow0 = ctxrow0 + (kt - 3) * 128;
    }
    __syncthreads();
#pragma unroll 1
    for (int i = 0; i < 4; ++i) {
      const int c = tid + 256 * i, j = c >> 3, ch = c & 7;
      const u16* zr = p.z + (size_t)(krow0 + j) * ZW;
      {
        const uint4 ownv = *(const uint4*)(zr + ZSK + g * 64 + ch * 8);
        uint4 outv = ownv;
        if (latk) {
          float own[8], par[8], o[8];
          unpack8(ownv, own);
          unpack8(*(const uint4*)(zr + ZSK + g * 64 + (ch ^ 2) * 8), par);
          const int t = nk * 128 + j;
          const float* rp = p.rope + ((size_t)t * 32 + (ch >> 2) * 16 + (ch & 1) * 8) * 2;
#pragma unroll
          for (int e = 0; e < 8; ++e) {
            const float cs = rp[e * 2], sn = rp[e * 2 + 1];
            o[e] = ((ch & 2) == 0) ? (own[e] * cs - par[e] * sn) : (own[e] * cs + par[e] * sn);
          }
          outv.x = pack2(o[0], o[1]); outv.y = pack2(o[2], o[3]); outv.z = pack2(o[4], o[5]); outv.w = pack2(o[6], o[7]);
        }
        *(uint4*)(Ks + j * 72 + ch * 8) = outv;
      }
      {
        const uint4 vv = *(const uint4*)(zr + ZSV + g * 64 + ch * 8);
        u16* vt = Vt + (ch * 8) * 136 + j;
        vt[0 * 136] = (u16)(vv.x & 0xffff); vt[1 * 136] = (u16)(vv.x >> 16);
        vt[2 * 136] = (u16)(vv.y & 0xffff); vt[3 * 136] = (u16)(vv.y >> 16);
        vt[4 * 136] = (u16)(vv.z & 0xffff); vt[5 * 136] = (u16)(vv.z >> 16);
        vt[6 * 136] = (u16)(vv.w & 0xffff); vt[7 * 136] = (u16)(vv.w >> 16);
      }
    }
    __syncthreads();
    f32x4 S[2][8];
#pragma unroll
    for (int ct = 0; ct < 8; ++ct) {
      const bf16x8 k0 = *(const bf16x8*)(Ks + (ct * 16 + l15) * 72 + lq * 8);
      const bf16x8 k1 = *(const bf16x8*)(Ks + (ct * 16 + l15) * 72 + 32 + lq * 8);
#pragma unroll
      for (int rt = 0; rt < 2; ++rt) {
        f32x4 s = f32x4{0.f, 0.f, 0.f, 0.f};
        s = MFMA16(Q[rt][0], k0, s);
        s = MFMA16(Q[rt][1], k1, s);
        S[rt][ct] = s;
      }
    }
    if (kt == 0 || kt == 2) {
#pragma unroll
      for (int rt = 0; rt < 2; ++rt)
#pragma unroll
        for (int ct = 0; ct < 8; ++ct)
#pragma unroll
          for (int j = 0; j < 4; ++j) {
            const int qi = wave * 32 + rt * 16 + lq * 4 + j;
            const int kj = ct * 16 + l15;
            const bool valid = (kt == 0) ? (kj >= qi) : (kj <= qi);
            if (!valid) S[rt][ct][j] = -1e30f;
          }
    }
#pragma unroll
    for (int rt = 0; rt < 2; ++rt)
#pragma unroll
      for (int j = 0; j < 4; ++j) {
        float mx = S[rt][0][j];
#pragma unroll
        for (int ct = 1; ct < 8; ++ct) mx = fmaxf(mx, S[rt][ct][j]);
        mx = fmaxf(mx, __shfl_xor(mx, 1)); mx = fmaxf(mx, __shfl_xor(mx, 2));
        mx = fmaxf(mx, __shfl_xor(mx, 4)); mx = fmaxf(mx, __shfl_xor(mx, 8));
        const float mnew = fmaxf(mrun[rt][j], mx);
        const float alpha = __expf(mrun[rt][j] - mnew);
        mrun[rt][j] = mnew;
        float rs = 0.f;
#pragma unroll
        for (int ct = 0; ct < 8; ++ct) {
          const float pv = __expf(S[rt][ct][j] - mnew);
          S[rt][ct][j] = pv;
          rs += pv;
        }
        rs += __shfl_xor(rs, 1); rs += __shfl_xor(rs, 2); rs += __shfl_xor(rs, 4); rs += __shfl_xor(rs, 8);
        lrun[rt][j] = lrun[rt][j] * alpha + rs;
#pragma unroll
        for (int dt = 0; dt < 4; ++dt) O[rt][dt][j] *= alpha;
#pragma unroll
        for (int ct = 0; ct < 8; ++ct) Pw[(rt * 16 + lq * 4 + j) * 136 + ct * 16 + l15] = f2bf(S[rt][ct][j]);
      }
    __syncthreads();
#pragma unroll
    for (int kk = 0; kk < 4; ++kk) {
      bf16x8 pf[2], vf[4];
#pragma unroll
      for (int rt = 0; rt < 2; ++rt) pf[rt] = *(const bf16x8*)(Pw + (rt * 16 + l15) * 136 + kk * 32 + lq * 8);
#pragma unroll
      for (int dt = 0; dt < 4; ++dt) vf[dt] = *(const bf16x8*)(Vt + (dt * 16 + l15) * 136 + kk * 32 + lq * 8);
#pragma unroll
      for (int rt = 0; rt < 2; ++rt)
#pragma unroll
        for (int dt = 0; dt < 4; ++dt) O[rt][dt] = MFMA16(pf[rt], vf[dt], O[rt][dt]);
    }
  }
#pragma unroll
  for (int rt = 0; rt < 2; ++rt)
#pragma unroll
    for (int j = 0; j < 4; ++j) {
      const float inv = 1.f / lrun[rt][j];
      const int row = qrow0 + rt * 16 + lq * 4 + j;
#pragma unroll
      for (int dt = 0; dt < 4; ++dt) p.cat[(size_t)row * DM + 512 + hq * 64 + dt * 16 + l15] = f2bf(O[rt][dt][j] * inv);
    }
  __syncthreads();
}

DI void gmlp_item(const Params& p, int layer, int ci, char* smem) {
  const int tid = threadIdx.x, lane = tid & 63, wave = tid >> 6;
  const int l15 = lane & 15, lq = lane >> 4;
  u16* vT = (u16*)smem;
  float* rowss = (float*)(smem + 256 * 136 * 2);
  const int grow0 = ci * 128;
  const float* lng = p.gmlp_ln_g + layer * 256;
  const float* lnb = p.gmlp_ln_b + layer * 256;
  for (int i = 0; i < 32; ++i) {
    const int pr = wave * 32 + i;
    const u16* zr = p.z + (size_t)(grow0 + pr) * ZW + ZGV + lane * 4;
    const uint2 u = *(const uint2*)zr;
    float v[4];
    v[0] = gelu_f(__uint_as_float(u.x << 16)); v[1] = gelu_f(__uint_as_float(u.x & 0xffff0000u));
    v[2] = gelu_f(__uint_as_float(u.y << 16)); v[3] = gelu_f(__uint_as_float(u.y & 0xffff0000u));
    const float mean = wave_sum(v[0] + v[1] + v[2] + v[3]) * (1.f / 256.f);
    float q = 0.f;
#pragma unroll
    for (int e = 0; e < 4; ++e) { v[e] -= mean; q += v[e] * v[e]; }
    q = wave_sum(q) * (1.f / 256.f);
    const float rstd = rsqrtf(q + 1e-5f);
#pragma unroll
    for (int e = 0; e < 4; ++e) {
      const int c = lane * 4 + e;
      vT[c * 136 + pr] = f2bf(v[e] * rstd * lng[c] + lnb[c]);
    }
  }
  __syncthreads();
  const int g = wave;
  const float* ws = p.gmlp_ws + (size_t)(layer * 4 + g) * 128 * 128;
  const float* bs = p.gmlp_bs + (size_t)(layer * 4 + g) * 128;
  const float* og = p.gmlp_out_g + layer * 256;
  for (int half = 0; half < 2; ++half) {
    f32x4 acc[4][4];
#pragma unroll
    for (int rt = 0; rt < 4; ++rt)
#pragma unroll
      for (int ct = 0; ct < 4; ++ct) acc[rt][ct] = f32x4{0.f, 0.f, 0.f, 0.f};
#pragma unroll 1
    for (int ks = 0; ks < 4; ++ks) {
      bf16x8 vf[4];
#pragma unroll
      for (int ct = 0; ct < 4; ++ct) vf[ct] = *(const bf16x8*)(vT + (g * 64 + ct * 16 + l15) * 136 + ks * 32 + lq * 8);
#pragma unroll
      for (int rt = 0; rt < 4; ++rt) {
        const float* wr = ws + (size_t)(half * 64 + rt * 16 + l15) * 128 + ks * 32 + lq * 8;
        const float4 w0 = *(const float4*)wr, w1 = *(const float4*)(wr + 4);
        uint4 pk;
        pk.x = pack2(w0.x, w0.y); pk.y = pack2(w0.z, w0.w); pk.z = pack2(w1.x, w1.y); pk.w = pack2(w1.z, w1.w);
        const bf16x8 af = __builtin_bit_cast(bf16x8, pk);
#pragma unroll
        for (int ct = 0; ct < 4; ++ct) acc[rt][ct] = MFMA16(af, vf[ct], acc[rt][ct]);
      }
    }
#pragma unroll
    for (int rt = 0; rt < 4; ++rt)
#pragma unroll
      for (int j = 0; j < 4; ++j) {
        const int pr = half * 64 + rt * 16 + lq * 4 + j;
        const float bias = bs[pr];
        const u16* zr = p.z + (size_t)(grow0 + pr) * ZW + ZGU + g * 64 + l15;
        float ss = 0.f;
#pragma unroll
        for (int ct = 0; ct < 4; ++ct) {
          const float u = gelu_f(bf2f(zr[ct * 16]));
          const float val = u * (acc[rt][ct][j] + bias);
          acc[rt][ct][j] = val;
          ss += val * val;
        }
        ss += __shfl_xor(ss, 1); ss += __shfl_xor(ss, 2); ss += __shfl_xor(ss, 4); ss += __shfl_xor(ss, 8);
        if (l15 == 0) rowss[g * 128 + pr] = ss;
      }
    __syncthreads();
#pragma unroll
    for (int rt = 0; rt < 4; ++rt)
#pragma unroll
      for (int j = 0; j < 4; ++j) {
        const int pr = half * 64 + rt * 16 + lq * 4 + j;
        const float tot = rowss[pr] + rowss[128 + pr] + rowss[256 + pr] + rowss[384 + pr];
        const float rstd = rsqrtf(tot * (1.f / 256.f) + 1e-6f);
#pragma unroll
        for (int ct = 0; ct < 4; ++ct) {
          const int c = g * 64 + ct * 16 + l15;
          p.cat[(size_t)(grow0 + pr) * DM + 256 + c] = f2bf(acc[rt][ct][j] * rstd * og[c]);
        }
      }
  }
  __syncthreads();
}

DI int gla_row(int b, int c, int s) { return c < 4 ? (M_LAT + b * TC + c * 64 + s) : (b * TL + (c - 4) * 64 + s); }
DI int gla_slot(int c, int dir) { return dir == 0 ? c : (c < 4 ? 3 - c : 39 - c); }

DI void gla_cum(const Params& p, int layer, int b, int h, int c, int dir, float* cum) {
  const int tid = threadIdx.x, lane = tid & 63, wave = tid >> 6;
  {
    const int s = tid >> 2, d0 = (tid & 3) * 8;
    const u16* zr = p.z + (size_t)gla_row(b, c, s) * ZW + (dir ? ZGB : ZGF) + h * 32 + d0;
    float zf[8];
    unpack8(*(const uint4*)zr, zf);
    const float* ba = p.gla_ba + (size_t)(layer * 2 + dir) * 128 + h * 32 + d0;
#pragma unroll
    for (int e = 0; e < 8; ++e) cum[s * 32 + d0 + e] = logsigmoid_f(zf[e] + ba[e]) * (1.f / 16.f);
  }
  __syncthreads();
  {
    const int s = dir ? 63 - lane : lane;
#pragma unroll
    for (int dd = 0; dd < 8; ++dd) {
      const int d = wave * 8 + dd;
      float v = cum[s * 32 + d];
#pragma unroll
      for (int off = 1; off < 64; off <<= 1) {
        const float t = __shfl_up(v, off);
        if (lane >= off) v += t;
      }
      cum[s * 32 + d] = v;
    }
  }
  __syncthreads();
}

DI void gla_a_item(const Params& p, int layer, int item, char* smem) {
  const int tid = threadIdx.x;
  float* cum = (float*)smem;
  float* kt = cum + 2048;
  float* vs = kt + 2112;
  const int c = item % NSLOT, h = (item / NSLOT) & 3, b = item / (NSLOT * 4);
  for (int i = tid; i < 512; i += NT) {
    const int s = i >> 3, ch = i & 7;
    float f[8];
    unpack8(*(const uint4*)(p.z + (size_t)gla_row(b, c, s) * ZW + ZV + h * 64 + ch * 8), f);
#pragma unroll
    for (int e = 0; e < 8; ++e) vs[s * 64 + ch * 8 + e] = f[e];
  }
  for (int dir = 0; dir < 2; ++dir) {
    gla_cum(p, layer, b, h, c, dir, cum);
    const int send = dir ? 0 : 63;
    {
      const int s = tid >> 2, d0 = (tid & 3) * 8;
      float kf[8];
      unpack8(*(const uint4*)(p.z + (size_t)gla_row(b, c, s) * ZW + ZK + h * 32 + d0), kf);
#pragma unroll
      for (int e = 0; e < 8; ++e) kt[s * 33 + d0 + e] = kf[e] * __expf(cum[send * 32 + d0 + e] - cum[s * 32 + d0 + e]);
    }
    const size_t sidx = ((size_t)((b * 4 + h) * 2 + dir) * NSLOT + gla_slot(c, dir));
    if (tid < 32) p.Dd[sidx * 32 + tid] = __expf(cum[send * 32 + tid]);
    __syncthreads();
    {
      const int d = tid >> 3, e0 = (tid & 7) * 8;
      float acc[8];
#pragma unroll
      for (int e = 0; e < 8; ++e) acc[e] = 0.f;
      for (int s = 0; s < 64; ++s) {
        const float a = kt[s * 33 + d];
        const float4 v0 = *(const float4*)(vs + s * 64 + e0), v1 = *(const float4*)(vs + s * 64 + e0 + 4);
        acc[0] += a * v0.x; acc[1] += a * v0.y; acc[2] += a * v0.z; acc[3] += a * v0.w;
        acc[4] += a * v1.x; acc[5] += a * v1.y; acc[6] += a * v1.z; acc[7] += a * v1.w;
      }
      float* Lp = p.L + sidx * 2048 + d * 64 + e0;
      *(float4*)Lp = make_float4(acc[0], acc[1], acc[2], acc[3]);
      *(float4*)(Lp + 4) = make_float4(acc[4], acc[5], acc[6], acc[7]);
    }
    __syncthreads();
  }
}

DI void phase_gla_b(const Params& p) {
  const int total = NB * 4 * 2 * 2048;
  for (int idx = blockIdx.x * NT + threadIdx.x; idx < total; idx += gridDim.x * NT) {
    const int chain = idx >> 11, de = idx & 2047, d = de >> 6;
    float S = 0.f;
    float* Lp = p.L + (size_t)chain * NSLOT * 2048 + de;
    const float* Dp = p.Dd + (size_t)chain * NSLOT * 32 + d;
    for (int sl = 0; sl < NSLOT; ++sl) {
      const float loc = Lp[(size_t)sl * 2048];
      Lp[(size_t)sl * 2048] = S;
      S = Dp[sl * 32] * S + loc;
    }
  }
}

DI void gla_c_item(const Params& p, int layer, int item, char* smem) {
  const int tid = threadIdx.x;
  float* cum = (float*)smem;
  float* qt = cum + 2048;
  float* kt = qt + 2112;
  float* vs = kt + 2112;
  float* att = vs + 4096;
  float* Ss = att + 4160;
  const int c = item % NSLOT, h = (item / NSLOT) & 3, b = item / (NSLOT * 4);
  for (int i = tid; i < 512; i += NT) {
    const int s = i >> 3, ch = i & 7;
    float f[8];
    unpack8(*(const uint4*)(p.z + (size_t)gla_row(b, c, s) * ZW + ZV + h * 64 + ch * 8), f);
#pragma unroll
    for (int e = 0; e < 8; ++e) vs[s * 64 + ch * 8 + e] = f[e];
  }
  const int t = tid >> 2, sg = tid & 3, e0 = sg * 16;
  float o[16];
#pragma unroll
  for (int e = 0; e < 16; ++e) o[e] = 0.f;
  for (int dir = 0; dir < 2; ++dir) {
    gla_cum(p, layer, b, h, c, dir, cum);
    {
      const int s = tid >> 2, d0 = (tid & 3) * 8;
      const u16* zr = p.z + (size_t)gla_row(b, c, s) * ZW + h * 32 + d0;
      float qf[8], kf[8];
      unpack8(*(const uint4*)(zr + ZQ), qf);
      unpack8(*(const uint4*)(zr + ZK), kf);
#pragma unroll
      for (int e = 0; e < 8; ++e) {
        const float cv = cum[s * 32 + d0 + e];
        qt[s * 33 + d0 + e] = qf[e] * 0.17677669529663687f * __expf(cv);
        kt[s * 33 + d0 + e] = kf[e] * __expf(-cv);
      }
      const size_t sidx = ((size_t)((b * 4 + h) * 2 + dir) * NSLOT + gla_slot(c, dir));
      const float* Lp = p.L + sidx * 2048;
      *(float4*)(Ss + tid * 8) = *(const float4*)(Lp + tid * 8);
      *(float4*)(Ss + tid * 8 + 4) = *(const float4*)(Lp + tid * 8 + 4);
    }
    __syncthreads();
    {
      float qr[32];
#pragma unroll
      for (int d = 0; d < 32; ++d) qr[d] = qt[t * 33 + d];
#pragma unroll 1
      for (int i = 0; i < 16; ++i) {
        const int s = sg * 16 + i;
        float a = 0.f;
#pragma unroll
        for (int d = 0; d < 32; ++d) a += qr[d] * kt[s * 33 + d];
        const bool valid = dir ? (s >= t) : (s <= t);
        a = valid ? a : 0.f;
        if (dir == 0) att[t * 65 + s] = a; else att[t * 65 + s] += a;
      }
#pragma unroll 2
      for (int d = 0; d < 32; ++d) {
        const float a = qr[d];
        const float* sp = Ss + d * 64 + e0;
#pragma unroll
        for (int e = 0; e < 16; e += 4) {
          const float4 v = *(const float4*)(sp + e);
          o[e] += a * v.x; o[e + 1] += a * v.y; o[e + 2] += a * v.z; o[e + 3] += a * v.w;
        }
      }
    }
    __syncthreads();
  }
#pragma unroll 2
  for (int s = 0; s < 64; ++s) {
    const float a = att[t * 65 + s];
    const float* vp = vs + s * 64 + e0;
#pragma unroll
    for (int e = 0; e < 16; e += 4) {
      const float4 v = *(const float4*)(vp + e);
      o[e] += a * v.x; o[e + 1] += a * v.y; o[e + 2] += a * v.z; o[e + 3] += a * v.w;
    }
  }
  float ss = 0.f;
#pragma unroll
  for (int e = 0; e < 16; ++e) ss += o[e] * o[e];
  ss += __shfl_xor(ss, 1); ss += __shfl_xor(ss, 2);
  const float rstd = rsqrtf(ss * (1.f / 64.f) + 1e-6f);
  const int row = gla_row(b, c, t);
  const u16* ogp = p.z + (size_t)row * ZW + ZOG + h * 64 + e0;
  float og[16];
  unpack8(*(const uint4*)ogp, og);
  unpack8(*(const uint4*)(ogp + 8), og + 8);
  const float* gn = p.gla_norm + layer * 64 + e0;
  unsigned pk[8];
#pragma unroll
  for (int e = 0; e < 16; e += 2)
    pk[e >> 1] = pack2(o[e] * rstd * gn[e] * silu_f(og[e]), o[e + 1] * rstd * gn[e + 1] * silu_f(og[e + 1]));
  u16* cp = p.cat + (size_t)row * DM + h * 64 + e0;
  *(uint4*)cp = make_uint4(pk[0], pk[1], pk[2], pk[3]);
  *(uint4*)(cp + 8) = make_uint4(pk[4], pk[5], pk[6], pk[7]);
  __syncthreads();
}

DI void swa_norm_rows(const Params& p, int layer, int Mrows) {
  const int tid = threadIdx.x, lane = tid & 63, wave = tid >> 6;
  const float* g = p.swa_out_g + layer * 512 + lane * 8;
  for (int row = blockIdx.x * 4 + wave; row < Mrows; row += gridDim.x * 4) {
    u16* cp = p.cat + (size_t)row * DM + 512 + lane * 8;
    float f[8];
    unpack8(*(const uint4*)cp, f);
    float ss = 0.f;
#pragma unroll
    for (int e = 0; e < 8; ++e) ss += f[e] * f[e];
    ss = wave_sum(ss);
    const float rstd = rsqrtf(ss * (1.f / 512.f) + 1e-6f);
    uint4 o;
    o.x = pack2(f[0] * rstd * g[0], f[1] * rstd * g[1]); o.y = pack2(f[2] * rstd * g[2], f[3] * rstd * g[3]);
    o.z = pack2(f[4] * rstd * g[4], f[5] * rstd * g[5]); o.w = pack2(f[6] * rstd * g[6], f[7] * rstd * g[7]);
    *(uint4*)cp = o;
  }
}

DI void phase_mix_a(const Params& p, int layer, char* smem) {
  const bool need_ctx = layer == 0;
  const int n_swa = 2048, n_swac = need_ctx ? 256 : 0, n_gm = need_ctx ? 288 : 256, n_gla = NB * 4 * NSLOT;
  const int total = n_swa + n_swac + n_gm + n_gla;
  for (int item = blockIdx.x; item < total; item += gridDim.x) {
    int it = item;
    if (it < n_swa) { swa_item(p, layer, it, false, smem); continue; }
    it -= n_swa;
    if (it < n_swac) { swa_item(p, layer, it, true, smem); continue; }
    it -= n_swac;
    if (it < n_gm) { gmlp_item(p, layer, it, smem); continue; }
    it -= n_gm;
    gla_a_item(p, layer, it, smem);
  }
}

DI void phase_mix_c(const Params& p, int layer, char* smem) {
  const bool need_ctx = layer == 0;
  const int n_gla = NB * 4 * NSLOT;
  for (int item = blockIdx.x; item < n_gla; item += gridDim.x) {
    const int c = item % NSLOT;
    if (!need_ctx && c < 4) continue;
    gla_c_item(p, layer, item, smem);
  }
  swa_norm_rows(p, layer, need_ctx ? M_ALL : M_LAT);
}

constexpr int N_STEPS = 2 + 2 * 9;

DI void run_step(const Params& p, int step, char* smem) {
  if (step == 0) { phase_prep(p, smem); return; }
  if (step == 1) { phase_rows(p, 0, M_ALL, true, 0, 0, nullptr, true, 0, 0, p.n1_pre); return; }
  const int l = (step - 2) / 9, ph = (step - 2) % 9;
  const int Mo = l == 0 ? M_ALL : M_LAT;
  switch (ph) {
    case 0: phase_gemm<0>(p.h, p.WinT + (size_t)l * ZW * DM, M_ALL, ZW, DM, p.z, ZW, smem); break;
    case 1: phase_mix_a(p, l, smem); break;
    case 2: phase_gla_b(p); break;
    case 3: phase_mix_c(p, l, smem); break;
    case 4: phase_gemm<0>(p.cat, p.WoutT + (size_t)l * DM * DM, Mo, DM, DM, p.y, DM, smem); break;
    case 5: phase_rows(p, 1, Mo, l == 0, l, 2, p.n1_post + l * DM, true, l, 3, p.n2_pre + l * DM); break;
    case 6: phase_gemm<1>(p.h, p.WguT + (size_t)l * 2 * DFF * DM, Mo, 2 * DFF, DM, p.act, DFF, smem); break;
    case 7: phase_gemm<0>(p.act, p.WdT + (size_t)l * DM * DFF, Mo, DM, DFF, p.y, DM, smem); break;
    case 8: phase_rows(p, 1, Mo, false, l, 5, p.n2_post + l * DM, l == 0, l + 1, 0, p.n1_pre + (l + 1 < 2 ? l + 1 : 1) * DM); break;
  }
}

template <int S>
DI void run_one(const Params& p, int step_begin, int step_end, char* smem) {
  if (step_begin <= S && S < step_end) {
    run_step(p, S, smem);
    if (S + 1 < step_end) cg::this_grid().sync();
  }
}

__global__ void __launch_bounds__(NT, 2) fwd_kernel(Params p_unused, int step_begin, int step_end) {
  __shared__ __attribute__((aligned(16))) char smem[SMEM_BYTES];
  const Params& p = *(const Params*)__builtin_amdgcn_kernarg_segment_ptr();
  run_one<0>(p, step_begin, step_end, smem);  run_one<1>(p, step_begin, step_end, smem);
  run_one<2>(p, step_begin, step_end, smem);  run_one<3>(p, step_begin, step_end, smem);
  run_one<4>(p, step_begin, step_end, smem);  run_one<5>(p, step_begin, step_end, smem);
  run_one<6>(p, step_begin, step_end, smem);  run_one<7>(p, step_begin, step_end, smem);
  run_one<8>(p, step_begin, step_end, smem);  run_one<9>(p, step_begin, step_end, smem);
  run_one<10>(p, step_begin, step_end, smem); run_one<11>(p, step_begin, step_end, smem);
  run_one<12>(p, step_begin, step_end, smem); run_one<13>(p, step_begin, step_end, smem);
  run_one<14>(p, step_begin, step_end, smem); run_one<15>(p, step_begin, step_end, smem);
  run_one<16>(p, step_begin, step_end, smem); run_one<17>(p, step_begin, step_end, smem);
  run_one<18>(p, step_begin, step_end, smem); run_one<19>(p, step_begin, step_end, smem);
}

extern "C" void kernel_launch(void* const* d_in, const int* in_sizes, int n_in, void* d_out, int out_size, void* d_ws,
                              size_t ws_size, hipStream_t stream) {
  static int grid_blocks = 0;
  if (!grid_blocks) {
    int dev = 0, cus = 0, per_cu = 0;
    hipGetDevice(&dev);
    hipDeviceGetAttribute(&cus, hipDeviceAttributeMultiprocessorCount, dev);
    hipOccupancyMaxActiveBlocksPerMultiprocessor(&per_cu, fwd_kernel, NT, 0);
    if (per_cu < 1) per_cu = 1;
    if (per_cu > 2) per_cu = 2;
    grid_blocks = cus * per_cu;
  }
  Params p{};
  const float** fp = (const float**)&p;
  for (int i = 0; i < 24; ++i) fp[i] = (const float*)d_in[i];
  p.out = (float*)d_out;
  char* w = (char*)d_ws;
  size_t off = 0;
  auto take = [&](size_t bytes) { char* r = w + off; off += (bytes + 255) & ~(size_t)255; return r; };
  p.WinT = (u16*)take((size_t)2 * ZW * DM * 2);
  p.WoutT = (u16*)take((size_t)2 * DM * DM * 2);
  p.WguT = (u16*)take((size_t)2 * 2 * DFF * DM * 2);
  p.WdT = (u16*)take((size_t)2 * DM * DFF * 2);
  p.mod = (float*)take((size_t)2 * 17 * 6144 * 4);
  p.rope = (float*)take((size_t)TL * 32 * 2 * 4);
  p.h = (u16*)take((size_t)M_ALL * DM * 2);
  p.z = (u16*)take((size_t)M_ALL * ZW * 2);
  p.cat = (u16*)take((size_t)M_ALL * DM * 2);
  p.act = p.z;
  p.y = (u16*)take((size_t)M_ALL * DM * 2);
  p.xc = (float*)take((size_t)M_CTX * DM * 4);
  p.L = (float*)take((size_t)NB * 4 * 2 * NSLOT * 2048 * 4);
  p.Dd = (float*)take((size_t)NB * 4 * 2 * NSLOT * 32 * 4);
  if (off > ws_size) { fprintf(stderr, "workspace too small: need %zu have %zu\n", off, ws_size); return; }
#if MK_ONE_LAUNCH
  int sb = 0, se = N_STEPS;
  void* args[] = {&p, &sb, &se};
  hipError_t e = hipLaunchCooperativeKernel((void*)fwd_kernel, dim3(grid_blocks), dim3(NT), args, 0, stream);
  if (e != hipSuccess) fprintf(stderr, "cooperative launch failed: %s (grid %d)\n", hipGetErrorString(e), grid_blocks);
#else
  for (int s = 0; s < N_STEPS; ++s) fwd_kernel<<<grid_blocks, NT, 0, stream>>>(p, s, s + 1);
#endif
}
```

```cpp
#include <hip/hip_runtime.h>
#include <hip/hip_cooperative_groups.h>
#include <cstdio>
namespace cg = cooperative_groups;

#ifndef MK_ONE_LAUNCH
#define MK_ONE_LAUNCH 1
#endif

#define DI __device__ __forceinline__
typedef unsigned short u16;
using bf16x8 = __attribute__((ext_vector_type(8))) short;
using f32x4 = __attribute__((ext_vector_type(4))) float;
#define MFMA16(a, b, c) __builtin_amdgcn_mfma_f32_16x16x32_bf16((a), (b), (c), 0, 0, 0)

constexpr int NT = 256;
constexpr int DM = 1024;
constexpr int NB = 16;
constexpr int TL = 2048;
constexpr int TC = 256;
constexpr int M_LAT = NB * TL;
constexpr int M_CTX = NB * TC;
constexpr int M_ALL = M_LAT + M_CTX;
constexpr int ZW = 2304;
constexpr int IN_COLS = 2080;
constexpr int DFF = 2816;
constexpr int ZQ = 0, ZK = 128, ZV = 256, ZOG = 512, ZGU = 768, ZGV = 1024, ZSQ = 1280, ZSK = 1792, ZSV = 1920, ZGF = 2048, ZGB = 2176;
constexpr int NSLOT = 36;
constexpr int SMEM_BYTES = 73728;

struct Params {
  const float *x, *c, *ctx, *c_ctx, *mod_w, *mod_b, *n1_pre, *n1_post, *n2_pre, *n2_post, *w_in, *w_out,
      *gla_wa2, *gla_ba, *gla_norm, *gmlp_ln_g, *gmlp_ln_b, *gmlp_ws, *gmlp_bs, *gmlp_out_g, *swa_sink, *swa_out_g,
      *ffn_w_gu, *ffn_w_down;
  float* out;
  u16 *WinT, *WoutT, *WguT, *WdT;
  float *mod, *rope;
  u16 *h, *z, *cat, *y, *act;
  float *xc, *L, *Dd;
};

DI u16 f2bf(float f) { unsigned u = __float_as_uint(f); u += 0x7fffu + ((u >> 16) & 1u); return (u16)(u >> 16); }
DI float bf2f(u16 h) { return __uint_as_float(((unsigned)h) << 16); }
DI unsigned pack2(float a, float b) { return (unsigned)f2bf(a) | ((unsigned)f2bf(b) << 16); }
DI float wave_sum(float v) {
#pragma unroll
  for (int o = 32; o >= 1; o >>= 1) v += __shfl_xor(v, o);
  return v;
}
DI float silu_f(float x) { return x / (1.f + __expf(-x)); }
DI float gelu_f(float x) { return 0.5f * x * (1.f + erff(x * 0.70710678118654752f)); }
DI float logsigmoid_f(float z) { return fminf(z, 0.f) - log1pf(__expf(-fabsf(z))); }
DI void unpack8(const uint4& v, float* f) {
  f[0] = __uint_as_float(v.x << 16); f[1] = __uint_as_float(v.x & 0xffff0000u);
  f[2] = __uint_as_float(v.y << 16); f[3] = __uint_as_float(v.y & 0xffff0000u);
  f[4] = __uint_as_float(v.z << 16); f[5] = __uint_as_float(v.z & 0xffff0000u);
  f[6] = __uint_as_float(v.w << 16); f[7] = __uint_as_float(v.w & 0xffff0000u);
}

DI int colmap_win(int n) { return n < 768 ? n : n + 32; }
DI int colmap_gu(int n) { int blk = n >> 4, w = n & 15; return (blk >> 1) * 16 + w + ((blk & 1) ? DFF : 0); }

template <int CM>
DI void transpose_tile(const float* __restrict__ src, int ld_src, int k0, int n0, u16* __restrict__ dst, int K, float* tile) {
  const int tid = threadIdx.x;
  {
    const int j = tid & 63, i0 = tid >> 6;
    const int n = n0 + j;
    const int col = CM == 1 ? colmap_win(n) : (CM == 2 ? colmap_gu(n) : n);
#pragma unroll
    for (int ii = 0; ii < 16; ++ii) {
      const int k = i0 + 4 * ii;
      tile[k * 65 + j] = src[(size_t)(k0 + k) * ld_src + col];
    }
  }
  __syncthreads();
  {
    const int kk = tid & 63, nn0 = tid >> 6;
#pragma unroll
    for (int ii = 0; ii < 16; ++ii) {
      const int n = nn0 + 4 * ii;
      dst[(size_t)(n0 + n) * K + k0 + kk] = f2bf(tile[kk * 65 + n]);
    }
  }
  __syncthreads();
}

DI void phase_prep(const Params& p, char* smem) {
  float* sf = (float*)smem;
  const int tid = threadIdx.x, lane = tid & 63, wave = tid >> 6;
  constexpr int N_TR_L = 512 + 256 + 1408 + 704;
  constexpr int N_TR = 2 * N_TR_L;
  constexpr int N_FOLD = 64, N_MOD = 192, N_ROPE = 256;
  constexpr int N_ALL = N_TR + N_FOLD + N_MOD + N_ROPE;
  for (int item = blockIdx.x; item < N_ALL; item += gridDim.x) {
    if (item < N_TR) {
      const int l = item / N_TR_L;
      int r = item - l * N_TR_L;
      if (r < 512) {
        transpose_tile<1>(p.w_in + (size_t)l * DM * IN_COLS, IN_COLS, (r >> 5) * 64, (r & 31) * 64, p.WinT + (size_t)l * ZW * DM, DM, sf);
      } else if (r < 768) {
        r -= 512;
        transpose_tile<0>(p.w_out + (size_t)l * DM * DM, DM, (r >> 4) * 64, (r & 15) * 64, p.WoutT + (size_t)l * DM * DM, DM, sf);
      } else if (r < 2176) {
        r -= 768;
        transpose_tile<2>(p.ffn_w_gu + (size_t)l * DM * 2 * DFF, 2 * DFF, (r / 88) * 64, (r % 88) * 64, p.WguT + (size_t)l * 2 * DFF * DM, DM, sf);
      } else {
        r -= 2176;
        transpose_tile<0>(p.ffn_w_down + (size_t)l * DFF * DM, DM, (r >> 4) * 64, (r & 15) * 64, p.WdT + (size_t)l * DM * DFF, DFF, sf);
      }
    } else if (item < N_TR + N_FOLD) {
      const int idx = item - N_TR;
      const int l = idx >> 5, dir = (idx >> 4) & 1, k0 = (idx & 15) * 64;
      float* wa = sf;
      float* cd = sf + 2048;
      const float* wa2 = p.gla_wa2 + (size_t)(l * 2 + dir) * 16 * 128;
      for (int i = tid; i < 2048; i += NT) wa[i] = wa2[i];
      for (int i = tid; i < 1024; i += NT) {
        const int kk = i >> 4, r = i & 15;
        cd[kk * 17 + r] = p.w_in[(size_t)l * DM * IN_COLS + (size_t)(k0 + kk) * IN_COLS + 768 + dir * 16 + r];
      }
      __syncthreads();
      const int kk = tid & 63, jg = tid >> 6;
      u16* dst = p.WinT + (size_t)l * ZW * DM;
      for (int jj = 0; jj < 32; ++jj) {
        const int j = jg * 32 + jj;
        float s = 0.f;
#pragma unroll
        for (int r = 0; r < 16; ++r) s += cd[kk * 17 + r] * wa[r * 128 + j];
        dst[(size_t)(ZGF + dir * 128 + j) * DM + k0 + kk] = f2bf(s);
      }
      __syncthreads();
    } else if (item < N_TR + N_FOLD + N_MOD) {
      const int cgi = item - N_TR - N_FOLD;
      const int gc = cgi * 64 + lane;
      const int l = gc / 6144, n = gc - l * 6144;
      for (int i = tid; i < 17 * 1024; i += NT) {
        const float v = i < 16 * 1024 ? p.c[i] : p.c_ctx[i - 16 * 1024];
        sf[i] = silu_f(v);
      }
      __syncthreads();
      float acc[17];
#pragma unroll
      for (int r = 0; r < 17; ++r) acc[r] = 0.f;
      const float* W = p.mod_w + (size_t)l * DM * 6144 + n;
      const int kb = wave * 256;
#pragma unroll 4
      for (int k = kb; k < kb + 256; ++k) {
        const float wv = W[(size_t)k * 6144];
#pragma unroll
        for (int r = 0; r < 17; ++r) acc[r] += sf[r * 1024 + k] * wv;
      }
      __syncthreads();
#pragma unroll
      for (int r = 0; r < 17; ++r) sf[(wave * 17 + r) * 64 + lane] = acc[r];
      __syncthreads();
      for (int o = tid; o < 17 * 64; o += NT) {
        const int r = o >> 6, ln = o & 63;
        const float s = sf[(0 * 17 + r) * 64 + ln] + sf[(1 * 17 + r) * 64 + ln] + sf[(2 * 17 + r) * 64 + ln] + sf[(3 * 17 + r) * 64 + ln];
        const int nn = cgi * 64 + ln - l * 6144;
        p.mod[(size_t)(l * 17 + r) * 6144 + nn] = s + p.mod_b[l * 6144 + nn];
      }
      __syncthreads();
    } else {
      const int idx = item - N_TR - N_FOLD - N_MOD;
      const int e = idx * 256 + tid;
      const int t = e >> 5, f = e & 31;
      const int fi = f & 15;
      const float inv = powf(10000.f, -(float)(2 * fi) / 32.f);
      const float pos = f < 16 ? (float)(t >> 6) : (float)(t & 63);
      const float ang = pos * inv;
      p.rope[e * 2 + 0] = cosf(ang);
      p.rope[e * 2 + 1] = sinf(ang);
    }
  }
}

DI void phase_rows(const Params& p, int mode, int Mrows, bool first_layer_input, int l_in, int gate_idx, const float* gpost,
                   bool write_h, int l_out, int sh_idx, const float* gpre) {
  const int tid = threadIdx.x, lane = tid & 63, wave = tid >> 6;
  for (int row = blockIdx.x * 4 + wave; row < Mrows; row += gridDim.x * 4) {
    const bool lat = row < M_LAT;
    const int mrow = lat ? (row >> 11) : 16;
    const float* xin;
    float* xout;
    if (lat) {
      xin = (first_layer_input ? p.x : p.out) + (size_t)row * DM;
      xout = p.out + (size_t)row * DM;
    } else {
      xin = (first_layer_input ? p.ctx : p.xc) + (size_t)(row - M_LAT) * DM;
      xout = p.xc + (size_t)(row - M_LAT) * DM;
    }
    float4 xv[4];
#pragma unroll
    for (int i = 0; i < 4; ++i) xv[i] = *(const float4*)(xin + lane * 4 + 256 * i);
    if (mode == 1) {
      const u16* yr = p.y + (size_t)row * DM;
      float4 yv[4];
      float ss = 0.f;
#pragma unroll
      for (int i = 0; i < 4; ++i) {
        const uint2 u = *(const uint2*)(yr + lane * 4 + 256 * i);
        yv[i].x = __uint_as_float(u.x << 16); yv[i].y = __uint_as_float(u.x & 0xffff0000u);
        yv[i].z = __uint_as_float(u.y << 16); yv[i].w = __uint_as_float(u.y & 0xffff0000u);
        ss += yv[i].x * yv[i].x + yv[i].y * yv[i].y + yv[i].z * yv[i].z + yv[i].w * yv[i].w;
      }
      ss = wave_sum(ss);
      const float rstd = rsqrtf(ss * (1.f / DM) + 1e-6f);
      const float* gate = p.mod + (size_t)(l_in * 17 + mrow) * 6144 + gate_idx * 1024;
#pragma unroll
      for (int i = 0; i < 4; ++i) {
        const int c0 = lane * 4 + 256 * i;
        const float4 g = *(const float4*)(gpost + c0);
        const float4 gt = *(const float4*)(gate + c0);
        xv[i].x += gt.x * (yv[i].x * rstd * g.x);
        xv[i].y += gt.y * (yv[i].y * rstd * g.y);
        xv[i].z += gt.z * (yv[i].z * rstd * g.z);
        xv[i].w += gt.w * (yv[i].w * rstd * g.w);
        *(float4*)(xout + c0) = xv[i];
      }
    }
    if (write_h) {
      float ss = 0.f;
#pragma unroll
      for (int i = 0; i < 4; ++i) ss += xv[i].x * xv[i].x + xv[i].y * xv[i].y + xv[i].z * xv[i].z + xv[i].w * xv[i].w;
      ss = wave_sum(ss);
      const float rstd = rsqrtf(ss * (1.f / DM) + 1e-6f);
      const float* sh = p.mod + (size_t)(l_out * 17 + mrow) * 6144 + sh_idx * 1024;
      const float* sc = sh + 1024;
      u16* hr = p.h + (size_t)row * DM;
#pragma unroll
      for (int i = 0; i < 4; ++i) {
        const int c0 = lane * 4 + 256 * i;
        const float4 g = *(const float4*)(gpre + c0);
        const float4 a = *(const float4*)(sh + c0);
        const float4 s = *(const float4*)(sc + c0);
        uint2 o;
        o.x = pack2(xv[i].x * rstd * g.x * (1.f + s.x) + a.x, xv[i].y * rstd * g.y * (1.f + s.y) + a.y);
        o.y = pack2(xv[i].z * rstd * g.z * (1.f + s.z) + a.z, xv[i].w * rstd * g.w * (1.f + s.w) + a.w);
        *(uint2*)(hr + c0) = o;
      }
    }
  }
}

template <int EPI>
DI void phase_gemm(const u16* __restrict__ A, const u16* __restrict__ Bt, int M, int N, int K, u16* __restrict__ C, int ldc, char* smem) {
  const int tid = threadIdx.x, lane = tid & 63, wave = tid >> 6;
  const int wm = wave >> 1, wn = wave & 1;
  const int l15 = lane & 15, lq = lane >> 4;
  constexpr int LDS_ROW = 72;
  u16* sA = (u16*)smem;
  u16* sB = sA + 2 * 128 * LDS_ROW;
  const int tiles_n = N >> 7;
  const int ntiles = (M >> 7) * tiles_n;
  const int nk = K >> 6;
  for (int tile = blockIdx.x; tile < ntiles; tile += gridDim.x) {
    const int tm = tile / tiles_n, tn = tile - tm * tiles_n;
    const u16* Ag = A + (size_t)(tm * 128) * K;
    const u16* Bg = Bt + (size_t)(tn * 128) * K;
    uint4 ra[4], rb[4];
#pragma unroll
    for (int i = 0; i < 4; ++i) {
      const int c = tid + 256 * i, r = c >> 3, kc = c & 7;
      ra[i] = *(const uint4*)(Ag + (size_t)r * K + kc * 8);
      rb[i] = *(const uint4*)(Bg + (size_t)r * K + kc * 8);
    }
#pragma unroll
    for (int i = 0; i < 4; ++i) {
      const int c = tid + 256 * i, r = c >> 3, kc = c & 7;
      *(uint4*)(sA + r * LDS_ROW + kc * 8) = ra[i];
      *(uint4*)(sB + r * LDS_ROW + kc * 8) = rb[i];
    }
    __syncthreads();
    f32x4 acc[4][4];
#pragma unroll
    for (int i = 0; i < 4; ++i)
#pragma unroll
      for (int j = 0; j < 4; ++j) acc[i][j] = f32x4{0.f, 0.f, 0.f, 0.f};
    for (int kt = 0; kt < nk; ++kt) {
      const bool more = kt + 1 < nk;
      if (more) {
        const int ko = (kt + 1) * 64;
#pragma unroll
        for (int i = 0; i < 4; ++i) {
          const int c = tid + 256 * i, r = c >> 3, kc = c & 7;
          ra[i] = *(const uint4*)(Ag + (size_t)r * K + ko + kc * 8);
          rb[i] = *(const uint4*)(Bg + (size_t)r * K + ko + kc * 8);
        }
      }
      const u16* a_s = sA + (kt & 1) * 128 * LDS_ROW + (wm * 64 + l15) * LDS_ROW + lq * 8;
      const u16* b_s = sB + (kt & 1) * 128 * LDS_ROW + (wn * 64 + l15) * LDS_ROW + lq * 8;
#pragma unroll
      for (int ks = 0; ks < 2; ++ks) {
        bf16x8 af[4], bfr[4];
#pragma unroll
        for (int i = 0; i < 4; ++i) af[i] = *(const bf16x8*)(a_s + i * 16 * LDS_ROW + ks * 32);
#pragma unroll
        for (int j = 0; j < 4; ++j) bfr[j] = *(const bf16x8*)(b_s + j * 16 * LDS_ROW + ks * 32);
#pragma unroll
        for (int i = 0; i < 4; ++i)
#pragma unroll
          for (int j = 0; j < 4; ++j) acc[i][j] = MFMA16(af[i], bfr[j], acc[i][j]);
      }
      if (more) {
        u16* dA = sA + ((kt + 1) & 1) * 128 * LDS_ROW;
        u16* dB = sB + ((kt + 1) & 1) * 128 * LDS_ROW;
#pragma unroll
        for (int i = 0; i < 4; ++i) {
          const int c = tid + 256 * i, r = c >> 3, kc = c & 7;
          *(uint4*)(dA + r * LDS_ROW + kc * 8) = ra[i];
          *(uint4*)(dB + r * LDS_ROW + kc * 8) = rb[i];
        }
      }
      __syncthreads();
    }
    const int row0 = tm * 128 + wm * 64 + lq * 4;
    if (EPI == 0) {
      const int col0 = tn * 128 + wn * 64 + l15;
#pragma unroll
      for (int i = 0; i < 4; ++i)
#pragma unroll
        for (int j = 0; j < 4; ++j)
#pragma unroll
          for (int r = 0; r < 4; ++r)
            C[(size_t)(row0 + i * 16 + r) * ldc + col0 + j * 16] = f2bf(acc[i][j][r]);
    } else {
      const int col0 = tn * 64 + wn * 32 + l15;
#pragma unroll
      for (int i = 0; i < 4; ++i)
#pragma unroll
        for (int jj = 0; jj < 2; ++jj)
#pragma unroll
          for (int r = 0; r < 4; ++r) {
            const float g = acc[i][2 * jj][r], u = acc[i][2 * jj + 1][r];
            C[(size_t)(row0 + i * 16 + r) * ldc + col0 + jj * 16] = f2bf(silu_f(g) * u);
          }
    }
  }
}

DI void swa_item(const Params& p, int layer, int item, bool ctxq, char* smem) {
  const int tid = threadIdx.x, lane = tid & 63, wave = tid >> 6;
  const int l15 = lane & 15, lq = lane >> 4;
  u16* Ks = (u16*)smem;
  u16* Vt = Ks + 128 * 72;
  u16* Ps = Vt + 64 * 136;
  u16* Pw = Ps + wave * 32 * 136;
  const int hq = item & 7;
  const int g = hq >> 2;
  int b, n;
  if (!ctxq) { n = (item >> 3) & 15; b = item >> 7; } else { n = (item >> 3) & 1; b = item >> 4; }
  const int qrow0 = (ctxq ? (M_LAT + b * TC + n * 128) : (b * TL + n * 128)) + wave * 32;
  const int ctxrow0 = M_LAT + b * TC;
  bf16x8 Q[2][2];
#pragma unroll
  for (int rt = 0; rt < 2; ++rt)
#pragma unroll
    for (int ks = 0; ks < 2; ++ks) {
      const int row = qrow0 + rt * 16 + l15;
      const int sub = lq * 8;
      const u16* zr = p.z + (size_t)row * ZW + ZSQ + hq * 64 + ks * 32;
      float own[8], par[8], o[8];
      unpack8(*(const uint4*)(zr + sub), own);
      if (!ctxq) {
        unpack8(*(const uint4*)(zr + (sub ^ 16)), par);
        const int t = n * 128 + wave * 32 + rt * 16 + l15;
        const float* rp = p.rope + ((size_t)t * 32 + ks * 16 + (sub & 8)) * 2;
#pragma unroll
        for (int e = 0; e < 8; ++e) {
          const float cs = rp[e * 2], sn = rp[e * 2 + 1];
          o[e] = (sub < 16) ? (own[e] * cs - par[e] * sn) : (own[e] * cs + par[e] * sn);
        }
      } else {
#pragma unroll
        for (int e = 0; e < 8; ++e) o[e] = own[e];
      }
      uint4 pk;
      pk.x = pack2(o[0] * 0.125f, o[1] * 0.125f); pk.y = pack2(o[2] * 0.125f, o[3] * 0.125f);
      pk.z = pack2(o[4] * 0.125f, o[5] * 0.125f); pk.w = pack2(o[6] * 0.125f, o[7] * 0.125f);
      Q[rt][ks] = __builtin_bit_cast(bf16x8, pk);
    }
  const float sink = p.swa_sink[layer * 8 + hq];
  float mrun[2][4], lrun[2][4];
  f32x4 O[2][4];
#pragma unroll
  for (int rt = 0; rt < 2; ++rt) {
#pragma unroll
    for (int j = 0; j < 4; ++j) { mrun[rt][j] = sink; lrun[rt][j] = 1.f; }
#pragma unroll
    for (int dt = 0; dt < 4; ++dt) O[rt][dt] = f32x4{0.f, 0.f, 0.f, 0.f};
  }
  for (int kt = (ctxq ? 3 : 0); kt < 5; ++kt) {
    int krow0; bool latk = kt < 3; int nk = 0;
    if (latk) {
      nk = n + kt - 1;
      if (nk < 0 || nk > 15) continue;
      krow0 = b * TL + nk * 128;
    } else {
      krow0 = ctxrow0 + (kt - 3) * 128;
    }
    __syncthreads();
#pragma unroll 1
    for (int i = 0; i < 4; ++i) {
      const int c = tid + 256 * i, j = c >> 3, ch = c & 7;
      const u16* zr = p.z + (size_t)(krow0 + j) * ZW;
      {
        const uint4 ownv = *(const uint4*)(zr + ZSK + g * 64 + ch * 8);
        uint4 outv = ownv;
        if (latk) {
          float own[8], par[8], o[8];
          unpack8(ownv, own);
          unpack8(*(const uint4*)(zr + ZSK + g * 64 + (ch ^ 2) * 8), par);
          const int t = nk * 128 + j;
          const float* rp = p.rope + ((size_t)t * 32 + (ch >> 2) * 16 + (ch & 1) * 8) * 2;
#pragma unroll
          for (int e = 0; e < 8; ++e) {
            const float cs = rp[e * 2], sn = rp[e * 2 + 1];
            o[e] = ((ch & 2) == 0) ? (own[e] * cs - par[e] * sn) : (own[e] * cs + par[e] * sn);
          }
          outv.x = pack2(o[0], o[1]); outv.y = pack2(o[2], o[3]); outv.z = pack2(o[4], o[5]); outv.w = pack2(o[6], o[7]);
        }
        *(uint4*)(Ks + j * 72 + ch * 8) = outv;
      }
      {
        const uint4 vv = *(const uint4*)(zr + ZSV + g * 64 + ch * 8);
        u16* vt = Vt + (ch * 8) * 136 + j;
        vt[0 * 136] = (u16)(vv.x & 0xffff); vt[1 * 136] = (u16)(vv.x >> 16);
        vt[2 * 136] = (u16)(vv.y & 0xffff); vt[3 * 136] = (u16)(vv.y >> 16);
        vt[4 * 136] = (u16)(vv.z & 0xffff); vt[5 * 136] = (u16)(vv.z >> 16);
        vt[6 * 136] = (u16)(vv.w & 0xffff); vt[7 * 136] = (u16)(vv.w >> 16);
      }
    }
    __syncthreads();
    f32x4 S[2][8];
#pragma unroll
    for (int ct = 0; ct < 8; ++ct) {
      const bf16x8 k0 = *(const bf16x8*)(Ks + (ct * 16 + l15) * 72 + lq * 8);
      const bf16x8 k1 = *(const bf16x8*)(Ks + (ct * 16 + l15) * 72 + 32 + lq * 8);
#pragma unroll
      for (int rt = 0; rt < 2; ++rt) {
        f32x4 s = f32x4{0.f, 0.f, 0.f, 0.f};
        s = MFMA16(Q[rt][0], k0, s);
        s = MFMA16(Q[rt][1], k1, s);
        S[rt][ct] = s;
      }
    }
    if (kt == 0 || kt == 2) {
#pragma unroll
      for (int rt = 0; rt < 2; ++rt)
#pragma unroll
        for (int ct = 0; ct < 8; ++ct)
#pragma unroll
          for (int j = 0; j < 4; ++j) {
            const int qi = wave * 32 + rt * 16 + lq * 4 + j;
            const int kj = ct * 16 + l15;
            const bool valid = (kt == 0) ? (kj >= qi) : (kj <= qi);
            if (!valid) S[rt][ct][j] = -1e30f;
          }
    }
#pragma unroll
    for (int rt = 0; rt < 2; ++rt)
#pragma unroll
      for (int j = 0; j < 4; ++j) {
        float mx = S[rt][0][j];
#pragma unroll
        for (int ct = 1; ct < 8; ++ct) mx = fmaxf(mx, S[rt][ct][j]);
        mx = fmaxf(mx, __shfl_xor(mx, 1)); mx = fmaxf(mx, __shfl_xor(mx, 2));
        mx = fmaxf(mx, __shfl_xor(mx, 4)); mx = fmaxf(mx, __shfl_xor(mx, 8));
        const float mnew = fmaxf(mrun[rt][j], mx);
        const float alpha = __expf(mrun[rt][j] - mnew);
        mrun[rt][j] = mnew;
        float rs = 0.f;
#pragma unroll
        for (int ct = 0; ct < 8; ++ct) {
          const float pv = __expf(S[rt][ct][j] - mnew);
          S[rt][ct][j] = pv;
          rs += pv;
        }
        rs += __shfl_xor(rs, 1); rs += __shfl_xor(rs, 2); rs += __shfl_xor(rs, 4); rs += __shfl_xor(rs, 8);
        lrun[rt][j] = lrun[rt][j] * alpha + rs;
#pragma unroll
        for (int dt = 0; dt < 4; ++dt) O[rt][dt][j] *= alpha;
#pragma unroll
        for (int ct = 0; ct < 8; ++ct) Pw[(rt * 16 + lq * 4 + j) * 136 + ct * 16 + l15] = f2bf(S[rt][ct][j]);
      }
    __syncthreads();
#pragma unroll
    for (int kk = 0; kk < 4; ++kk) {
      bf16x8 pf[2], vf[4];
#pragma unroll
      for (int rt = 0; rt < 2; ++rt) pf[rt] = *(const bf16x8*)(Pw + (rt * 16 + l15) * 136 + kk * 32 + lq * 8);
#pragma unroll
      for (int dt = 0; dt < 4; ++dt) vf[dt] = *(const bf16x8*)(Vt + (dt * 16 + l15) * 136 + kk * 32 + lq * 8);
#pragma unroll
      for (int rt = 0; rt < 2; ++rt)
#pragma unroll
        for (int dt = 0; dt < 4; ++dt) O[rt][dt] = MFMA16(pf[rt], vf[dt], O[rt][dt]);
    }
  }
#pragma unroll
  for (int rt = 0; rt < 2; ++rt)
#pragma unroll
    for (int j = 0; j < 4; ++j) {
      const float inv = 1.f / lrun[rt][j];
      const int row = qrow0 + rt * 16 + lq * 4 + j;
#pragma unroll
      for (int dt = 0; dt < 4; ++dt) p.cat[(size_t)row * DM + 512 + hq * 64 + dt * 16 + l15] = f2bf(O[rt][dt][j] * inv);
    }
  __syncthreads();
}

DI void gmlp_item(const Params& p, int layer, int ci, char* smem) {
  const int tid = threadIdx.x, lane = tid & 63, wave = tid >> 6;
  const int l15 = lane & 15, lq = lane >> 4;
  u16* vT = (u16*)smem;
  float* rowss = (float*)(smem + 256 * 136 * 2);
  const int grow0 = ci * 128;
  const float* lng = p.gmlp_ln_g + layer * 256;
  const float* lnb = p.gmlp_ln_b + layer * 256;
  for (int i = 0; i < 32; ++i) {
    const int pr = wave * 32 + i;
    const u16* zr = p.z + (size_t)(grow0 + pr) * ZW + ZGV + lane * 4;
    const uint2 u = *(const uint2*)zr;
    float v[4];
    v[0] = gelu_f(__uint_as_float(u.x << 16)); v[1] = gelu_f(__uint_as_float(u.x & 0xffff0000u));
    v[2] = gelu_f(__uint_as_float(u.y << 16)); v[3] = gelu_f(__uint_as_float(u.y & 0xffff0000u));
    const float mean = wave_sum(v[0] + v[1] + v[2] + v[3]) * (1.f / 256.f);
    float q = 0.f;
#pragma unroll
    for (int e = 0; e < 4; ++e) { v[e] -= mean; q += v[e] * v[e]; }
    q = wave_sum(q) * (1.f / 256.f);
    const float rstd = rsqrtf(q + 1e-5f);
#pragma unroll
    for (int e = 0; e < 4; ++e) {
      const int c = lane * 4 + e;
      vT[c * 136 + pr] = f2bf(v[e] * rstd * lng[c] + lnb[c]);
    }
  }
  __syncthreads();
  const int g = wave;
  const float* ws = p.gmlp_ws + (size_t)(layer * 4 + g) * 128 * 128;
  const float* bs = p.gmlp_bs + (size_t)(layer * 4 + g) * 128;
  const float* og = p.gmlp_out_g + layer * 256;
  for (int half = 0; half < 2; ++half) {
    f32x4 acc[4][4];
#pragma unroll
    for (int rt = 0; rt < 4; ++rt)
#pragma unroll
      for (int ct = 0; ct < 4; ++ct) acc[rt][ct] = f32x4{0.f, 0.f, 0.f, 0.f};
#pragma unroll 1
    for (int ks = 0; ks < 4; ++ks) {
      bf16x8 vf[4];
#pragma unroll
      for (int ct = 0; ct < 4; ++ct) vf[ct] = *(const bf16x8*)(vT + (g * 64 + ct * 16 + l15) * 136 + ks * 32 + lq * 8);
#pragma unroll
      for (int rt = 0; rt < 4; ++rt) {
        const float* wr = ws + (size_t)(half * 64 + rt * 16 + l15) * 128 + ks * 32 + lq * 8;
        const float4 w0 = *(const float4*)wr, w1 = *(const float4*)(wr + 4);
        uint4 pk;
        pk.x = pack2(w0.x, w0.y); pk.y = pack2(w0.z, w0.w); pk.z = pack2(w1.x, w1.y); pk.w = pack2(w1.z, w1.w);
        const bf16x8 af = __builtin_bit_cast(bf16x8, pk);
#pragma unroll
        for (int ct = 0; ct < 4; ++ct) acc[rt][ct] = MFMA16(af, vf[ct], acc[rt][ct]);
      }
    }
#pragma unroll
    for (int rt = 0; rt < 4; ++rt)
#pragma unroll
      for (int j = 0; j < 4; ++j) {
        const int pr = half * 64 + rt * 16 + lq * 4 + j;
        const float bias = bs[pr];
        const u16* zr = p.z + (size_t)(grow0 + pr) * ZW + ZGU + g * 64 + l15;
        float ss = 0.f;
#pragma unroll
        for (int ct = 0; ct < 4; ++ct) {
          const float u = gelu_f(bf2f(zr[ct * 16]));
          const float val = u * (acc[rt][ct][j] + bias);
          acc[rt][ct][j] = val;
          ss += val * val;
        }
        ss += __shfl_xor(ss, 1); ss += __shfl_xor(ss, 2); ss += __shfl_xor(ss, 4); ss += __shfl_xor(ss, 8);
        if (l15 == 0) rowss[g * 128 + pr] = ss;
      }
    __syncthreads();
#pragma unroll
    for (int rt = 0; rt < 4; ++rt)
#pragma unroll
      for (int j = 0; j < 4; ++j) {
        const int pr = half * 64 + rt * 16 + lq * 4 + j;
        const float tot = rowss[pr] + rowss[128 + pr] + rowss[256 + pr] + rowss[384 + pr];
        const float rstd = rsqrtf(tot * (1.f / 256.f) + 1e-6f);
#pragma unroll
        for (int ct = 0; ct < 4; ++ct) {
          const int c = g * 64 + ct * 16 + l15;
          p.cat[(size_t)(grow0 + pr) * DM + 256 + c] = f2bf(acc[rt][ct][j] * rstd * og[c]);
        }
      }
  }
  __syncthreads();
}

DI int gla_row(int b, int c, int s) { return c < 4 ? (M_LAT + b * TC + c * 64 + s) : (b * TL + (c - 4) * 64 + s); }
DI int gla_slot(int c, int dir) { return dir == 0 ? c : (c < 4 ? 3 - c : 39 - c); }

DI void gla_cum(const Params& p, int layer, int b, int h, int c, int dir, float* cum) {
  const int tid = threadIdx.x, lane = tid & 63, wave = tid >> 6;
  {
    const int s = tid >> 2, d0 = (tid & 3) * 8;
    const u16* zr = p.z + (size_t)gla_row(b, c, s) * ZW + (dir ? ZGB : ZGF) + h * 32 + d0;
    float zf[8];
    unpack8(*(const uint4*)zr, zf);
    const float* ba = p.gla_ba + (size_t)(layer * 2 + dir) * 128 + h * 32 + d0;
#pragma unroll
    for (int e = 0; e < 8; ++e) cum[s * 32 + d0 + e] = logsigmoid_f(zf[e] + ba[e]) * (1.f / 16.f);
  }
  __syncthreads();
  {
    const int s = dir ? 63 - lane : lane;
#pragma unroll
    for (int dd = 0; dd < 8; ++dd) {
      const int d = wave * 8 + dd;
      float v = cum[s * 32 + d];
#pragma unroll
      for (int off = 1; off < 64; off <<= 1) {
        const float t = __shfl_up(v, off);
        if (lane >= off) v += t;
      }
      cum[s * 32 + d] = v;
    }
  }
  __syncthreads();
}

DI void gla_a_item(const Params& p, int layer, int item, char* smem) {
  const int tid = threadIdx.x;
  float* cum = (float*)smem;
  float* kt = cum + 2048;
  float* vs = kt + 2112;
  const int c = item % NSLOT, h = (item / NSLOT) & 3, b = item / (NSLOT * 4);
  for (int i = tid; i < 512; i += NT) {
    const int s = i >> 3, ch = i & 7;
    float f[8];
    unpack8(*(const uint4*)(p.z + (size_t)gla_row(b, c, s) * ZW + ZV + h * 64 + ch * 8), f);
#pragma unroll
    for (int e = 0; e < 8; ++e) vs[s * 64 + ch * 8 + e] = f[e];
  }
  for (int dir = 0; dir < 2; ++dir) {
    gla_cum(p, layer, b, h, c, dir, cum);
    const int send = dir ? 0 : 63;
    {
      const int s = tid >> 2, d0 = (tid & 3) * 8;
      float kf[8];
      unpack8(*(const uint4*)(p.z + (size_t)gla_row(b, c, s) * ZW + ZK + h * 32 + d0), kf);
#pragma unroll
      for (int e = 0; e < 8; ++e) kt[s * 33 + d0 + e] = kf[e] * __expf(cum[send * 32 + d0 + e] - cum[s * 32 + d0 + e]);
    }
    const size_t sidx = ((size_t)((b * 4 + h) * 2 + dir) * NSLOT + gla_slot(c, dir));
    if (tid < 32) p.Dd[sidx * 32 + tid] = __expf(cum[send * 32 + tid]);
    __syncthreads();
    {
      const int d = tid >> 3, e0 = (tid & 7) * 8;
      float acc[8];
#pragma unroll
      for (int e = 0; e < 8; ++e) acc[e] = 0.f;
      for (int s = 0; s < 64; ++s) {
        const float a = kt[s * 33 + d];
        const float4 v0 = *(const float4*)(vs + s * 64 + e0), v1 = *(const float4*)(vs + s * 64 + e0 + 4);
        acc[0] += a * v0.x; acc[1] += a * v0.y; acc[2] += a * v0.z; acc[3] += a * v0.w;
        acc[4] += a * v1.x; acc[5] += a * v1.y; acc[6] += a * v1.z; acc[7] += a * v1.w;
      }
      float* Lp = p.L + sidx * 2048 + d * 64 + e0;
      *(float4*)Lp = make_float4(acc[0], acc[1], acc[2], acc[3]);
      *(float4*)(Lp + 4) = make_float4(acc[4], acc[5], acc[6], acc[7]);
    }
    __syncthreads();
  }
}

DI void phase_gla_b(const Params& p) {
  const int total = NB * 4 * 2 * 2048;
  for (int idx = blockIdx.x * NT + threadIdx.x; idx < total; idx += gridDim.x * NT) {
    const int chain = idx >> 11, de = idx & 2047, d = de >> 6;
    float S = 0.f;
    float* Lp = p.L + (size_t)chain * NSLOT * 2048 + de;
    const float* Dp = p.Dd + (size_t)chain * NSLOT * 32 + d;
    for (int sl = 0; sl < NSLOT; ++sl) {
      const float loc = Lp[(size_t)sl * 2048];
      Lp[(size_t)sl * 2048] = S;
      S = Dp[sl * 32] * S + loc;
    }
  }
}

DI void gla_c_item(const Params& p, int layer, int item, char* smem) {
  const int tid = threadIdx.x;
  float* cum = (float*)smem;
  float* qt = cum + 2048;
  float* kt = qt + 2112;
  float* vs = kt + 2112;
  float* att = vs + 4096;
  float* Ss = att + 4160;
  const int c = item % NSLOT, h = (item / NSLOT) & 3, b = item / (NSLOT * 4);
  for (int i = tid; i < 512; i += NT) {
    const int s = i >> 3, ch = i & 7;
    float f[8];
    unpack8(*(const uint4*)(p.z + (size_t)gla_row(b, c, s) * ZW + ZV + h * 64 + ch * 8), f);
#pragma unroll
    for (int e = 0; e < 8; ++e) vs[s * 64 + ch * 8 + e] = f[e];
  }
  const int t = tid >> 2, sg = tid & 3, e0 = sg * 16;
  float o[16];
#pragma unroll
  for (int e = 0; e < 16; ++e) o[e] = 0.f;
  for (int dir = 0; dir < 2; ++dir) {
    gla_cum(p, layer, b, h, c, dir, cum);
    {
      const int s = tid >> 2, d0 = (tid & 3) * 8;
      const u16* zr = p.z + (size_t)gla_row(b, c, s) * ZW + h * 32 + d0;
      float qf[8], kf[8];
      unpack8(*(const uint4*)(zr + ZQ), qf);
      unpack8(*(const uint4*)(zr + ZK), kf);
#pragma unroll
      for (int e = 0; e < 8; ++e) {
        const float cv = cum[s * 32 + d0 + e];
        qt[s * 33 + d0 + e] = qf[e] * 0.17677669529663687f * __expf(cv);
        kt[s * 33 + d0 + e] = kf[e] * __expf(-cv);
      }
      const size_t sidx = ((size_t)((b * 4 + h) * 2 + dir) * NSLOT + gla_slot(c, dir));
      const float* Lp = p.L + sidx * 2048;
      *(float4*)(Ss + tid * 8) = *(const float4*)(Lp + tid * 8);
      *(float4*)(Ss + tid * 8 + 4) = *(const float4*)(Lp + tid * 8 + 4);
    }
    __syncthreads();
    {
      float qr[32];
#pragma unroll
      for (int d = 0; d < 32; ++d) qr[d] = qt[t * 33 + d];
#pragma unroll 1
      for (int i = 0; i < 16; ++i) {
        const int s = sg * 16 + i;
        float a = 0.f;
#pragma unroll
        for (int d = 0; d < 32; ++d) a += qr[d] * kt[s * 33 + d];
        const bool valid = dir ? (s >= t) : (s <= t);
        a = valid ? a : 0.f;
        if (dir == 0) att[t * 65 + s] = a; else att[t * 65 + s] += a;
      }
#pragma unroll 2
      for (int d = 0; d < 32; ++d) {
        const float a = qr[d];
        const float* sp = Ss + d * 64 + e0;
#pragma unroll
        for (int e = 0; e < 16; e += 4) {
          const float4 v = *(const float4*)(sp + e);
          o[e] += a * v.x; o[e + 1] += a * v.y; o[e + 2] += a * v.z; o[e + 3] += a * v.w;
        }
      }
    }
    __syncthreads();
  }
#pragma unroll 2
  for (int s = 0; s < 64; ++s) {
    const float a = att[t * 65 + s];
    const float* vp = vs + s * 64 + e0;
#pragma unroll
    for (int e = 0; e < 16; e += 4) {
      const float4 v = *(const float4*)(vp + e);
      o[e] += a * v.x; o[e + 1] += a * v.y; o[e + 2] += a * v.z; o[e + 3] += a * v.w;
    }
  }
  float ss = 0.f;
#pragma unroll
  for (int e = 0; e < 16; ++e) ss += o[e] * o[e];
  ss += __shfl_xor(ss, 1); ss += __shfl_xor(ss, 2);
  const float rstd = rsqrtf(ss * (1.f / 64.f) + 1e-6f);
  const int row = gla_row(b, c, t);
  const u16* ogp = p.z + (size_t)row * ZW + ZOG + h * 64 + e0;
  float og[16];
  unpack8(*(const uint4*)ogp, og);
  unpack8(*(const uint4*)(ogp + 8), og + 8);
  const float* gn = p.gla_norm + layer * 64 + e0;
  unsigned pk[8];
#pragma unroll
  for (int e = 0; e < 16; e += 2)
    pk[e >> 1] = pack2(o[e] * rstd * gn[e] * silu_f(og[e]), o[e + 1] * rstd * gn[e + 1] * silu_f(og[e + 1]));
  u16* cp = p.cat + (size_t)row * DM + h * 64 + e0;
  *(uint4*)cp = make_uint4(pk[0], pk[1], pk[2], pk[3]);
  *(uint4*)(cp + 8) = make_uint4(pk[4], pk[5], pk[6], pk[7]);
  __syncthreads();
}

DI void swa_norm_rows(const Params& p, int layer, int Mrows) {
  const int tid = threadIdx.x, lane = tid & 63, wave = tid >> 6;
  const float* g = p.swa_out_g + layer * 512 + lane * 8;
  for (int row = blockIdx.x * 4 + wave; row < Mrows; row += gridDim.x * 4) {
    u16* cp = p.cat + (size_t)row * DM + 512 + lane * 8;
    float f[8];
    unpack8(*(const uint4*)cp, f);
    float ss = 0.f;
#pragma unroll
    for (int e = 0; e < 8; ++e) ss += f[e] * f[e];
    ss = wave_sum(ss);
    const float rstd = rsqrtf(ss * (1.f / 512.f) + 1e-6f);
    uint4 o;
    o.x = pack2(f[0] * rstd * g[0], f[1] * rstd * g[1]); o.y = pack2(f[2] * rstd * g[2], f[3] * rstd * g[3]);
    o.z = pack2(f[4] * rstd * g[4], f[5] * rstd * g[5]); o.w = pack2(f[6] * rstd * g[6], f[7] * rstd * g[7]);
    *(uint4*)cp = o;
  }
}

DI void phase_mix_a(const Params& p, int layer, char* smem) {
  const bool need_ctx = layer == 0;
  const int n_swa = 2048, n_swac = need_ctx ? 256 : 0, n_gm = need_ctx ? 288 : 256, n_gla = NB * 4 * NSLOT;
  const int total = n_swa + n_swac + n_gm + n_gla;
  for (int item = blockIdx.x; item < total; item += gridDim.x) {
    int it = item;
    if (it < n_swa) { swa_item(p, layer, it, false, smem); continue; }
    it -= n_swa;
    if (it < n_swac) { swa_item(p, layer, it, true, smem); continue; }
    it -= n_swac;
    if (it < n_gm) { gmlp_item(p, layer, it, smem); continue; }
    it -= n_gm;
    gla_a_item(p, layer, it, smem);
  }
}

DI void phase_mix_c(const Params& p, int layer, char* smem) {
  const bool need_ctx = layer == 0;
  const int n_gla = NB * 4 * NSLOT;
  for (int item = blockIdx.x; item < n_gla; item += gridDim.x) {
    const int c = item % NSLOT;
    if (!need_ctx && c < 4) continue;
    gla_c_item(p, layer, item, smem);
  }
  swa_norm_rows(p, layer, need_ctx ? M_ALL : M_LAT);
}

constexpr int N_STEPS = 2 + 2 * 9;

DI void run_step(const Params& p, int step, char* smem) {
  if (step == 0) { phase_prep(p, smem); return; }
  if (step == 1) { phase_rows(p, 0, M_ALL, true, 0, 0, nullptr, true, 0, 0, p.n1_pre); return; }
  const int l = (step - 2) / 9, ph = (step - 2) % 9;
  const int Mo = l == 0 ? M_ALL : M_LAT;
  switch (ph) {
    case 0: phase_gemm<0>(p.h, p.WinT + (size_t)l * ZW * DM, M_ALL, ZW, DM, p.z, ZW, smem); break;
    case 1: phase_mix_a(p, l, smem); break;
    case 2: phase_gla_b(p); break;
    case 3: phase_mix_c(p, l, smem); break;
    case 4: phase_gemm<0>(p.cat, p.WoutT + (size_t)l * DM * DM, Mo, DM, DM, p.y, DM, smem); break;
    case 5: phase_rows(p, 1, Mo, l == 0, l, 2, p.n1_post + l * DM, true, l, 3, p.n2_pre + l * DM); break;
    case 6: phase_gemm<1>(p.h, p.WguT + (size_t)l * 2 * DFF * DM, Mo, 2 * DFF, DM, p.act, DFF, smem); break;
    case 7: phase_gemm<0>(p.act, p.WdT + (size_t)l * DM * DFF, Mo, DM, DFF, p.y, DM, smem); break;
    case 8: phase_rows(p, 1, Mo, false, l, 5, p.n2_post + l * DM, l == 0, l + 1, 0, p.n1_pre + (l + 1 < 2 ? l + 1 : 1) * DM); break;
  }
}

template <int S>
DI void run_one(const Params& p, int step_begin, int step_end, char* smem) {
  if (step_begin <= S && S < step_end) {
    run_step(p, S, smem);
    if (S + 1 < step_end) cg::this_grid().sync();
  }
}

__global__ void __launch_bounds__(NT, 2) fwd_kernel(Params p_unused, int step_begin, int step_end) {
  __shared__ __attribute__((aligned(16))) char smem[SMEM_BYTES];
  const Params& p = *(const Params*)__builtin_amdgcn_kernarg_segment_ptr();
  run_one<0>(p, step_begin, step_end, smem);  run_one<1>(p, step_begin, step_end, smem);
  run_one<2>(p, step_begin, step_end, smem);  run_one<3>(p, step_begin, step_end, smem);
  run_one<4>(p, step_begin, step_end, smem);  run_one<5>(p, step_begin, step_end, smem);
  run_one<6>(p, step_begin, step_end, smem);  run_one<7>(p, step_begin, step_end, smem);
  run_one<8>(p, step_begin, step_end, smem);  run_one<9>(p, step_begin, step_end, smem);
  run_one<10>(p, step_begin, step_end, smem); run_one<11>(p, step_begin, step_end, smem);
  run_one<12>(p, step_begin, step_end, smem); run_one<13>(p, step_begin, step_end, smem);
  run_one<14>(p, step_begin, step_end, smem); run_one<15>(p, step_begin, step_end, smem);
  run_one<16>(p, step_begin, step_end, smem); run_one<17>(p, step_begin, step_end, smem);
  run_one<18>(p, step_begin, step_end, smem); run_one<19>(p, step_begin, step_end, smem);
}

extern "C" void kernel_launch(void* const* d_in, const int* in_sizes, int n_in, void* d_out, int out_size, void* d_ws,
                              size_t ws_size, hipStream_t stream) {
  static int grid_blocks = 0;
  if (!grid_blocks) {
    int dev = 0, cus = 0, per_cu = 0;
    hipGetDevice(&dev);
    hipDeviceGetAttribute(&cus, hipDeviceAttributeMultiprocessorCount, dev);
    hipOccupancyMaxActiveBlocksPerMultiprocessor(&per_cu, fwd_kernel, NT, 0);
    if (per_cu < 1) per_cu = 1;
    if (per_cu > 2) per_cu = 2;
    grid_blocks = cus * per_cu;
  }
  Params p{};
  const float** fp = (const float**)&p;
  for (int i = 0; i < 24; ++i) fp[i] = (const float*)d_in[i];
  p.out = (float*)d_out;
  char* w = (char*)d_ws;
  size_t off = 0;
  auto take = [&](size_t bytes) { char* r = w + off; off += (bytes + 255) & ~(size_t)255; return r; };
  p.WinT = (u16*)take((size_t)2 * ZW * DM * 2);
  p.WoutT = (u16*)take((size_t)2 * DM * DM * 2);
  p.WguT = (u16*)take((size_t)2 * 2 * DFF * DM * 2);
  p.WdT = (u16*)take((size_t)2 * DM * DFF * 2);
  p.mod = (float*)take((size_t)2 * 17 * 6144 * 4);
  p.rope = (float*)take((size_t)TL * 32 * 2 * 4);
  p.h = (u16*)take((size_t)M_ALL * DM * 2);
  p.z = (u16*)take((size_t)M_ALL * ZW * 2);
  p.cat = (u16*)take((size_t)M_ALL * DM * 2);
  p.act = p.z;
  p.y = (u16*)take((size_t)M_ALL * DM * 2);
  p.xc = (float*)take((size_t)M_CTX * DM * 4);
  p.L = (float*)take((size_t)NB * 4 * 2 * NSLOT * 2048 * 4);
  p.Dd = (float*)take((size_t)NB * 4 * 2 * NSLOT * 32 * 4);
  if (off > ws_size) { fprintf(stderr, "workspace too small: need %zu have %zu\n", off, ws_size); return; }
#if MK_ONE_LAUNCH
  int sb = 0, se = N_STEPS;
  void* args[] = {&p, &sb, &se};
  hipError_t e = hipLaunchCooperativeKernel((void*)fwd_kernel, dim3(grid_blocks), dim3(NT), args, 0, stream);
  if (e != hipSuccess) fprintf(stderr, "cooperative launch failed: %s (grid %d)\n", hipGetErrorString(e), grid_blocks);
#else
  for (int s = 0; s < N_STEPS; ++s) fwd_kernel<<<grid_blocks, NT, 0, stream>>>(p, s, s + 1);
#endif
}
```

```cpp
#include <hip/hip_runtime.h>
#include <hip/hip_cooperative_groups.h>
#include <cstdio>
namespace cg = cooperative_groups;

#ifndef MK_ONE_LAUNCH
#define MK_ONE_LAUNCH 1
#endif

#define DI __device__ __forceinline__
typedef unsigned short u16;
using bf16x8 = __attribute__((ext_vector_type(8))) short;
using f32x4 = __attribute__((ext_vector_type(4))) float;
#define MFMA16(a, b, c) __builtin_amdgcn_mfma_f32_16x16x32_bf16((a), (b), (c), 0, 0, 0)

constexpr int NT = 256;
constexpr int DM = 1024;
constexpr int NB = 16;
constexpr int TL = 2048;
constexpr int TC = 256;
constexpr int M_LAT = NB * TL;
constexpr int M_CTX = NB * TC;
constexpr int M_ALL = M_LAT + M_CTX;
constexpr int ZW = 2304;
constexpr int IN_COLS = 2080;
constexpr int DFF = 2816;
constexpr int ZQ = 0, ZK = 128, ZV = 256, ZOG = 512, ZGU = 768, ZGV = 1024, ZSQ = 1280, ZSK = 1792, ZSV = 1920, ZGF = 2048, ZGB = 2176;
constexpr int NSLOT = 36;
constexpr int SMEM_BYTES = 73728;

struct Params {
  const float *x, *c, *ctx, *c_ctx, *mod_w, *mod_b, *n1_pre, *n1_post, *n2_pre, *n2_post, *w_in, *w_out,
      *gla_wa2, *gla_ba, *gla_norm, *gmlp_ln_g, *gmlp_ln_b, *gmlp_ws, *gmlp_bs, *gmlp_out_g, *swa_sink, *swa_out_g,
      *ffn_w_gu, *ffn_w_down;
  float* out;
  u16 *WinT, *WoutT, *WguT, *WdT;
  float *mod, *rope;
  u16 *h, *z, *cat, *y, *act;
  float *xc, *L, *Dd;
  unsigned* bar;
};

DI u16 f2bf(float f) { unsigned u = __float_as_uint(f); u += 0x7fffu + ((u >> 16) & 1u); return (u16)(u >> 16); }
DI float bf2f(u16 h) { return __uint_as_float(((unsigned)h) << 16); }
DI unsigned pack2(float a, float b) { return (unsigned)f2bf(a) | ((unsigned)f2bf(b) << 16); }
DI float wave_sum(float v) {
#pragma unroll
  for (int o = 32; o >= 1; o >>= 1) v += __shfl_xor(v, o);
  return v;
}
DI float silu_f(float x) { return x / (1.f + __expf(-x)); }
DI float gelu_f(float x) { return 0.5f * x * (1.f + erff(x * 0.70710678118654752f)); }
DI float logsigmoid_f(float z) { return fminf(z, 0.f) - log1pf(__expf(-fabsf(z))); }
DI void unpack8(const uint4& v, float* f) {
  f[0] = __uint_as_float(v.x << 16); f[1] = __uint_as_float(v.x & 0xffff0000u);
  f[2] = __uint_as_float(v.y << 16); f[3] = __uint_as_float(v.y & 0xffff0000u);
  f[4] = __uint_as_float(v.z << 16); f[5] = __uint_as_float(v.z & 0xffff0000u);
  f[6] = __uint_as_float(v.w << 16); f[7] = __uint_as_float(v.w & 0xffff0000u);
}

DI int colmap_win(int n) { return n < 768 ? n : n + 32; }
DI int colmap_gu(int n) { int blk = n >> 4, w = n & 15; return (blk >> 1) * 16 + w + ((blk & 1) ? DFF : 0); }

template <int CM>
DI void transpose_tile(const float* __restrict__ src, int ld_src, int k0, int n0, u16* __restrict__ dst, int K, float* tile) {
  const int tid = threadIdx.x;
  {
    const int j = tid & 63, i0 = tid >> 6;
    const int n = n0 + j;
    const int col = CM == 1 ? colmap_win(n) : (CM == 2 ? colmap_gu(n) : n);
#pragma unroll
    for (int ii = 0; ii < 16; ++ii) {
      const int k = i0 + 4 * ii;
      tile[k * 65 + j] = src[(size_t)(k0 + k) * ld_src + col];
    }
  }
  __syncthreads();
  {
    const int kk = tid & 63, nn0 = tid >> 6;
#pragma unroll
    for (int ii = 0; ii < 16; ++ii) {
      const int n = nn0 + 4 * ii;
      dst[(size_t)(n0 + n) * K + k0 + kk] = f2bf(tile[kk * 65 + n]);
    }
  }
  __syncthreads();
}

DI void phase_prep(const Params& p, char* smem) {
  float* sf = (float*)smem;
  const int tid = threadIdx.x, lane = tid & 63, wave = tid >> 6;
  constexpr int N_TR_L = 512 + 256 + 1408 + 704;
  constexpr int N_TR = 2 * N_TR_L;
  constexpr int N_FOLD = 64, N_MOD = 192, N_ROPE = 256;
  constexpr int N_ALL = N_TR + N_FOLD + N_MOD + N_ROPE;
  for (int item = blockIdx.x; item < N_ALL; item += gridDim.x) {
    if (item < N_TR) {
      const int l = item / N_TR_L;
      int r = item - l * N_TR_L;
      if (r < 512) {
        transpose_tile<1>(p.w_in + (size_t)l * DM * IN_COLS, IN_COLS, (r >> 5) * 64, (r & 31) * 64, p.WinT + (size_t)l * ZW * DM, DM, sf);
      } else if (r < 768) {
        r -= 512;
        transpose_tile<0>(p.w_out + (size_t)l * DM * DM, DM, (r >> 4) * 64, (r & 15) * 64, p.WoutT + (size_t)l * DM * DM, DM, sf);
      } else if (r < 2176) {
        r -= 768;
        transpose_tile<2>(p.ffn_w_gu + (size_t)l * DM * 2 * DFF, 2 * DFF, (r / 88) * 64, (r % 88) * 64, p.WguT + (size_t)l * 2 * DFF * DM, DM, sf);
      } else {
        r -= 2176;
        transpose_tile<0>(p.ffn_w_down + (size_t)l * DFF * DM, DM, (r >> 4) * 64, (r & 15) * 64, p.WdT + (size_t)l * DM * DFF, DFF, sf);
      }
    } else if (item < N_TR + N_FOLD) {
      const int idx = item - N_TR;
      const int l = idx >> 5, dir = (idx >> 4) & 1, k0 = (idx & 15) * 64;
      float* wa = sf;
      float* cd = sf + 2048;
      const float* wa2 = p.gla_wa2 + (size_t)(l * 2 + dir) * 16 * 128;
      for (int i = tid; i < 2048; i += NT) wa[i] = wa2[i];
      for (int i = tid; i < 1024; i += NT) {
        const int kk = i >> 4, r = i & 15;
        cd[kk * 17 + r] = p.w_in[(size_t)l * DM * IN_COLS + (size_t)(k0 + kk) * IN_COLS + 768 + dir * 16 + r];
      }
      __syncthreads();
      const int kk = tid & 63, jg = tid >> 6;
      u16* dst = p.WinT + (size_t)l * ZW * DM;
      for (int jj = 0; jj < 32; ++jj) {
        const int j = jg * 32 + jj;
        float s = 0.f;
#pragma unroll
        for (int r = 0; r < 16; ++r) s += cd[kk * 17 + r] * wa[r * 128 + j];
        dst[(size_t)(ZGF + dir * 128 + j) * DM + k0 + kk] = f2bf(s);
      }
      __syncthreads();
    } else if (item < N_TR + N_FOLD + N_MOD) {
      const int cgi = item - N_TR - N_FOLD;
      const int gc = cgi * 64 + lane;
      const int l = gc / 6144, n = gc - l * 6144;
      for (int i = tid; i < 17 * 1024; i += NT) {
        const float v = i < 16 * 1024 ? p.c[i] : p.c_ctx[i - 16 * 1024];
        sf[i] = silu_f(v);
      }
      __syncthreads();
      float acc[17];
#pragma unroll
      for (int r = 0; r < 17; ++r) acc[r] = 0.f;
      const float* W = p.mod_w + (size_t)l * DM * 6144 + n;
      const int kb = wave * 256;
#pragma unroll 4
      for (int k = kb; k < kb + 256; ++k) {
        const float wv = W[(size_t)k * 6144];
#pragma unroll
        for (int r = 0; r < 17; ++r) acc[r] += sf[r * 1024 + k] * wv;
      }
      __syncthreads();
#pragma unroll
      for (int r = 0; r < 17; ++r) sf[(wave * 17 + r) * 64 + lane] = acc[r];
      __syncthreads();
      for (int o = tid; o < 17 * 64; o += NT) {
        const int r = o >> 6, ln = o & 63;
        const float s = sf[(0 * 17 + r) * 64 + ln] + sf[(1 * 17 + r) * 64 + ln] + sf[(2 * 17 + r) * 64 + ln] + sf[(3 * 17 + r) * 64 + ln];
        const int nn = cgi * 64 + ln - l * 6144;
        p.mod[(size_t)(l * 17 + r) * 6144 + nn] = s + p.mod_b[l * 6144 + nn];
      }
      __syncthreads();
    } else {
      const int idx = item - N_TR - N_FOLD - N_MOD;
      const int e = idx * 256 + tid;
      const int t = e >> 5, f = e & 31;
      const int fi = f & 15;
      const float inv = powf(10000.f, -(float)(2 * fi) / 32.f);
      const float pos = f < 16 ? (float)(t >> 6) : (float)(t & 63);
      const float ang = pos * inv;
      p.rope[e * 2 + 0] = cosf(ang);
      p.rope[e * 2 + 1] = sinf(ang);
    }
  }
}

DI void phase_rows(const Params& p, int mode, int Mrows, bool first_layer_input, int l_in, int gate_idx, const float* gpost,
                   bool write_h, int l_out, int sh_idx, const float* gpre) {
  const int tid = threadIdx.x, lane = tid & 63, wave = tid >> 6;
  for (int row = blockIdx.x * 4 + wave; row < Mrows; row += gridDim.x * 4) {
    const bool lat = row < M_LAT;
    const int mrow = lat ? (row >> 11) : 16;
    const float* xin;
    float* xout;
    if (lat) {
      xin = (first_layer_input ? p.x : p.out) + (size_t)row * DM;
      xout = p.out + (size_t)row * DM;
    } else {
      xin = (first_layer_input ? p.ctx : p.xc) + (size_t)(row - M_LAT) * DM;
      xout = p.xc + (size_t)(row - M_LAT) * DM;
    }
    float4 xv[4];
#pragma unroll
    for (int i = 0; i < 4; ++i) xv[i] = *(const float4*)(xin + lane * 4 + 256 * i);
    if (mode == 1) {
      const u16* yr = p.y + (size_t)row * DM;
      float4 yv[4];
      float ss = 0.f;
#pragma unroll
      for (int i = 0; i < 4; ++i) {
        const uint2 u = *(const uint2*)(yr + lane * 4 + 256 * i);
        yv[i].x = __uint_as_float(u.x << 16); yv[i].y = __uint_as_float(u.x & 0xffff0000u);
        yv[i].z = __uint_as_float(u.y << 16); yv[i].w = __uint_as_float(u.y & 0xffff0000u);
        ss += yv[i].x * yv[i].x + yv[i].y * yv[i].y + yv[i].z * yv[i].z + yv[i].w * yv[i].w;
      }
      ss = wave_sum(ss);
      const float rstd = rsqrtf(ss * (1.f / DM) + 1e-6f);
      const float* gate = p.mod + (size_t)(l_in * 17 + mrow) * 6144 + gate_idx * 1024;
#pragma unroll
      for (int i = 0; i < 4; ++i) {
        const int c0 = lane * 4 + 256 * i;
        const float4 g = *(const float4*)(gpost + c0);
        const float4 gt = *(const float4*)(gate + c0);
        xv[i].x += gt.x * (yv[i].x * rstd * g.x);
        xv[i].y += gt.y * (yv[i].y * rstd * g.y);
        xv[i].z += gt.z * (yv[i].z * rstd * g.z);
        xv[i].w += gt.w * (yv[i].w * rstd * g.w);
        *(float4*)(xout + c0) = xv[i];
      }
    }
    if (write_h) {
      float ss = 0.f;
#pragma unroll
      for (int i = 0; i < 4; ++i) ss += xv[i].x * xv[i].x + xv[i].y * xv[i].y + xv[i].z * xv[i].z + xv[i].w * xv[i].w;
      ss = wave_sum(ss);
      const float rstd = rsqrtf(ss * (1.f / DM) + 1e-6f);
      const float* sh = p.mod + (size_t)(l_out * 17 + mrow) * 6144 + sh_idx * 1024;
      const float* sc = sh + 1024;
      u16* hr = p.h + (size_t)row * DM;
#pragma unroll
      for (int i = 0; i < 4; ++i) {
        const int c0 = lane * 4 + 256 * i;
        const float4 g = *(const float4*)(gpre + c0);
        const float4 a = *(const float4*)(sh + c0);
        const float4 s = *(const float4*)(sc + c0);
        uint2 o;
        o.x = pack2(xv[i].x * rstd * g.x * (1.f + s.x) + a.x, xv[i].y * rstd * g.y * (1.f + s.y) + a.y);
        o.y = pack2(xv[i].z * rstd * g.z * (1.f + s.z) + a.z, xv[i].w * rstd * g.w * (1.f + s.w) + a.w);
        *(uint2*)(hr + c0) = o;
      }
    }
  }
}

template <int EPI>
DI void phase_gemm(const u16* __restrict__ A, const u16* __restrict__ Bt, int M, int N, int K, u16* __restrict__ C, int ldc, char* smem) {
  const int tid = threadIdx.x, lane = tid & 63, wave = tid >> 6;
  const int wm = wave >> 1, wn = wave & 1;
  const int l15 = lane & 15, lq = lane >> 4;
  constexpr int LDS_ROW = 72;
  u16* sA = (u16*)smem;
  u16* sB = sA + 2 * 128 * LDS_ROW;
  const int tiles_n = N >> 7;
  const int ntiles = (M >> 7) * tiles_n;
  const int nk = K >> 6;
  for (int tile = blockIdx.x; tile < ntiles; tile += gridDim.x) {
    const int tm = tile / tiles_n, tn = tile - tm * tiles_n;
    const u16* Ag = A + (size_t)(tm * 128) * K;
    const u16* Bg = Bt + (size_t)(tn * 128) * K;
    uint4 ra[4], rb[4];
#pragma unroll
    for (int i = 0; i < 4; ++i) {
      const int c = tid + 256 * i, r = c >> 3, kc = c & 7;
      ra[i] = *(const uint4*)(Ag + (size_t)r * K + kc * 8);
      rb[i] = *(const uint4*)(Bg + (size_t)r * K + kc * 8);
    }
#pragma unroll
    for (int i = 0; i < 4; ++i) {
      const int c = tid + 256 * i, r = c >> 3, kc = c & 7;
      *(uint4*)(sA + r * LDS_ROW + kc * 8) = ra[i];
      *(uint4*)(sB + r * LDS_ROW + kc * 8) = rb[i];
    }
    __syncthreads();
    f32x4 acc[4][4];
#pragma unroll
    for (int i = 0; i < 4; ++i)
#pragma unroll
      for (int j = 0; j < 4; ++j) acc[i][j] = f32x4{0.f, 0.f, 0.f, 0.f};
    for (int kt = 0; kt < nk; ++kt) {
      const bool more = kt + 1 < nk;
      if (more) {
        const int ko = (kt + 1) * 64;
#pragma unroll
        for (int i = 0; i < 4; ++i) {
          const int c = tid + 256 * i, r = c >> 3, kc = c & 7;
          ra[i] = *(const uint4*)(Ag + (size_t)r * K + ko + kc * 8);
          rb[i] = *(const uint4*)(Bg + (size_t)r * K + ko + kc * 8);
        }
      }
      const u16* a_s = sA + (kt & 1) * 128 * LDS_ROW + (wm * 64 + l15) * LDS_ROW + lq * 8;
      const u16* b_s = sB + (kt & 1) * 128 * LDS_ROW + (wn * 64 + l15) * LDS_ROW + lq * 8;
#pragma unroll
      for (int ks = 0; ks < 2; ++ks) {
        bf16x8 af[4], bfr[4];
#pragma unroll
        for (int i = 0; i < 4; ++i) af[i] = *(const bf16x8*)(a_s + i * 16 * LDS_ROW + ks * 32);
#pragma unroll
        for (int j = 0; j < 4; ++j) bfr[j] = *(const bf16x8*)(b_s + j * 16 * LDS_ROW + ks * 32);
#pragma unroll
        for (int i = 0; i < 4; ++i)
#pragma unroll
          for (int j = 0; j < 4; ++j) acc[i][j] = MFMA16(af[i], bfr[j], acc[i][j]);
      }
      if (more) {
        u16* dA = sA + ((kt + 1) & 1) * 128 * LDS_ROW;
        u16* dB = sB + ((kt + 1) & 1) * 128 * LDS_ROW;
#pragma unroll
        for (int i = 0; i < 4; ++i) {
          const int c = tid + 256 * i, r = c >> 3, kc = c & 7;
          *(uint4*)(dA + r * LDS_ROW + kc * 8) = ra[i];
          *(uint4*)(dB + r * LDS_ROW + kc * 8) = rb[i];
        }
      }
      __syncthreads();
    }
    const int row0 = tm * 128 + wm * 64 + lq * 4;
    if (EPI == 0) {
      const int col0 = tn * 128 + wn * 64 + l15;
#pragma unroll
      for (int i = 0; i < 4; ++i)
#pragma unroll
        for (int j = 0; j < 4; ++j)
#pragma unroll
          for (int r = 0; r < 4; ++r)
            C[(size_t)(row0 + i * 16 + r) * ldc + col0 + j * 16] = f2bf(acc[i][j][r]);
    } else {
      const int col0 = tn * 64 + wn * 32 + l15;
#pragma unroll
      for (int i = 0; i < 4; ++i)
#pragma unroll
        for (int jj = 0; jj < 2; ++jj)
#pragma unroll
          for (int r = 0; r < 4; ++r) {
            const float g = acc[i][2 * jj][r], u = acc[i][2 * jj + 1][r];
            C[(size_t)(row0 + i * 16 + r) * ldc + col0 + jj * 16] = f2bf(silu_f(g) * u);
          }
    }
  }
}

DI void swa_item(const Params& p, int layer, int item, bool ctxq, char* smem) {
  const int tid = threadIdx.x, lane = tid & 63, wave = tid >> 6;
  const int l15 = lane & 15, lq = lane >> 4;
  u16* Ks = (u16*)smem;
  u16* Vt = Ks + 128 * 72;
  u16* Ps = Vt + 64 * 136;
  u16* Pw = Ps + wave * 32 * 136;
  const int hq = item & 7;
  const int g = hq >> 2;
  int b, n;
  if (!ctxq) { n = (item >> 3) & 15; b = item >> 7; } else { n = (item >> 3) & 1; b = item >> 4; }
  const int qrow0 = (ctxq ? (M_LAT + b * TC + n * 128) : (b * TL + n * 128)) + wave * 32;
  const int ctxrow0 = M_LAT + b * TC;
  bf16x8 Q[2][2];
#pragma unroll
  for (int rt = 0; rt < 2; ++rt)
#pragma unroll
    for (int ks = 0; ks < 2; ++ks) {
      const int row = qrow0 + rt * 16 + l15;
      const int sub = lq * 8;
      const u16* zr = p.z + (size_t)row * ZW + ZSQ + hq * 64 + ks * 32;
      float own[8], par[8], o[8];
      unpack8(*(const uint4*)(zr + sub), own);
      if (!ctxq) {
        unpack8(*(const uint4*)(zr + (sub ^ 16)), par);
        const int t = n * 128 + wave * 32 + rt * 16 + l15;
        const float* rp = p.rope + ((size_t)t * 32 + ks * 16 + (sub & 8)) * 2;
#pragma unroll
        for (int e = 0; e < 8; ++e) {
          const float cs = rp[e * 2], sn = rp[e * 2 + 1];
          o[e] = (sub < 16) ? (own[e] * cs - par[e] * sn) : (own[e] * cs + par[e] * sn);
        }
      } else {
#pragma unroll
        for (int e = 0; e < 8; ++e) o[e] = own[e];
      }
      uint4 pk;
      pk.x = pack2(o[0] * 0.125f, o[1] * 0.125f); pk.y = pack2(o[2] * 0.125f, o[3] * 0.125f);
      pk.z = pack2(o[4] * 0.125f, o[5] * 0.125f); pk.w = pack2(o[6] * 0.125f, o[7] * 0.125f);
      Q[rt][ks] = __builtin_bit_cast(bf16x8, pk);
    }
  const float sink = p.swa_sink[layer * 8 + hq];
  float mrun[2][4], lrun[2][4];
  f32x4 O[2][4];
#pragma unroll
  for (int rt = 0; rt < 2; ++rt) {
#pragma unroll
    for (int j = 0; j < 4; ++j) { mrun[rt][j] = sink; lrun[rt][j] = 1.f; }
#pragma unroll
    for (int dt = 0; dt < 4; ++dt) O[rt][dt] = f32x4{0.f, 0.f, 0.f, 0.f};
  }
  for (int kt = (ctxq ? 3 : 0); kt < 5; ++kt) {
    int krow0; bool latk = kt < 3; int nk = 0;
    if (latk) {
      nk = n + kt - 1;
      if (nk < 0 || nk > 15) continue;
      krow0 = b * TL + nk * 128;
    } else {
      krow0 = ctxrow0 + (kt - 3) * 128;
    }
    __syncthreads();
#pragma unroll 1
    for (int i = 0; i < 4; ++i) {
      const int c = tid + 256 * i, j = c >> 3, ch = c & 7;
      const u16* zr = p.z + (size_t)(krow0 + j) * ZW;
      {
        const uint4 ownv = *(const uint4*)(zr + ZSK + g * 64 + ch * 8);
        uint4 outv = ownv;
        if (latk) {
          float own[8], par[8], o[8];
          unpack8(ownv, own);
          unpack8(*(const uint4*)(zr + ZSK + g * 64 + (ch ^ 2) * 8), par);
          const int t = nk * 128 + j;
          const float* rp = p.rope + ((size_t)t * 32 + (ch >> 2) * 16 + (ch & 1) * 8) * 2;
#pragma unroll
          for (int e = 0; e < 8; ++e) {
            const float cs = rp[e * 2], sn = rp[e * 2 + 1];
            o[e] = ((ch & 2) == 0) ? (own[e] * cs - par[e] * sn) : (own[e] * cs + par[e] * sn);
          }
          outv.x = pack2(o[0], o[1]); outv.y = pack2(o[2], o[3]); outv.z = pack2(o[4], o[5]); outv.w = pack2(o[6], o[7]);
        }
        *(uint4*)(Ks + j * 72 + ch * 8) = outv;
      }
      {
        const uint4 vv = *(const uint4*)(zr + ZSV + g * 64 + ch * 8);
        u16* vt = Vt + (ch * 8) * 136 + j;
        vt[0 * 136] = (u16)(vv.x & 0xffff); vt[1 * 136] = (u16)(vv.x >> 16);
        vt[2 * 136] = (u16)(vv.y & 0xffff); vt[3 * 136] = (u16)(vv.y >> 16);
        vt[4 * 136] = (u16)(vv.z & 0xffff); vt[5 * 136] = (u16)(vv.z >> 16);
        vt[6 * 136] = (u16)(vv.w & 0xffff); vt[7 * 136] = (u16)(vv.w >> 16);
      }
    }
    __syncthreads();
    f32x4 S[2][8];
#pragma unroll
    for (int ct = 0; ct < 8; ++ct) {
      const bf16x8 k0 = *(const bf16x8*)(Ks + (ct * 16 + l15) * 72 + lq * 8);
      const bf16x8 k1 = *(const bf16x8*)(Ks + (ct * 16 + l15) * 72 + 32 + lq * 8);
#pragma unroll
      for (int rt = 0; rt < 2; ++rt) {
        f32x4 s = f32x4{0.f, 0.f, 0.f, 0.f};
        s = MFMA16(Q[rt][0], k0, s);
        s = MFMA16(Q[rt][1], k1, s);
        S[rt][ct] = s;
      }
    }
    if (kt == 0 || kt == 2) {
#pragma unroll
      for (int rt = 0; rt < 2; ++rt)
#pragma unroll
        for (int ct = 0; ct < 8; ++ct)
#pragma unroll
          for (int j = 0; j < 4; ++j) {
            const int qi = wave * 32 + rt * 16 + lq * 4 + j;
            const int kj = ct * 16 + l15;
            const bool valid = (kt == 0) ? (kj >= qi) : (kj <= qi);
            if (!valid) S[rt][ct][j] = -1e30f;
          }
    }
#pragma unroll
    for (int rt = 0; rt < 2; ++rt)
#pragma unroll
      for (int j = 0; j < 4; ++j) {
        float mx = S[rt][0][j];
#pragma unroll
        for (int ct = 1; ct < 8; ++ct) mx = fmaxf(mx, S[rt][ct][j]);
        mx = fmaxf(mx, __shfl_xor(mx, 1)); mx = fmaxf(mx, __shfl_xor(mx, 2));
        mx = fmaxf(mx, __shfl_xor(mx, 4)); mx = fmaxf(mx, __shfl_xor(mx, 8));
        const float mnew = fmaxf(mrun[rt][j], mx);
        const float alpha = __expf(mrun[rt][j] - mnew);
        mrun[rt][j] = mnew;
        float rs = 0.f;
#pragma unroll
        for (int ct = 0; ct < 8; ++ct) {
          const float pv = __expf(S[rt][ct][j] - mnew);
          S[rt][ct][j] = pv;
          rs += pv;
        }
        rs += __shfl_xor(rs, 1); rs += __shfl_xor(rs, 2); rs += __shfl_xor(rs, 4); rs += __shfl_xor(rs, 8);
        lrun[rt][j] = lrun[rt][j] * alpha + rs;
#pragma unroll
        for (int dt = 0; dt < 4; ++dt) O[rt][dt][j] *= alpha;
#pragma unroll
        for (int ct = 0; ct < 8; ++ct) Pw[(rt * 16 + lq * 4 + j) * 136 + ct * 16 + l15] = f2bf(S[rt][ct][j]);
      }
    __syncthreads();
#pragma unroll
    for (int kk = 0; kk < 4; ++kk) {
      bf16x8 pf[2], vf[4];
#pragma unroll
      for (int rt = 0; rt < 2; ++rt) pf[rt] = *(const bf16x8*)(Pw + (rt * 16 + l15) * 136 + kk * 32 + lq * 8);
#pragma unroll
      for (int dt = 0; dt < 4; ++dt) vf[dt] = *(const bf16x8*)(Vt + (dt * 16 + l15) * 136 + kk * 32 + lq * 8);
#pragma unroll
      for (int rt = 0; rt < 2; ++rt)
#pragma unroll
        for (int dt = 0; dt < 4; ++dt) O[rt][dt] = MFMA16(pf[rt], vf[dt], O[rt][dt]);
    }
  }
#pragma unroll
  for (int rt = 0; rt < 2; ++rt)
#pragma unroll
    for (int j = 0; j < 4; ++j) {
      const float inv = 1.f / lrun[rt][j];
      const int row = qrow0 + rt * 16 + lq * 4 + j;
#pragma unroll
      for (int dt = 0; dt < 4; ++dt) p.cat[(size_t)row * DM + 512 + hq * 64 + dt * 16 + l15] = f2bf(O[rt][dt][j] * inv);
    }
  __syncthreads();
}

DI void gmlp_item(const Params& p, int layer, int ci, char* smem) {
  const int tid = threadIdx.x, lane = tid & 63, wave = tid >> 6;
  const int l15 = lane & 15, lq = lane >> 4;
  u16* vT = (u16*)smem;
  float* rowss = (float*)(smem + 256 * 136 * 2);
  const int grow0 = ci * 128;
  const float* lng = p.gmlp_ln_g + layer * 256;
  const float* lnb = p.gmlp_ln_b + layer * 256;
  for (int i = 0; i < 32; ++i) {
    const int pr = wave * 32 + i;
    const u16* zr = p.z + (size_t)(grow0 + pr) * ZW + ZGV + lane * 4;
    const uint2 u = *(const uint2*)zr;
    float v[4];
    v[0] = gelu_f(__uint_as_float(u.x << 16)); v[1] = gelu_f(__uint_as_float(u.x & 0xffff0000u));
    v[2] = gelu_f(__uint_as_float(u.y << 16)); v[3] = gelu_f(__uint_as_float(u.y & 0xffff0000u));
    const float mean = wave_sum(v[0] + v[1] + v[2] + v[3]) * (1.f / 256.f);
    float q = 0.f;
#pragma unroll
    for (int e = 0; e < 4; ++e) { v[e] -= mean; q += v[e] * v[e]; }
    q = wave_sum(q) * (1.f / 256.f);
    const float rstd = rsqrtf(q + 1e-5f);
#pragma unroll
    for (int e = 0; e < 4; ++e) {
      const int c = lane * 4 + e;
      vT[c * 136 + pr] = f2bf(v[e] * rstd * lng[c] + lnb[c]);
    }
  }
  __syncthreads();
  const int g = wave;
  const float* ws = p.gmlp_ws + (size_t)(layer * 4 + g) * 128 * 128;
  const float* bs = p.gmlp_bs + (size_t)(layer * 4 + g) * 128;
  const float* og = p.gmlp_out_g + layer * 256;
  for (int half = 0; half < 2; ++half) {
    f32x4 acc[4][4];
#pragma unroll
    for (int rt = 0; rt < 4; ++rt)
#pragma unroll
      for (int ct = 0; ct < 4; ++ct) acc[rt][ct] = f32x4{0.f, 0.f, 0.f, 0.f};
#pragma unroll 1
    for (int ks = 0; ks < 4; ++ks) {
      bf16x8 vf[4];
#pragma unroll
      for (int ct = 0; ct < 4; ++ct) vf[ct] = *(const bf16x8*)(vT + (g * 64 + ct * 16 + l15) * 136 + ks * 32 + lq * 8);
#pragma unroll
      for (int rt = 0; rt < 4; ++rt) {
        const float* wr = ws + (size_t)(half * 64 + rt * 16 + l15) * 128 + ks * 32 + lq * 8;
        const float4 w0 = *(const float4*)wr, w1 = *(const float4*)(wr + 4);
        uint4 pk;
        pk.x = pack2(w0.x, w0.y); pk.y = pack2(w0.z, w0.w); pk.z = pack2(w1.x, w1.y); pk.w = pack2(w1.z, w1.w);
        const bf16x8 af = __builtin_bit_cast(bf16x8, pk);
#pragma unroll
        for (int ct = 0; ct < 4; ++ct) acc[rt][ct] = MFMA16(af, vf[ct], acc[rt][ct]);
      }
    }
#pragma unroll
    for (int rt = 0; rt < 4; ++rt)
#pragma unroll
      for (int j = 0; j < 4; ++j) {
        const int pr = half * 64 + rt * 16 + lq * 4 + j;
        const float bias = bs[pr];
        const u16* zr = p.z + (size_t)(grow0 + pr) * ZW + ZGU + g * 64 + l15;
        float ss = 0.f;
#pragma unroll
        for (int ct = 0; ct < 4; ++ct) {
          const float u = gelu_f(bf2f(zr[ct * 16]));
          const float val = u * (acc[rt][ct][j] + bias);
          acc[rt][ct][j] = val;
          ss += val * val;
        }
        ss += __shfl_xor(ss, 1); ss += __shfl_xor(ss, 2); ss += __shfl_xor(ss, 4); ss += __shfl_xor(ss, 8);
        if (l15 == 0) rowss[g * 128 + pr] = ss;
      }
    __syncthreads();
#pragma unroll
    for (int rt = 0; rt < 4; ++rt)
#pragma unroll
      for (int j = 0; j < 4; ++j) {
        const int pr = half * 64 + rt * 16 + lq * 4 + j;
        const float tot = rowss[pr] + rowss[128 + pr] + rowss[256 + pr] + rowss[384 + pr];
        const float rstd = rsqrtf(tot * (1.f / 256.f) + 1e-6f);
#pragma unroll
        for (int ct = 0; ct < 4; ++ct) {
          const int c = g * 64 + ct * 16 + l15;
          p.cat[(size_t)(grow0 + pr) * DM + 256 + c] = f2bf(acc[rt][ct][j] * rstd * og[c]);
        }
      }
  }
  __syncthreads();
}

DI int gla_row(int b, int c, int s) { return c < 4 ? (M_LAT + b * TC + c * 64 + s) : (b * TL + (c - 4) * 64 + s); }
DI int gla_slot(int c, int dir) { return dir == 0 ? c : (c < 4 ? 3 - c : 39 - c); }

DI void gla_cum(const Params& p, int layer, int b, int h, int c, int dir, float* cum) {
  const int tid = threadIdx.x, lane = tid & 63, wave = tid >> 6;
  {
    const int s = tid >> 2, d0 = (tid & 3) * 8;
    const u16* zr = p.z + (size_t)gla_row(b, c, s) * ZW + (dir ? ZGB : ZGF) + h * 32 + d0;
    float zf[8];
    unpack8(*(const uint4*)zr, zf);
    const float* ba = p.gla_ba + (size_t)(layer * 2 + dir) * 128 + h * 32 + d0;
#pragma unroll
    for (int e = 0; e < 8; ++e) cum[s * 32 + d0 + e] = logsigmoid_f(zf[e] + ba[e]) * (1.f / 16.f);
  }
  __syncthreads();
  {
    const int s = dir ? 63 - lane : lane;
#pragma unroll
    for (int dd = 0; dd < 8; ++dd) {
      const int d = wave * 8 + dd;
      float v = cum[s * 32 + d];
#pragma unroll
      for (int off = 1; off < 64; off <<= 1) {
        const float t = __shfl_up(v, off);
        if (lane >= off) v += t;
      }
      cum[s * 32 + d] = v;
    }
  }
  __syncthreads();
}

DI void gla_a_item(const Params& p, int layer, int item, char* smem) {
  const int tid = threadIdx.x;
  float* cum = (float*)smem;
  float* kt = cum + 2048;
  float* vs = kt + 2112;
  const int c = item % NSLOT, h = (item / NSLOT) & 3, b = item / (NSLOT * 4);
  for (int i = tid; i < 512; i += NT) {
    const int s = i >> 3, ch = i & 7;
    float f[8];
    unpack8(*(const uint4*)(p.z + (size_t)gla_row(b, c, s) * ZW + ZV + h * 64 + ch * 8), f);
#pragma unroll
    for (int e = 0; e < 8; ++e) vs[s * 64 + ch * 8 + e] = f[e];
  }
  for (int dir = 0; dir < 2; ++dir) {
    gla_cum(p, layer, b, h, c, dir, cum);
    const int send = dir ? 0 : 63;
    {
      const int s = tid >> 2, d0 = (tid & 3) * 8;
      float kf[8];
      unpack8(*(const uint4*)(p.z + (size_t)gla_row(b, c, s) * ZW + ZK + h * 32 + d0), kf);
#pragma unroll
      for (int e = 0; e < 8; ++e) kt[s * 33 + d0 + e] = kf[e] * __expf(cum[send * 32 + d0 + e] - cum[s * 32 + d0 + e]);
    }
    const size_t sidx = ((size_t)((b * 4 + h) * 2 + dir) * NSLOT + gla_slot(c, dir));
    if (tid < 32) p.Dd[sidx * 32 + tid] = __expf(cum[send * 32 + tid]);
    __syncthreads();
    {
      const int d = tid >> 3, e0 = (tid & 7) * 8;
      float acc[8];
#pragma unroll
      for (int e = 0; e < 8; ++e) acc[e] = 0.f;
      for (int s = 0; s < 64; ++s) {
        const float a = kt[s * 33 + d];
        const float4 v0 = *(const float4*)(vs + s * 64 + e0), v1 = *(const float4*)(vs + s * 64 + e0 + 4);
        acc[0] += a * v0.x; acc[1] += a * v0.y; acc[2] += a * v0.z; acc[3] += a * v0.w;
        acc[4] += a * v1.x; acc[5] += a * v1.y; acc[6] += a * v1.z; acc[7] += a * v1.w;
      }
      float* Lp = p.L + sidx * 2048 + d * 64 + e0;
      *(float4*)Lp = make_float4(acc[0], acc[1], acc[2], acc[3]);
      *(float4*)(Lp + 4) = make_float4(acc[4], acc[5], acc[6], acc[7]);
    }
    __syncthreads();
  }
}

DI void phase_gla_b(const Params& p) {
  const int total = NB * 4 * 2 * 2048;
  for (int idx = blockIdx.x * NT + threadIdx.x; idx < total; idx += gridDim.x * NT) {
    const int chain = idx >> 11, de = idx & 2047, d = de >> 6;
    float S = 0.f;
    float* Lp = p.L + (size_t)chain * NSLOT * 2048 + de;
    const float* Dp = p.Dd + (size_t)chain * NSLOT * 32 + d;
    for (int sl = 0; sl < NSLOT; ++sl) {
      const float loc = Lp[(size_t)sl * 2048];
      Lp[(size_t)sl * 2048] = S;
      S = Dp[sl * 32] * S + loc;
    }
  }
}

DI void gla_c_item(const Params& p, int layer, int item, char* smem) {
  const int tid = threadIdx.x;
  float* cum = (float*)smem;
  float* qt = cum + 2048;
  float* kt = qt + 2112;
  float* vs = kt + 2112;
  float* att = vs + 4096;
  float* Ss = att + 4160;
  const int c = item % NSLOT, h = (item / NSLOT) & 3, b = item / (NSLOT * 4);
  for (int i = tid; i < 512; i += NT) {
    const int s = i >> 3, ch = i & 7;
    float f[8];
    unpack8(*(const uint4*)(p.z + (size_t)gla_row(b, c, s) * ZW + ZV + h * 64 + ch * 8), f);
#pragma unroll
    for (int e = 0; e < 8; ++e) vs[s * 64 + ch * 8 + e] = f[e];
  }
  const int t = tid >> 2, sg = tid & 3, e0 = sg * 16;
  float o[16];
#pragma unroll
  for (int e = 0; e < 16; ++e) o[e] = 0.f;
  for (int dir = 0; dir < 2; ++dir) {
    gla_cum(p, layer, b, h, c, dir, cum);
    {
      const int s = tid >> 2, d0 = (tid & 3) * 8;
      const u16* zr = p.z + (size_t)gla_row(b, c, s) * ZW + h * 32 + d0;
      float qf[8], kf[8];
      unpack8(*(const uint4*)(zr + ZQ), qf);
      unpack8(*(const uint4*)(zr + ZK), kf);
#pragma unroll
      for (int e = 0; e < 8; ++e) {
        const float cv = cum[s * 32 + d0 + e];
        qt[s * 33 + d0 + e] = qf[e] * 0.17677669529663687f * __expf(cv);
        kt[s * 33 + d0 + e] = kf[e] * __expf(-cv);
      }
      const size_t sidx = ((size_t)((b * 4 + h) * 2 + dir) * NSLOT + gla_slot(c, dir));
      const float* Lp = p.L + sidx * 2048;
      *(float4*)(Ss + tid * 8) = *(const float4*)(Lp + tid * 8);
      *(float4*)(Ss + tid * 8 + 4) = *(const float4*)(Lp + tid * 8 + 4);
    }
    __syncthreads();
    {
      float qr[32];
#pragma unroll
      for (int d = 0; d < 32; ++d) qr[d] = qt[t * 33 + d];
#pragma unroll 1
      for (int i = 0; i < 16; ++i) {
        const int s = sg * 16 + i;
        float a = 0.f;
#pragma unroll
        for (int d = 0; d < 32; ++d) a += qr[d] * kt[s * 33 + d];
        const bool valid = dir ? (s >= t) : (s <= t);
        a = valid ? a : 0.f;
        if (dir == 0) att[t * 65 + s] = a; else att[t * 65 + s] += a;
      }
#pragma unroll 2
      for (int d = 0; d < 32; ++d) {
        const float a = qr[d];
        const float* sp = Ss + d * 64 + e0;
#pragma unroll
        for (int e = 0; e < 16; e += 4) {
          const float4 v = *(const float4*)(sp + e);
          o[e] += a * v.x; o[e + 1] += a * v.y; o[e + 2] += a * v.z; o[e + 3] += a * v.w;
        }
      }
    }
    __syncthreads();
  }
#pragma unroll 2
  for (int s = 0; s < 64; ++s) {
    const float a = att[t * 65 + s];
    const float* vp = vs + s * 64 + e0;
#pragma unroll
    for (int e = 0; e < 16; e += 4) {
      const float4 v = *(const float4*)(vp + e);
      o[e] += a * v.x; o[e + 1] += a * v.y; o[e + 2] += a * v.z; o[e + 3] += a * v.w;
    }
  }
  float ss = 0.f;
#pragma unroll
  for (int e = 0; e < 16; ++e) ss += o[e] * o[e];
  ss += __shfl_xor(ss, 1); ss += __shfl_xor(ss, 2);
  const float rstd = rsqrtf(ss * (1.f / 64.f) + 1e-6f);
  const int row = gla_row(b, c, t);
  const u16* ogp = p.z + (size_t)row * ZW + ZOG + h * 64 + e0;
  float og[16];
  unpack8(*(const uint4*)ogp, og);
  unpack8(*(const uint4*)(ogp + 8), og + 8);
  const float* gn = p.gla_norm + layer * 64 + e0;
  unsigned pk[8];
#pragma unroll
  for (int e = 0; e < 16; e += 2)
    pk[e >> 1] = pack2(o[e] * rstd * gn[e] * silu_f(og[e]), o[e + 1] * rstd * gn[e + 1] * silu_f(og[e + 1]));
  u16* cp = p.cat + (size_t)row * DM + h * 64 + e0;
  *(uint4*)cp = make_uint4(pk[0], pk[1], pk[2], pk[3]);
  *(uint4*)(cp + 8) = make_uint4(pk[4], pk[5], pk[6], pk[7]);
  __syncthreads();
}

DI void swa_norm_rows(const Params& p, int layer, int Mrows) {
  const int tid = threadIdx.x, lane = tid & 63, wave = tid >> 6;
  const float* g = p.swa_out_g + layer * 512 + lane * 8;
  for (int row = blockIdx.x * 4 + wave; row < Mrows; row += gridDim.x * 4) {
    u16* cp = p.cat + (size_t)row * DM + 512 + lane * 8;
    float f[8];
    unpack8(*(const uint4*)cp, f);
    float ss = 0.f;
#pragma unroll
    for (int e = 0; e < 8; ++e) ss += f[e] * f[e];
    ss = wave_sum(ss);
    const float rstd = rsqrtf(ss * (1.f / 512.f) + 1e-6f);
    uint4 o;
    o.x = pack2(f[0] * rstd * g[0], f[1] * rstd * g[1]); o.y = pack2(f[2] * rstd * g[2], f[3] * rstd * g[3]);
    o.z = pack2(f[4] * rstd * g[4], f[5] * rstd * g[5]); o.w = pack2(f[6] * rstd * g[6], f[7] * rstd * g[7]);
    *(uint4*)cp = o;
  }
}

DI void phase_mix_a(const Params& p, int layer, char* smem) {
  const bool need_ctx = layer == 0;
  const int n_swa = 2048, n_swac = need_ctx ? 256 : 0, n_gm = need_ctx ? 288 : 256, n_gla = NB * 4 * NSLOT;
  const int total = n_swa + n_swac + n_gm + n_gla;
  for (int item = blockIdx.x; item < total; item += gridDim.x) {
    int it = item;
    if (it < n_swa) { swa_item(p, layer, it, false, smem); continue; }
    it -= n_swa;
    if (it < n_swac) { swa_item(p, layer, it, true, smem); continue; }
    it -= n_swac;
    if (it < n_gm) { gmlp_item(p, layer, it, smem); continue; }
    it -= n_gm;
    gla_a_item(p, layer, it, smem);
  }
}

DI void phase_mix_c(const Params& p, int layer, char* smem) {
  const bool need_ctx = layer == 0;
  const int n_gla = NB * 4 * NSLOT;
  for (int item = blockIdx.x; item < n_gla; item += gridDim.x) {
    const int c = item % NSLOT;
    if (!need_ctx && c < 4) continue;
    gla_c_item(p, layer, item, smem);
  }
  swa_norm_rows(p, layer, need_ctx ? M_ALL : M_LAT);
}


#define XB_TMO      128
#define XB_XCNT(j)  (256  + 64 * (j))
#define XB_XSUB(j)  (1280 + 64 * (j))
#define XB_XGEN(j)  (2304 + 64 * (j))
#define XB_TOP      3328
#define XB_TOPGEN   3392
#define XCD_BAR_WORDS 3456
#define XB_SPIN_CAP (1u << 22)
#define LAS __attribute__((address_space(3)))
DI unsigned xb_ld(unsigned* p) { return __hip_atomic_load(p, __ATOMIC_RELAXED, __HIP_MEMORY_SCOPE_AGENT); }
DI unsigned xb_add(unsigned* p, unsigned v) { return __hip_atomic_fetch_add(p, v, __ATOMIC_RELAXED, __HIP_MEMORY_SCOPE_AGENT); }
DI unsigned xb_xcc_id() { return (unsigned)__builtin_amdgcn_s_getreg((3 << 11) | 20) & 0xFu; }
#define XB_SPIN(cond, bar) do { unsigned _sp = 0; while (cond) { __builtin_amdgcn_s_sleep(1); \
    if ((++_sp & 255u) == 0u) { if (xb_ld(&(bar)[XB_TMO])) break; if (_sp > XB_SPIN_CAP) { atomicAdd(&(bar)[XB_TMO], 1u); break; } } } } while (0)
struct XcdBarrier { unsigned* bar; unsigned x; volatile LAS unsigned* st; };
DI XcdBarrier xcd_barrier_post(unsigned* bar, volatile LAS unsigned* st) {
  XcdBarrier b; b.bar = bar; b.x = xb_xcc_id(); b.st = st;
  if (threadIdx.x == 0) (void)xb_add(&bar[XB_XCNT(b.x)], 1u);
  return b;
}
DI void xcd_barrier_complete(unsigned* bar, unsigned x, unsigned& nloc, unsigned& nx) {
  const unsigned G = gridDim.x * gridDim.y * gridDim.z;
  unsigned sum, cnt, mine, sp = 0u;
  for (;;) {
    sum = 0u; cnt = 0u; mine = 0u;
#pragma unroll
    for (unsigned j = 0; j < 16; ++j) { const unsigned c = xb_ld(&bar[XB_XCNT(j)]); sum += c; cnt += (c > 0u) ? 1u : 0u; mine = (j == x) ? c : mine; }
    if (sum == G) break;
    __builtin_amdgcn_s_sleep(1);
    if ((++sp & 255u) == 0u) { if (xb_ld(&bar[XB_TMO])) break; if (sp > XB_SPIN_CAP) { atomicAdd(&bar[XB_TMO], 1u); break; } }
  }
  nloc = mine > 0u ? mine : 1u; nx = cnt > 0u ? cnt : 1u;
}
DI void xcd_barrier(const XcdBarrier& b) {
  asm volatile("s_waitcnt vmcnt(0)" ::: "memory");
  __syncthreads();
  if (threadIdx.x == 0) {
    unsigned* bar = b.bar;
    __builtin_amdgcn_s_waitcnt(0);
    unsigned nloc = b.st[0], nx = b.st[1];
    if (nloc == 0u) { xcd_barrier_complete(bar, b.x, nloc, nx); b.st[0] = nloc; b.st[1] = nx; }
    const unsigned old = xb_add(&bar[XB_XSUB(b.x)], 1u);
    const unsigned gen = old / nloc;
    if (old + 1u == (gen + 1u) * nloc) {
      __builtin_amdgcn_fence(__ATOMIC_RELEASE, "agent");
      asm volatile("s_waitcnt vmcnt(0)" ::: "memory");
      const unsigned og = xb_add(&bar[XB_TOP], 1u);
      const unsigned tg = og / nx;
      if (og + 1u == (tg + 1u) * nx) xb_add(&bar[XB_TOPGEN], 1u);
      else XB_SPIN(xb_ld(&bar[XB_TOPGEN]) == tg, bar);
      __builtin_amdgcn_fence(__ATOMIC_ACQUIRE, "agent");
      xb_add(&bar[XB_XGEN(b.x)], 1u);
      asm volatile("s_waitcnt vmcnt(0)" ::: "memory");
    } else {
      XB_SPIN(xb_ld(&bar[XB_XGEN(b.x)]) == gen, bar);
      __builtin_amdgcn_fence(__ATOMIC_ACQUIRE, "agent");
      asm volatile("s_waitcnt vmcnt(0)" ::: "memory");
    }
  }
  __syncthreads();
}

constexpr int N_STEPS = 2 + 2 * 9;

DI void run_step(const Params& p, int step, char* smem) {
  if (step == 0) { phase_prep(p, smem); return; }
  if (step == 1) { phase_rows(p, 0, M_ALL, true, 0, 0, nullptr, true, 0, 0, p.n1_pre); return; }
  const int l = (step - 2) / 9, ph = (step - 2) % 9;
  const int Mo = l == 0 ? M_ALL : M_LAT;
  switch (ph) {
    case 0: phase_gemm<0>(p.h, p.WinT + (size_t)l * ZW * DM, M_ALL, ZW, DM, p.z, ZW, smem); break;
    case 1: phase_mix_a(p, l, smem); break;
    case 2: phase_gla_b(p); break;
    case 3: phase_mix_c(p, l, smem); break;
    case 4: phase_gemm<0>(p.cat, p.WoutT + (size_t)l * DM * DM, Mo, DM, DM, p.y, DM, smem); break;
    case 5: phase_rows(p, 1, Mo, l == 0, l, 2, p.n1_post + l * DM, true, l, 3, p.n2_pre + l * DM); break;
    case 6: phase_gemm<1>(p.h, p.WguT + (size_t)l * 2 * DFF * DM, Mo, 2 * DFF, DM, p.act, DFF, smem); break;
    case 7: phase_gemm<0>(p.act, p.WdT + (size_t)l * DM * DFF, Mo, DM, DFF, p.y, DM, smem); break;
    case 8: phase_rows(p, 1, Mo, false, l, 5, p.n2_post + l * DM, l == 0, l + 1, 0, p.n1_pre + (l + 1 < 2 ? l + 1 : 1) * DM); break;
  }
}

template <int S>
DI void run_one(const Params& p, int step_begin, int step_end, int use_cg, const XcdBarrier& xb, char* smem) {
  if (step_begin <= S && S < step_end) {
    run_step(p, S, smem);
    if (S + 1 < step_end) {
      if (use_cg) cg::this_grid().sync();
      else xcd_barrier(xb);
    }
  }
}

__global__ void __launch_bounds__(NT, 2) fwd_kernel(Params p_unused, int step_begin, int step_end, int use_cg) {
  __shared__ __attribute__((aligned(16))) char smem[SMEM_BYTES];
  __shared__ uint4 xb_words;
  const Params& p = *(const Params*)__builtin_amdgcn_kernarg_segment_ptr();
  if (threadIdx.x == 0) xb_words = make_uint4(0u, 0u, 0u, 0u);
  __syncthreads();
  XcdBarrier xb = xcd_barrier_post(p.bar, (volatile LAS unsigned*)&xb_words);
  run_one<0>(p, step_begin, step_end, use_cg, xb, smem);  run_one<1>(p, step_begin, step_end, use_cg, xb, smem);
  run_one<2>(p, step_begin, step_end, use_cg, xb, smem);  run_one<3>(p, step_begin, step_end, use_cg, xb, smem);
  run_one<4>(p, step_begin, step_end, use_cg, xb, smem);  run_one<5>(p, step_begin, step_end, use_cg, xb, smem);
  run_one<6>(p, step_begin, step_end, use_cg, xb, smem);  run_one<7>(p, step_begin, step_end, use_cg, xb, smem);
  run_one<8>(p, step_begin, step_end, use_cg, xb, smem);  run_one<9>(p, step_begin, step_end, use_cg, xb, smem);
  run_one<10>(p, step_begin, step_end, use_cg, xb, smem); run_one<11>(p, step_begin, step_end, use_cg, xb, smem);
  run_one<12>(p, step_begin, step_end, use_cg, xb, smem); run_one<13>(p, step_begin, step_end, use_cg, xb, smem);
  run_one<14>(p, step_begin, step_end, use_cg, xb, smem); run_one<15>(p, step_begin, step_end, use_cg, xb, smem);
  run_one<16>(p, step_begin, step_end, use_cg, xb, smem); run_one<17>(p, step_begin, step_end, use_cg, xb, smem);
  run_one<18>(p, step_begin, step_end, use_cg, xb, smem); run_one<19>(p, step_begin, step_end, use_cg, xb, smem);
}

extern "C" void kernel_launch(void* const* d_in, const int* in_sizes, int n_in, void* d_out, int out_size, void* d_ws,
                              size_t ws_size, hipStream_t stream) {
  static int grid_blocks = 0;
  if (!grid_blocks) {
    int dev = 0, cus = 0, per_cu = 0;
    hipGetDevice(&dev);
    hipDeviceGetAttribute(&cus, hipDeviceAttributeMultiprocessorCount, dev);
    hipOccupancyMaxActiveBlocksPerMultiprocessor(&per_cu, fwd_kernel, NT, 0);
    if (per_cu < 1) per_cu = 1;
    if (per_cu > 2) per_cu = 2;
    grid_blocks = cus * per_cu;
  }
  Params p{};
  const float** fp = (const float**)&p;
  for (int i = 0; i < 24; ++i) fp[i] = (const float*)d_in[i];
  p.out = (float*)d_out;
  char* w = (char*)d_ws;
  size_t off = 0;
  auto take = [&](size_t bytes) { char* r = w + off; off += (bytes + 255) & ~(size_t)255; return r; };
  p.WinT = (u16*)take((size_t)2 * ZW * DM * 2);
  p.WoutT = (u16*)take((size_t)2 * DM * DM * 2);
  p.WguT = (u16*)take((size_t)2 * 2 * DFF * DM * 2);
  p.WdT = (u16*)take((size_t)2 * DM * DFF * 2);
  p.mod = (float*)take((size_t)2 * 17 * 6144 * 4);
  p.rope = (float*)take((size_t)TL * 32 * 2 * 4);
  p.h = (u16*)take((size_t)M_ALL * DM * 2);
  p.z = (u16*)take((size_t)M_ALL * ZW * 2);
  p.cat = (u16*)take((size_t)M_ALL * DM * 2);
  p.act = p.z;
  p.y = (u16*)take((size_t)M_ALL * DM * 2);
  p.xc = (float*)take((size_t)M_CTX * DM * 4);
  p.L = (float*)take((size_t)NB * 4 * 2 * NSLOT * 2048 * 4);
  p.Dd = (float*)take((size_t)NB * 4 * 2 * NSLOT * 32 * 4);
  p.bar = (unsigned*)take((size_t)XCD_BAR_WORDS * 4);
  if (off > ws_size) { fprintf(stderr, "workspace too small: need %zu have %zu\n", off, ws_size); return; }
#if MK_ONE_LAUNCH
  int sb = 0, se = N_STEPS, use_cg = 0;
  void* args[] = {&p, &sb, &se, &use_cg};
  (void)hipMemsetAsync(p.bar, 0, (size_t)XCD_BAR_WORDS * 4, stream);
  hipError_t e = hipLaunchCooperativeKernel((void*)fwd_kernel, dim3(grid_blocks), dim3(NT), args, 0, stream);
  if (e != hipSuccess) fprintf(stderr, "cooperative launch failed: %s (grid %d)\n", hipGetErrorString(e), grid_blocks);
#else
  for (int s = 0; s < N_STEPS; ++s) fwd_kernel<<<grid_blocks, NT, 0, stream>>>(p, s, s + 1, 0);
#endif
}
```

```cpp
#include <hip/hip_runtime.h>
#include <hip/hip_cooperative_groups.h>
#include <cstdio>
namespace cg = cooperative_groups;

#ifndef MK_ONE_LAUNCH
#define MK_ONE_LAUNCH 1
#endif

#define DI __device__ __forceinline__
typedef unsigned short u16;
using bf16x8 = __attribute__((ext_vector_type(8))) short;
using f32x4 = __attribute__((ext_vector_type(4))) float;
#define MFMA16(a, b, c) __builtin_amdgcn_mfma_f32_16x16x32_bf16((a), (b), (c), 0, 0, 0)

constexpr int NT = 512;
constexpr int ST = 256;
constexpr int DM = 1024;
constexpr int NB = 16;
constexpr int TL = 2048;
constexpr int TC = 256;
constexpr int M_LAT = NB * TL;
constexpr int M_CTX = NB * TC;
constexpr int M_ALL = M_LAT + M_CTX;
constexpr int ZW = 2304;
constexpr int IN_COLS = 2080;
constexpr int DFF = 2816;
constexpr int ZQ = 0, ZK = 128, ZV = 256, ZOG = 512, ZGU = 768, ZGV = 1024, ZSQ = 1280, ZSK = 1792, ZSV = 1920, ZGF = 2048, ZGB = 2176;
constexpr int NSLOT = 36;
constexpr int SMEM_BYTES = 147456;

struct Params {
  const float *x, *c, *ctx, *c_ctx, *mod_w, *mod_b, *n1_pre, *n1_post, *n2_pre, *n2_post, *w_in, *w_out,
      *gla_wa2, *gla_ba, *gla_norm, *gmlp_ln_g, *gmlp_ln_b, *gmlp_ws, *gmlp_bs, *gmlp_out_g, *swa_sink, *swa_out_g,
      *ffn_w_gu, *ffn_w_down;
  float* out;
  u16 *WinT, *WoutT, *WguT, *WdT;
  float *mod, *rope, *cumbuf;
  u16 *h, *z, *cat, *y, *act;
  u16 *xc, *xr; float *L, *Dd;
  unsigned* bar;
  u16* vT;
};

DI u16 f2bf(float f) { const __bf16 hv = (__bf16)f; return __builtin_bit_cast(u16, hv); }
DI float bf2f(u16 h) { return __uint_as_float(((unsigned)h) << 16); }
typedef __bf16 bf16x2_t __attribute__((ext_vector_type(2)));
typedef float f32x2_t __attribute__((ext_vector_type(2)));
DI unsigned pack2(float a, float b) { f32x2_t v = {a, b}; bf16x2_t r = __builtin_convertvector(v, bf16x2_t); return __builtin_bit_cast(unsigned, r); }
DI f32x2_t gelu_pk(f32x2_t v) {
  const f32x2_t av = __builtin_elementwise_abs(v), d = av * 0.2316418882f + 1.0f;
  f32x2_t t; t.x = __builtin_amdgcn_rcpf(d.x); t.y = __builtin_amdgcn_rcpf(d.y);
  f32x2_t q = t * 0.5307027145f + (-0.7265760135f); q = q * t + 0.7107068705f; q = q * t + (-0.142248368f); q = q * t + 0.127414796f; q = q * t;
  const f32x2_t s = (v * v) * (-0.72134752044f);
  f32x2_t e; e.x = __builtin_amdgcn_exp2f(s.x); e.y = __builtin_amdgcn_exp2f(s.y);
  const f32x2_t m = v * (q * e), r = v - m;
  f32x2_t o; o.x = v.x < 0.f ? m.x : r.x; o.y = v.y < 0.f ? m.y : r.y; return o;
}
DI int opaque_tid() { int t = threadIdx.x; asm volatile("" : "+v"(t)); return t; }
template <int CTRL, int ROWMASK>
DI float dpp_acc(float v) { const int t = __builtin_amdgcn_update_dpp(0, __float_as_int(v), CTRL, ROWMASK, 0xf, false); return v + __int_as_float(t); }
DI float wave_incl_scan(float v) {
  v = dpp_acc<0x111, 0xf>(v); v = dpp_acc<0x112, 0xf>(v); v = dpp_acc<0x114, 0xf>(v); v = dpp_acc<0x118, 0xf>(v);
  v = dpp_acc<0x142, 0xa>(v); v = dpp_acc<0x143, 0xc>(v);
  return v;
}

DI float wave_sum(float v) { return __int_as_float(__builtin_amdgcn_readlane(__float_as_int(wave_incl_scan(v)), 63)); }
DI float silu_f(float x) { return x * __builtin_amdgcn_rcpf(1.f + __expf(-x)); }
DI float gelu_f(float x) { return 0.5f * x * (1.f + erff(x * 0.70710678118654752f)); }
DI float logsigmoid_f(float z) { return fminf(z, 0.f) - __logf(1.f + __expf(-fabsf(z))); }
DI void unpack8(const uint4& v, float* f) {
  f[0] = __uint_as_float(v.x << 16); f[1] = __uint_as_float(v.x & 0xffff0000u);
  f[2] = __uint_as_float(v.y << 16); f[3] = __uint_as_float(v.y & 0xffff0000u);
  f[4] = __uint_as_float(v.z << 16); f[5] = __uint_as_float(v.z & 0xffff0000u);
  f[6] = __uint_as_float(v.w << 16); f[7] = __uint_as_float(v.w & 0xffff0000u);
}

DI int colmap_win(int n) { return n < 768 ? n : n + 32; }
DI int colmap_gu(int n) { int pn = n >> 8, w = n & 255; return pn * 128 + (w & 127) + ((w & 128) ? DFF : 0); }

template <int CM>
DI void transpose_tile(const float* __restrict__ src, int ld_src, int k0, int n0, u16* __restrict__ dst, int K, float* tile) {
  const int tid = threadIdx.x & 255;
  {
    const int j = tid & 63, i0 = tid >> 6;
    const int n = n0 + j;
    const int col = CM == 1 ? colmap_win(n) : (CM == 2 ? colmap_gu(n) : n);
#pragma unroll
    for (int ii = 0; ii < 16; ++ii) {
      const int k = i0 + 4 * ii;
      tile[k * 65 + j] = src[(size_t)(k0 + k) * ld_src + col];
    }
  }
  __syncthreads();
  {
    const int kk = tid & 63, nn0 = tid >> 6;
#pragma unroll
    for (int ii = 0; ii < 16; ++ii) {
      const int n = nn0 + 4 * ii;
      dst[(size_t)(n0 + n) * K + k0 + kk] = f2bf(tile[kk * 65 + n]);
    }
  }
  __syncthreads();
}

DI void phase_prep(const Params& p, char* smem, int part) {
  const int sub = threadIdx.x >> 8;
  float* sf = (float*)smem + sub * 4352;
  float* stab = (float*)smem + 2 * 4352;
  const int tid = threadIdx.x & 255, lane = tid & 63, wave = tid >> 6;
  constexpr int N_TR_L = 512 + 256 + 1408 + 704;
  constexpr int N_TR = 2 * N_TR_L;
  constexpr int N_FOLD = 64, N_MOD = 192, N_ROPE = 256;
  constexpr int N_ALL = N_TR + N_FOLD + N_MOD + N_ROPE;
  const int nq = part == 0 ? (N_TR_L + 32 + N_MOD + N_ROPE) : (N_TR_L + 32);
  const int skip = (part == 1 && gridDim.x > 128) ? 64 : 0;
  const int bid = (int)blockIdx.x - skip;
  const int nb = (int)gridDim.x - skip;
  if (bid < 0) return;
  for (int pi = bid; pi < nq / 2; pi += nb) {
    const int q = 2 * pi + sub;
    int item;
    if (part == 0) item = q < N_TR_L ? q : (q < N_TR_L + 32 ? N_TR + (q - N_TR_L) : N_TR + N_FOLD + (q - N_TR_L - 32));
    else item = q < N_TR_L ? N_TR_L + q : N_TR + 32 + (q - N_TR_L);
    if (item < N_TR) {
      const int l = item / N_TR_L;
      int r = item - l * N_TR_L;
      if (r < 512) {
        transpose_tile<1>(p.w_in + (size_t)l * DM * IN_COLS, IN_COLS, (r >> 5) * 64, (r & 31) * 64, p.WinT + (size_t)l * ZW * DM, DM, sf);
      } else if (r < 768) {
        r -= 512;
        transpose_tile<0>(p.w_out + (size_t)l * DM * DM, DM, (r >> 4) * 64, (r & 15) * 64, p.WoutT + (size_t)l * DM * DM, DM, sf);
      } else if (r < 2176) {
        r -= 768;
        transpose_tile<2>(p.ffn_w_gu + (size_t)l * DM * 2 * DFF, 2 * DFF, (r / 88) * 64, (r % 88) * 64, p.WguT + (size_t)l * 2 * DFF * DM, DM, sf);
      } else {
        r -= 2176;
        transpose_tile<0>(p.ffn_w_down + (size_t)l * DFF * DM, DM, (r >> 4) * 64, (r & 15) * 64, p.WdT + (size_t)l * DM * DFF, DFF, sf);
      }
    } else if (item < N_TR + N_FOLD) {
      const int idx = item - N_TR;
      const int l = idx >> 5, dir = (idx >> 4) & 1, k0 = (idx & 15) * 64;
      float* wa = sf;
      float* cd = sf + 2048;
      const float* wa2 = p.gla_wa2 + (size_t)(l * 2 + dir) * 16 * 128;
      for (int i = tid; i < 2048; i += ST) wa[i] = wa2[i];
      for (int i = tid; i < 1024; i += ST) {
        const int kk = i >> 4, r = i & 15;
        cd[kk * 17 + r] = p.w_in[(size_t)l * DM * IN_COLS + (size_t)(k0 + kk) * IN_COLS + 768 + dir * 16 + r];
      }
      __syncthreads();
      const int kk = tid & 63, jg = tid >> 6;
      u16* dst = p.WinT + (size_t)l * ZW * DM;
      for (int jj = 0; jj < 32; ++jj) {
        const int j = jg * 32 + jj;
        float s = 0.f;
#pragma unroll
        for (int r = 0; r < 16; ++r) s += cd[kk * 17 + r] * wa[r * 128 + j];
        dst[(size_t)(ZGF + dir * 128 + j) * DM + k0 + kk] = f2bf(s);
      }
      __syncthreads();
    } else if (item < N_TR + N_FOLD + N_MOD) {
      const int cgi = item - N_TR - N_FOLD;
      const int gc = cgi * 64 + lane;
      const int l = gc / 6144, n = gc - l * 6144;
      for (int i = threadIdx.x; i < 17 * 1024; i += NT) {
        const float v = i < 16 * 1024 ? p.c[i] : p.c_ctx[i - 16 * 1024];
        stab[i] = silu_f(v);
      }
      __syncthreads();
      float acc[17];
#pragma unroll
      for (int r = 0; r < 17; ++r) acc[r] = 0.f;
      const float* W = p.mod_w + (size_t)l * DM * 6144 + n;
      const int kb = wave * 256;
#pragma unroll 4
      for (int k = kb; k < kb + 256; ++k) {
        const float wv = W[(size_t)k * 6144];
#pragma unroll
        for (int r = 0; r < 17; ++r) acc[r] += stab[r * 1024 + k] * wv;
      }
      __syncthreads();
#pragma unroll
      for (int r = 0; r < 17; ++r) sf[(wave * 17 + r) * 64 + lane] = acc[r];
      __syncthreads();
      for (int o = tid; o < 17 * 64; o += ST) {
        const int r = o >> 6, ln = o & 63;
        const float s = sf[(0 * 17 + r) * 64 + ln] + sf[(1 * 17 + r) * 64 + ln] + sf[(2 * 17 + r) * 64 + ln] + sf[(3 * 17 + r) * 64 + ln];
        const int nn = cgi * 64 + ln - l * 6144;
        p.mod[(size_t)(l * 17 + r) * 6144 + nn] = s + p.mod_b[l * 6144 + nn];
      }
      __syncthreads();
    } else {
      const int idx = item - N_TR - N_FOLD - N_MOD;
      const int e = idx * 256 + tid;
      const int t = e >> 5, f = e & 31;
      const int fi = f & 15;
      const float inv = powf(10000.f, -(float)(2 * fi) / 32.f);
      const float pos = f < 16 ? (float)(t >> 6) : (float)(t & 63);
      const float ang = pos * inv;
      p.rope[e * 2 + 0] = cosf(ang);
      p.rope[e * 2 + 1] = sinf(ang);
    }
  }
}

DI void rows_chunk(const Params& p, int mode, int row0, int nrows, int mrow, const void* xin, bool xin_bf, void* xout, bool xout_bf,
                   int l_in, int gate_idx, const float* gpost, bool write_h, int l_out, int sh_idx, const float* gpre, int lane) {
  float4 G[4], A[4], Sh[4];
#pragma unroll
  for (int i = 0; i < 4; ++i) {
    const int c0 = lane * 4 + 256 * i;
    if (mode == 1) {
      const float4 g = *(const float4*)(gpost + c0);
      const float4 gt = *(const float4*)(p.mod + (size_t)(l_in * 17 + mrow) * 6144 + gate_idx * 1024 + c0);
      G[i] = make_float4(g.x * gt.x, g.y * gt.y, g.z * gt.z, g.w * gt.w);
    }
    if (write_h) {
      const float* sh = p.mod + (size_t)(l_out * 17 + mrow) * 6144 + sh_idx * 1024 + c0;
      const float4 g = *(const float4*)(gpre + c0);
      const float4 s = *(const float4*)(sh + 1024);
      Sh[i] = *(const float4*)sh;
      A[i] = make_float4(g.x * (1.f + s.x), g.y * (1.f + s.y), g.z * (1.f + s.z), g.w * (1.f + s.w));
    }
  }
  float4 xn[4]; uint2 xb[4]; uint2 yn[4];
#define ROWS_LOAD(R) do { \
    const u16* yr_ = p.y + (size_t)(row0 + (R)) * DM + lane * 4; \
    _Pragma("unroll") for (int i = 0; i < 4; ++i) { \
      if (xin_bf) xb[i] = *(const uint2*)((const u16*)xin + (size_t)(R) * DM + lane * 4 + 256 * i); \
      else xn[i] = *(const float4*)((const float*)xin + (size_t)(R) * DM + lane * 4 + 256 * i); \
      if (mode == 1) yn[i] = *(const uint2*)(yr_ + 256 * i); } } while (0)
  ROWS_LOAD(0);
  for (int r = 0; r < nrows; ++r) {
    float4 xv[4]; uint2 yu[4];
#pragma unroll
    for (int i = 0; i < 4; ++i) {
      if (xin_bf) {
        xv[i].x = __uint_as_float(xb[i].x << 16); xv[i].y = __uint_as_float(xb[i].x & 0xffff0000u);
        xv[i].z = __uint_as_float(xb[i].y << 16); xv[i].w = __uint_as_float(xb[i].y & 0xffff0000u);
      } else xv[i] = xn[i];
      yu[i] = yn[i];
    }
    if (r + 1 < nrows) ROWS_LOAD(r + 1);
    if (mode == 1) {
      float4 yv[4];
      float ss = 0.f;
#pragma unroll
      for (int i = 0; i < 4; ++i) {
        yv[i].x = __uint_as_float(yu[i].x << 16); yv[i].y = __uint_as_float(yu[i].x & 0xffff0000u);
        yv[i].z = __uint_as_float(yu[i].y << 16); yv[i].w = __uint_as_float(yu[i].y & 0xffff0000u);
        ss += yv[i].x * yv[i].x + yv[i].y * yv[i].y + yv[i].z * yv[i].z + yv[i].w * yv[i].w;
      }
      ss = wave_sum(ss);
      const float rstd = rsqrtf(ss * (1.f / DM) + 1e-6f);
#pragma unroll
      for (int i = 0; i < 4; ++i) {
        xv[i].x += G[i].x * (yv[i].x * rstd);
        xv[i].y += G[i].y * (yv[i].y * rstd);
        xv[i].z += G[i].z * (yv[i].z * rstd);
        xv[i].w += G[i].w * (yv[i].w * rstd);
        if (xout_bf) {
          uint2 o; o.x = pack2(xv[i].x, xv[i].y); o.y = pack2(xv[i].z, xv[i].w);
          *(uint2*)((u16*)xout + (size_t)r * DM + lane * 4 + 256 * i) = o;
          xv[i].x = __uint_as_float(o.x << 16); xv[i].y = __uint_as_float(o.x & 0xffff0000u);
          xv[i].z = __uint_as_float(o.y << 16); xv[i].w = __uint_as_float(o.y & 0xffff0000u);
        } else {
          *(float4*)((float*)xout + (size_t)r * DM + lane * 4 + 256 * i) = xv[i];
        }
      }
    }
    if (write_h) {
      float ss = 0.f;
#pragma unroll
      for (int i = 0; i < 4; ++i) ss += xv[i].x * xv[i].x + xv[i].y * xv[i].y + xv[i].z * xv[i].z + xv[i].w * xv[i].w;
      ss = wave_sum(ss);
      const float rstd = rsqrtf(ss * (1.f / DM) + 1e-6f);
      u16* hr = p.h + (size_t)(row0 + r) * DM + lane * 4;
#pragma unroll
      for (int i = 0; i < 4; ++i) {
        uint2 o;
        o.x = pack2(xv[i].x * rstd * A[i].x + Sh[i].x, xv[i].y * rstd * A[i].y + Sh[i].y);
        o.y = pack2(xv[i].z * rstd * A[i].z + Sh[i].z, xv[i].w * rstd * A[i].w + Sh[i].w);
        *(uint2*)(hr + 256 * i) = o;
      }
    }
  }
#undef ROWS_LOAD
}

DI void phase_rows(const Params& p, int mode, int Mrows, int stage, int l_in, int gate_idx, const float* gpost,
                   bool write_h, int l_out, int sh_idx, const float* gpre) {
  const int tid = threadIdx.x, lane = tid & 63, wave = tid >> 6;
  const int nw = gridDim.x * 8;
  const bool xin_bf = stage >= 2, xout_bf = stage != 3;
  for (int ch = blockIdx.x * 8 + wave; ch < M_LAT / 16; ch += nw) {
    const int row0 = ch * 16;
    const void* xin = xin_bf ? (const void*)(p.xr + (size_t)row0 * DM) : (const void*)(p.x + (size_t)row0 * DM);
    void* xout = xout_bf ? (void*)(p.xr + (size_t)row0 * DM) : (void*)(p.out + (size_t)row0 * DM);
    rows_chunk(p, mode, row0, 16, row0 >> 11, xin, xin_bf, xout, xout_bf, l_in, gate_idx, gpost, write_h, l_out, sh_idx, gpre, lane);
  }
  if (Mrows > M_LAT) {
    for (int ch = blockIdx.x * 8 + wave; ch < M_CTX / 2; ch += nw) {
      const int rc = ch * 2;
      const void* xin = xin_bf ? (const void*)(p.xc + (size_t)rc * DM) : (const void*)(p.ctx + (size_t)rc * DM);
      rows_chunk(p, mode, M_LAT + rc, 2, 16, xin, xin_bf, (void*)(p.xc + (size_t)rc * DM), true, l_in, gate_idx, gpost, write_h, l_out, sh_idx, gpre, lane);
    }
  }
}

namespace pg8 {
#define PG8_LAS __attribute__((address_space(3)))
typedef unsigned short bf16_t;
typedef short bf16x8 __attribute__((ext_vector_type(8)));
typedef float f32x4 __attribute__((ext_vector_type(4)));
typedef unsigned u32x4 __attribute__((ext_vector_type(4)));
constexpr int BM = 256, BK = 64, HALF = 128, HTB = HALF * BK * 2  , STAGE_BYTES = 8 * HTB, NXCD = 8, WGM = 4;

__host__ __device__ __forceinline__ int lds_byte(int r, int c) { const int st = (r >> 4) * 2 + (c >> 5), rr = r & 15, cc = c & 31, ob = rr * 64 + cc * 2; return st * 1024 + (ob ^ (((ob >> 9) & 1) << 5)); }
__host__ __device__ __forceinline__ void stage_rc(int b, int& R, int& C) { const int st = b / 1024, sb = b % 1024, swz = sb ^ (((sb >> 9) & 1) << 5); R = (st >> 1) * 16 + swz / 64; C = (st & 1) * 32 + (swz % 64) / 2; }
__host__ __device__ __forceinline__ int perm32(int rho) { const int n = rho >> 4, i = rho & 15; return 8 * (i >> 2) + 4 * n + (i & 3); }

struct Unit { int pm, pn; };
struct Gemm { const bf16_t* A; const bf16_t* Bt; int M, N, K; };

struct StaticOrder {
    int nM, nN, nwg, G, c;
    __host__ __device__ void init(int M, int N, int G_, int c_) { nM = M / BM; nN = N / BM; nwg = nM * nN; G = G_; c = c_; }
    __host__ __device__ bool next(int i, Unit& u) const {
        const long L = (long)i * G + c; if (L >= nwg) return false;
        int wgid = (int)L; { const int q = nwg / NXCD, r = nwg % NXCD, xcd = wgid % NXCD, off = wgid / NXCD; wgid = (xcd < r ? xcd * (q + 1) : r * (q + 1) + (xcd - r) * q) + off; }
        const int nig = WGM * nN, gid = wgid / nig, fm = gid * WGM, gsz = (nM - fm) < WGM ? (nM - fm) : WGM;
        u.pm = fm + ((wgid % nig) % gsz); u.pn = (wgid % nig) / gsz; return true;
    }
    __device__ __forceinline__ void a_ready(const Unit&) const {}
    __device__ __forceinline__ void done(const Unit&) const {}
};
__device__ __forceinline__ unsigned cvt_pk_bf16(float lo, float hi) { return pack2(lo, hi); }

struct InProjLastOrder : StaticOrder {
    __host__ __device__ void init2(int G_, int c_) { init(32768, 2304, G_, c_); }
    __host__ __device__ bool next(int i, Unit& u) const {
        const long L = (long)i * G + c;
        if (L < nwg) return StaticOrder::next(i, u);
        const int j = (int)(L - nwg); if (j >= 64) return false;
        const int k = j & 3; u.pm = 128 + (j >> 2); u.pn = k < 2 ? k : k + 5; return true;
    }
};
struct EpiStoreBf16 {
    static constexpr bool PERM = true, AFTER_DRAIN = false;
    bf16_t* O; int ldc;
    __device__ __forceinline__ void operator()(const f32x4 (&acc)[2][2][4][2], const Unit& u, int wr, int wc, int fr, int fq) const {
        const int row0 = u.pm * BM + wr * 64 + fr, col0 = u.pn * BM + wc * 32 + 8 * fq;
#pragma unroll
        for (int ai = 0; ai < 2; ++ai)
#pragma unroll
            for (int m = 0; m < 4; ++m) { bf16_t* rowp = O + (size_t)(row0 + ai * HALF + m * 16) * ldc + col0;
#pragma unroll
                for (int bj = 0; bj < 2; ++bj) { const f32x4 v0 = acc[ai][bj][m][0], v1 = acc[ai][bj][m][1];
                    u32x4 w; w.x = cvt_pk_bf16(v0[0], v0[1]); w.y = cvt_pk_bf16(v0[2], v0[3]); w.z = cvt_pk_bf16(v1[0], v1[1]); w.w = cvt_pk_bf16(v1[2], v1[3]);
                    *(u32x4*)(rowp + bj * HALF) = w; } }
    }
};
struct EpiInProj {
    static constexpr bool PERM = true, AFTER_DRAIN = false;
    bf16_t* O; int ldc; const float* rope; bf16_t* vT;
    static __device__ __forceinline__ void rot(f32x4& v0, f32x4& v1, const f32x4 (&c)[4], float sg) {
        const float q0 = __shfl_xor(v0[0], 32), q1 = __shfl_xor(v0[1], 32), q2 = __shfl_xor(v0[2], 32), q3 = __shfl_xor(v0[3], 32);
        const float r0 = __shfl_xor(v1[0], 32), r1 = __shfl_xor(v1[1], 32), r2 = __shfl_xor(v1[2], 32), r3 = __shfl_xor(v1[3], 32);
        v0[0] = v0[0] * c[0][0] + sg * q0 * c[0][1]; v0[1] = v0[1] * c[0][2] + sg * q1 * c[0][3];
        v0[2] = v0[2] * c[1][0] + sg * q2 * c[1][1]; v0[3] = v0[3] * c[1][2] + sg * q3 * c[1][3];
        v1[0] = v1[0] * c[2][0] + sg * r0 * c[2][1]; v1[1] = v1[1] * c[2][2] + sg * r1 * c[2][3];
        v1[2] = v1[2] * c[3][0] + sg * r2 * c[3][1]; v1[3] = v1[3] * c[3][2] + sg * r3 * c[3][3];
    }
    __device__ __forceinline__ void emit(f32x4 v0, f32x4 v1, const Unit& u, int row, int col0, int bj, int wc, int fq, bool lat, bool dorot, const f32x4 (&c)[4], float sg) const {
        constexpr float QS = 0.125f * 1.4426950408889634f;
        if (u.pn == 7 && bj == 1) {
            const int blk = lat ? (row >> 7) : (256 + ((row - 32768) >> 7));
            const int d0 = wc * 32 + 8 * fq;
            bf16_t* vp = vT + ((size_t)(blk * 2 + (d0 >> 6)) * 64 + (d0 & 63)) * 128 + (row & 127);
#pragma unroll
            for (int j = 0; j < 4; ++j) { vp[j * 128] = f2bf(v0[j]); vp[(4 + j) * 128] = f2bf(v1[j]); }
            return;
        }
        if (dorot) rot(v0, v1, c, sg);
        if (u.pn < 7) { v0 *= QS; v1 *= QS; }
        u32x4 w; w.x = cvt_pk_bf16(v0[0], v0[1]); w.y = cvt_pk_bf16(v0[2], v0[3]); w.z = cvt_pk_bf16(v1[0], v1[1]); w.w = cvt_pk_bf16(v1[2], v1[3]);
        *(u32x4*)(O + (size_t)row * ldc + col0 + bj * HALF) = w;
    }
    __device__ __forceinline__ void operator()(const f32x4 (&acc)[2][2][4][2], const Unit& u, int wr, int wc, int fr, int fq) const {
        const int row0 = u.pm * BM + wr * 64 + fr, col0 = u.pn * BM + wc * 32 + 8 * fq;
        const bool swa = (u.pn >= 5) && (u.pn <= 7);
        if (!swa) {
#pragma unroll
            for (int ai = 0; ai < 2; ++ai)
#pragma unroll
                for (int m = 0; m < 4; ++m) { bf16_t* rowp = O + (size_t)(row0 + ai * HALF + m * 16) * ldc + col0;
#pragma unroll
                    for (int bj = 0; bj < 2; ++bj) { const f32x4 v0 = acc[ai][bj][m][0], v1 = acc[ai][bj][m][1];
                        u32x4 w; w.x = cvt_pk_bf16(v0[0], v0[1]); w.y = cvt_pk_bf16(v0[2], v0[3]); w.z = cvt_pk_bf16(v1[0], v1[1]); w.w = cvt_pk_bf16(v1[2], v1[3]);
                        *(u32x4*)(rowp + bj * HALF) = w; } }
            return;
        }
        const bool lat = u.pm < 128;
        const float sg = (fq < 2) ? -1.f : 1.f;
        if (wc & 1) {
#pragma unroll
            for (int m = 0; m < 4; ++m) {
                f32x4 c[4];
                if (lat) { const float* rp = rope + ((size_t)(16 * m + fr) * 32 + 16 + 8 * (fq & 1)) * 2;
#pragma unroll
                    for (int k = 0; k < 4; ++k) c[k] = *(const f32x4*)(rp + 4 * k); }
#pragma unroll
                for (int ai = 0; ai < 2; ++ai)
#pragma unroll
                    for (int bj = 0; bj < 2; ++bj) emit(acc[ai][bj][m][0], acc[ai][bj][m][1], u, row0 + ai * HALF + m * 16, col0, bj, wc, fq, lat, lat, c, sg);
                __builtin_amdgcn_sched_barrier(0);
            }
        } else {
#pragma unroll
            for (int ai = 0; ai < 2; ++ai) {
                f32x4 c[4];
                if (lat) { const float* rp = rope + ((size_t)((row0 + ai * HALF) & 2047) * 32 + 8 * (fq & 1)) * 2;
#pragma unroll
                    for (int k = 0; k < 4; ++k) c[k] = *(const f32x4*)(rp + 4 * k); }
#pragma unroll
                for (int m = 0; m < 4; ++m)
#pragma unroll
                    for (int bj = 0; bj < 2; ++bj) emit(acc[ai][bj][m][0], acc[ai][bj][m][1], u, row0 + ai * HALF + m * 16, col0, bj, wc, fq, lat, lat, c, sg);
                __builtin_amdgcn_sched_barrier(0);
            }
        }
    }
};
struct EpiSwiglu {
    static constexpr bool PERM = true, AFTER_DRAIN = false;
    bf16_t* O; int ldc;
    __device__ __forceinline__ void operator()(const f32x4 (&acc)[2][2][4][2], const Unit& u, int wr, int wc, int fr, int fq) const {
        const int row0 = u.pm * BM + wr * 64 + fr, col0 = u.pn * HALF + wc * 32 + 8 * fq;
#pragma unroll
        for (int ai = 0; ai < 2; ++ai)
#pragma unroll
            for (int m = 0; m < 4; ++m) { bf16_t* rowp = O + (size_t)(row0 + ai * HALF + m * 16) * ldc + col0;
                float r[8];
#pragma unroll
                for (int n = 0; n < 2; ++n)
#pragma unroll
                    for (int j = 0; j < 4; ++j) { const float g = acc[ai][0][m][n][j], up = acc[ai][1][m][n][j]; r[n * 4 + j] = g * up * __builtin_amdgcn_rcpf(1.f + __builtin_amdgcn_exp2f(g * -1.4426950408889634f)); }
                u32x4 w; w.x = cvt_pk_bf16(r[0], r[1]); w.y = cvt_pk_bf16(r[2], r[3]); w.z = cvt_pk_bf16(r[4], r[5]); w.w = cvt_pk_bf16(r[6], r[7]);
                *(u32x4*)rowp = w; }
    }
};

template <class Epi, class Sched, bool STAMP = false>
__device__ __forceinline__ void gemm_phase(PG8_LAS unsigned char* lds, const Gemm g, const Sched& S, const Epi& E, unsigned long long* stamps) {
    const int tid = threadIdx.x, wid = __builtin_amdgcn_readfirstlane(tid >> 6), lane = tid & 63, wr = wid >> 2, wc = wid & 3, fr = lane & 15, fq = lane >> 4;
    const int K = g.K, nt = K / BK;
    int ts_lo = 0, ts_hi = 0, nts = 0; const unsigned long long rt_entry = STAMP ? (unsigned long long)wall_clock64() : 0ull;
#define PG8_STAMP() do { if (STAMP && wid == 0 && nts < 64) { const unsigned long long _c = (unsigned long long)clock64(); \
        ts_lo = (lane == nts) ? (int)(unsigned)_c : ts_lo; ts_hi = (lane == nts) ? (int)(unsigned)(_c >> 32) : ts_hi; ++nts; } } while (0)
    PG8_STAMP();
    unsigned voffA[2], voffB[2];
#pragma unroll
    for (int i = 0; i < 2; ++i) { int R, C; stage_rc(tid * 16 + i * 8192, R, C); const int Rb = Epi::PERM ? ((R & ~31) + perm32(R & 31)) : R;
        voffA[i] = (unsigned)(R * K + C) * 2u; voffB[i] = (unsigned)(Rb * K + C) * 2u; }
    const size_t kstep = (size_t)(BK * 2);
    const size_t hstep = (size_t)HALF * K * 2;
    const size_t tstep = 2 * hstep;
    const unsigned ldsw = (unsigned)wid * 1024u;
    const int aoff = lds_byte(wr * 64 + fr, fq * 8), boff = lds_byte(wc * 32 + fr, fq * 8);
#define PG8_SA(b, h) (((b) * 2 + (h)) * HTB)
#define PG8_SB(b, h) ((4 + (b) * 2 + (h)) * HTB)
#define PG8_STAGE(bufoff, gbase, voff) do { _Pragma("unroll") for (int _i = 0; _i < 2; ++_i) \
        __builtin_amdgcn_global_load_lds((const unsigned*)((const char*)(gbase) + (voff)[_i]), (PG8_LAS unsigned*)(lds + (bufoff) + ldsw + _i * 8192), 16, 0, 0); } while (0)
#define PG8_LDA(dst, b, h) do { _Pragma("unroll") for (int m = 0; m < 4; ++m) _Pragma("unroll") for (int k = 0; k < 2; ++k) dst[m][k] = *(const PG8_LAS bf16x8*)(lds + PG8_SA(b, h) + aoff + m * 2048 + k * 1024); } while (0)
#define PG8_LDB(dst, b, h) do { _Pragma("unroll") for (int n = 0; n < 2; ++n) _Pragma("unroll") for (int k = 0; k < 2; ++k) dst[n][k] = *(const PG8_LAS bf16x8*)(lds + PG8_SB(b, h) + boff + n * 2048 + k * 1024); } while (0)
#define PG8_MMA(ai, bj, At, Bt) do { __builtin_amdgcn_s_setprio(1); _Pragma("unroll") for (int m = 0; m < 4; ++m) _Pragma("unroll") for (int n = 0; n < 2; ++n) _Pragma("unroll") for (int k = 0; k < 2; ++k) \
        acc[ai][bj][m][n] = __builtin_amdgcn_mfma_f32_16x16x32_bf16(Bt[n][k], At[m][k], acc[ai][bj][m][n], 0, 0, 0); __builtin_amdgcn_s_setprio(0); } while (0)
#define PG8_WAIT_V(n) asm volatile("s_waitcnt vmcnt(" #n ")" ::: "memory")
#define PG8_WAIT_L(n) asm volatile("s_waitcnt lgkmcnt(" #n ")" ::: "memory")
#define PG8_BAR __builtin_amdgcn_s_barrier()
#define PG8_SCHED __builtin_amdgcn_sched_barrier(0)
    Unit cur, nxt; int ui = 0;
    if (!S.next(0, cur)) return;
    f32x4 acc[2][2][4][2];
#pragma unroll
    for (int a = 0; a < 2; ++a)
#pragma unroll
        for (int b = 0; b < 2; ++b)
#pragma unroll
            for (int m = 0; m < 4; ++m)
#pragma unroll
                for (int n = 0; n < 2; ++n) acc[a][b][m][n] = (f32x4){0.f, 0.f, 0.f, 0.f};
    bf16x8 At[4][2], B0[2][2], B1[2][2];
    const char* cA = (const char*)g.A + (size_t)cur.pm * tstep; const char* cB = (const char*)g.Bt + (size_t)cur.pn * tstep;
    S.a_ready(cur);
    PG8_STAGE(PG8_SB(0, 0), cB, voffB); PG8_STAGE(PG8_SA(0, 0), cA, voffA); PG8_STAGE(PG8_SB(0, 1), cB + hstep, voffB); PG8_STAGE(PG8_SA(0, 1), cA + hstep, voffA);
    if (wr == 1) PG8_BAR;
    PG8_WAIT_V(4); PG8_BAR;
    PG8_STAGE(PG8_SB(1, 0), cB + kstep, voffB); PG8_STAGE(PG8_SA(1, 0), cA + kstep, voffA); PG8_STAGE(PG8_SB(1, 1), cB + hstep + kstep, voffB);
    PG8_WAIT_V(6); PG8_BAR;
    PG8_STAMP();
    for (;;) {
        const bool has_next = S.next(ui + 1, nxt);
        const char* nA = has_next ? (const char*)g.A + (size_t)nxt.pm * tstep : cA; const char* nB = has_next ? (const char*)g.Bt + (size_t)nxt.pn * tstep : cB;
        for (int t = 0; t < nt; t += 2) {
            const bool last = (t == nt - 2);
            const char* a1 = cA + (size_t)(t + 1) * kstep;
            const char* a2 = last ? nA : cA + (size_t)(t + 2) * kstep; const char* b2 = last ? nB : cB + (size_t)(t + 2) * kstep;
            const char* a3 = a2 + kstep; const char* b3 = b2 + kstep;
            if (last && has_next) S.a_ready(nxt);
            PG8_LDB(B0, 0, 0); PG8_SCHED; PG8_LDA(At, 0, 0); PG8_STAGE(PG8_SA(1, 1), a1 + hstep, voffA);
            PG8_WAIT_L(8); PG8_BAR; PG8_WAIT_L(0); PG8_MMA(0, 0, At, B0); PG8_BAR; PG8_SCHED;
            PG8_LDB(B1, 0, 1); PG8_STAGE(PG8_SB(0, 0), b2, voffB);
            PG8_BAR; PG8_WAIT_L(0); PG8_MMA(0, 1, At, B1); PG8_BAR;
            PG8_LDA(At, 0, 1); PG8_STAGE(PG8_SA(0, 0), a2, voffA);
            PG8_BAR; PG8_WAIT_L(0); PG8_MMA(1, 0, At, B0); PG8_BAR; PG8_SCHED;
            PG8_STAGE(PG8_SB(0, 1), b2 + hstep, voffB);
            PG8_WAIT_V(6); PG8_BAR; PG8_MMA(1, 1, At, B1); PG8_BAR;
            PG8_LDB(B0, 1, 0); PG8_SCHED; PG8_LDA(At, 1, 0); PG8_STAGE(PG8_SA(0, 1), a2 + hstep, voffA);
            PG8_WAIT_L(8); PG8_BAR; PG8_WAIT_L(0); PG8_MMA(0, 0, At, B0); PG8_BAR; PG8_SCHED;
            PG8_LDB(B1, 1, 1); PG8_STAGE(PG8_SB(1, 0), b3, voffB);
            PG8_BAR; PG8_WAIT_L(0); PG8_MMA(0, 1, At, B1); PG8_BAR;
            PG8_LDA(At, 1, 1); PG8_STAGE(PG8_SA(1, 0), a3, voffA);
            PG8_BAR; PG8_WAIT_L(0); PG8_MMA(1, 0, At, B0); PG8_BAR; PG8_SCHED;
            PG8_STAGE(PG8_SB(1, 1), b3 + hstep, voffB);
            PG8_WAIT_V(6); PG8_BAR; PG8_MMA(1, 1, At, B1); PG8_BAR;
        }
        PG8_STAMP();
        if constexpr (!Epi::AFTER_DRAIN) { E(acc, cur, wr, wc, fr, fq); S.done(cur); }
        PG8_STAMP();
        if (!has_next) break;
#pragma unroll
        for (int a = 0; a < 2; ++a)
#pragma unroll
            for (int b = 0; b < 2; ++b)
#pragma unroll
                for (int m = 0; m < 4; ++m)
#pragma unroll
                    for (int n = 0; n < 2; ++n) acc[a][b][m][n] = (f32x4){0.f, 0.f, 0.f, 0.f};
        cur = nxt; cA = nA; cB = nB; ++ui;
    }
    PG8_WAIT_V(0);
    if (wr == 0) PG8_BAR;
    PG8_BAR;
    if constexpr (Epi::AFTER_DRAIN) { E.fused(acc, cur, wr, wc, fr, fq, lds, wid, lane); S.done(cur); }
    PG8_STAMP();
    if (STAMP && wid == 0) { stamps[lane] = lane < nts ? (((unsigned long long)(unsigned)ts_hi << 32) | (unsigned)ts_lo) : 0ull;
        if (lane == 62) stamps[62] = rt_entry; if (lane == 63) stamps[63] = (unsigned long long)wall_clock64(); }
#undef PG8_STAMP
#undef PG8_SA
#undef PG8_SB
#undef PG8_STAGE
#undef PG8_LDA
#undef PG8_LDB
#undef PG8_MMA
#undef PG8_WAIT_V
#undef PG8_WAIT_L
#undef PG8_BAR
#undef PG8_SCHED
}
}

template <int EPI>
DI void phase_gemm(const u16* A, const u16* Bt, int M, int N, int K, u16* C, int ldc, char* smem, const float* rope = nullptr, u16* vT = nullptr) {
  pg8::Gemm g; g.A = A; g.Bt = Bt; g.M = M; g.N = N; g.K = K;
  pg8::StaticOrder S; S.init(M, N, (int)gridDim.x, (int)blockIdx.x);
  if (EPI == 3) { pg8::InProjLastOrder S2; S2.init2((int)gridDim.x, (int)blockIdx.x);
    pg8::EpiInProj E; E.O = C; E.ldc = ldc; E.rope = rope; E.vT = vT; pg8::gemm_phase<pg8::EpiInProj, pg8::InProjLastOrder, false>((PG8_LAS unsigned char*)smem, g, S2, E, nullptr); }
  else if (EPI == 2) { pg8::EpiInProj E; E.O = C; E.ldc = ldc; E.rope = rope; E.vT = vT; pg8::gemm_phase<pg8::EpiInProj, pg8::StaticOrder, false>((PG8_LAS unsigned char*)smem, g, S, E, nullptr); }
  else if (EPI == 0) { pg8::EpiStoreBf16 E; E.O = C; E.ldc = ldc; pg8::gemm_phase<pg8::EpiStoreBf16, pg8::StaticOrder, false>((PG8_LAS unsigned char*)smem, g, S, E, nullptr); }
  else { pg8::EpiSwiglu E; E.O = C; E.ldc = ldc; pg8::gemm_phase<pg8::EpiSwiglu, pg8::StaticOrder, false>((PG8_LAS unsigned char*)smem, g, S, E, nullptr); }
  __syncthreads();
}

DI void swa_item(const Params& p, int layer, int pi, bool ctxq, char* smem) {
  const int tid = opaque_tid(), lane = tid & 63, wave = tid >> 6, w4 = wave & 3;
  const int w4u = __builtin_amdgcn_readfirstlane(w4);
  const int l15 = lane & 15, lq = lane >> 4;
  const int hq = (pi & 3) * 2 + (wave >> 2);
  const int g = hq >> 2;
  int b, n;
  if (!ctxq) { n = (pi >> 2) & 15; b = pi >> 6; } else { n = (pi >> 2) & 1; b = pi >> 3; }
  const int qrow0 = (ctxq ? (M_LAT + b * TC + n * 128) : (b * TL + n * 128)) + w4 * 32;
  const int ctxrow0 = M_LAT + b * TC;
  bf16x8 Q[2][2];
#pragma unroll
  for (int rt = 0; rt < 2; ++rt)
#pragma unroll
    for (int ks = 0; ks < 2; ++ks)
      Q[rt][ks] = *(const bf16x8*)(p.z + (size_t)(qrow0 + rt * 16 + l15) * ZW + ZSQ + hq * 64 + ks * 32 + lq * 8);
  const float sink = p.swa_sink[layer * 8 + hq] * 1.4426950408889634f;
  float mrun[2], lrun[2];
  f32x4 O[4][2];
#pragma unroll
  for (int rt = 0; rt < 2; ++rt) {
    mrun[rt] = sink; lrun[rt] = (lq == 0) ? 1.f : 0.f;
#pragma unroll
    for (int dt = 0; dt < 4; ++dt) O[dt][rt] = f32x4{0.f, 0.f, 0.f, 0.f};
  }
  uint4 kreg0, kreg1, vreg0, vreg1;
#define SWA_LOAD_TILE(KT) do { \
    int krow0_, blk_; \
    if ((KT) < 3) { const int nk_ = n + (KT) - 1; krow0_ = b * TL + nk_ * 128; blk_ = b * 16 + nk_; } \
    else { krow0_ = ctxrow0 + ((KT) - 3) * 128; blk_ = 256 + b * 2 + ((KT) - 3); } \
    const u16* kb_ = p.z + (size_t)krow0_ * ZW + ZSK + g * 64; \
    const u16* vb_ = p.vT + (size_t)(blk_ * 2 + g) * 64 * 128; \
    kreg0 = *(const uint4*)(kb_ + (size_t)(tid >> 3) * ZW + (tid & 7) * 8); \
    kreg1 = *(const uint4*)(kb_ + (size_t)((tid + 512) >> 3) * ZW + (tid & 7) * 8); \
    vreg0 = *(const uint4*)(vb_ + (tid >> 4) * 128 + (tid & 15) * 8); \
    vreg1 = *(const uint4*)(vb_ + ((tid + 512) >> 4) * 128 + (tid & 15) * 8); \
  } while (0)
  int kt = ctxq ? 3 : (n == 0 ? 1 : 0);
  SWA_LOAD_TILE(kt);
  int buf = 0;
  while (kt < 5) {
    u16* Ks = (u16*)smem + buf * (128 * 72 + 64 * 136);
    u16* Vt = Ks + 128 * 72;
    *(uint4*)(Ks + (tid >> 3) * 72 + (tid & 7) * 8) = kreg0;
    *(uint4*)(Ks + ((tid + 512) >> 3) * 72 + (tid & 7) * 8) = kreg1;
    *(uint4*)(Vt + (tid >> 4) * 136 + (tid & 15) * 8) = vreg0;
    *(uint4*)(Vt + ((tid + 512) >> 4) * 136 + (tid & 15) * 8) = vreg1;
    __syncthreads();
    const int ktn = (kt == 1 && n == 15 && !ctxq) ? 3 : kt + 1;
    if (ktn < 5) SWA_LOAD_TILE(ktn);
#pragma unroll 1
    for (int hf = 0; hf < 2; ++hf) {
      f32x4 S[4][2];
#pragma unroll
      for (int c4 = 0; c4 < 4; ++c4) {
        const u16* kr = Ks + ((hf * 4 + c4) * 16 + l15) * 72 + lq * 8;
        const bf16x8 k0 = *(const bf16x8*)kr;
        const bf16x8 k1 = *(const bf16x8*)(kr + 32);
#pragma unroll
        for (int rt = 0; rt < 2; ++rt) {
          f32x4 s = f32x4{0.f, 0.f, 0.f, 0.f};
          s = MFMA16(k0, Q[rt][0], s);
          s = MFMA16(k1, Q[rt][1], s);
          S[c4][rt] = s;
        }
      }
      if (kt == 0 || kt == 2) {
        const bool prev = kt == 0;
#pragma unroll
        for (int rt = 0; rt < 2; ++rt) {
          const int dq = 2 * w4u + rt;
#pragma unroll
          for (int c4 = 0; c4 < 4; ++c4) {
            const int ct = hf * 4 + c4;
            if (prev ? (ct < dq) : (ct > dq)) {
              S[c4][rt] = f32x4{-1e30f, -1e30f, -1e30f, -1e30f};
            } else if (ct == dq) {
#pragma unroll
              for (int j = 0; j < 4; ++j) {
                const bool valid = prev ? (lq * 4 + j >= l15) : (lq * 4 + j <= l15);
                if (!valid) S[c4][rt][j] = -1e30f;
              }
            }
          }
        }
      }
      unsigned Pk[4][2][2];
#pragma unroll
      for (int rt = 0; rt < 2; ++rt) {
        float mx = S[0][rt][0];
#pragma unroll
        for (int c4 = 0; c4 < 4; ++c4)
#pragma unroll
          for (int j = 0; j < 4; ++j) mx = fmaxf(mx, S[c4][rt][j]);
        mx = fmaxf(mx, __shfl_xor(mx, 16));
        mx = fmaxf(mx, __shfl_xor(mx, 32));
        if (__builtin_amdgcn_ballot_w64(mx - mrun[rt] > 6.f) != 0ull) {
          const float mnew = fmaxf(mrun[rt], mx);
          const float alpha = __builtin_amdgcn_exp2f(mrun[rt] - mnew);
          mrun[rt] = mnew;
          lrun[rt] *= alpha;
#pragma unroll
          for (int dt = 0; dt < 4; ++dt) O[dt][rt] *= alpha;
        }
        const float mref = mrun[rt];
        float rs = 0.f;
#pragma unroll
        for (int c4 = 0; c4 < 4; ++c4) {
          float pv[4];
#pragma unroll
          for (int j = 0; j < 4; ++j) { pv[j] = __builtin_amdgcn_exp2f(S[c4][rt][j] - mref); rs += pv[j]; }
          Pk[c4][rt][0] = pack2(pv[0], pv[1]);
          Pk[c4][rt][1] = pack2(pv[2], pv[3]);
        }
        lrun[rt] += rs;
      }
#pragma unroll
      for (int kk = 0; kk < 2; ++kk) {
        bf16x8 pb[2];
#pragma unroll
        for (int rt = 0; rt < 2; ++rt) {
          uint4 t4 = make_uint4(Pk[2 * kk][rt][0], Pk[2 * kk][rt][1], Pk[2 * kk + 1][rt][0], Pk[2 * kk + 1][rt][1]);
          pb[rt] = __builtin_bit_cast(bf16x8, t4);
        }
#pragma unroll
        for (int dt = 0; dt < 4; ++dt) {
          const u16* vrow = Vt + (dt * 16 + l15) * 136 + lq * 4 + (hf * 4 + 2 * kk) * 16;
          const uint2 lo = *(const uint2*)(vrow);
          const uint2 hi = *(const uint2*)(vrow + 16);
          const bf16x8 va = __builtin_bit_cast(bf16x8, make_uint4(lo.x, lo.y, hi.x, hi.y));
#pragma unroll
          for (int rt = 0; rt < 2; ++rt) O[dt][rt] = MFMA16(va, pb[rt], O[dt][rt]);
        }
      }
    }
    kt = ktn; buf ^= 1;
  }
#pragma unroll
  for (int rt = 0; rt < 2; ++rt) {
    float l = lrun[rt];
    l += __shfl_xor(l, 16);
    l += __shfl_xor(l, 32);
    const float inv = 1.f / l;
    const int row = qrow0 + rt * 16 + l15;
#pragma unroll
    for (int dt = 0; dt < 4; ++dt) {
      uint2 o;
      o.x = pack2(O[dt][rt][0] * inv, O[dt][rt][1] * inv);
      o.y = pack2(O[dt][rt][2] * inv, O[dt][rt][3] * inv);
      *(uint2*)(p.cat + (size_t)row * DM + 512 + hq * 64 + dt * 16 + lq * 4) = o;
    }
  }
  __syncthreads();
}

DI void gmlp_item(const Params& p, int layer, int ci, char* smem) {
  const int tid = opaque_tid(), lane = tid & 63, wave = tid >> 6;
  const int l15 = lane & 15, lq = lane >> 4;
  u16* vT = (u16*)smem;
  float* rowss = (float*)(smem + 256 * 136 * 2);
  const int grow0 = ci * 128;
  {
    const int pr = tid >> 2, qd = tid & 3;
    const u16* zr = p.z + (size_t)(grow0 + pr) * ZW + ZGV + qd * 64;
    float v[64];
#pragma unroll
    for (int i = 0; i < 8; ++i) {
      const uint4 raw = *(const uint4*)(zr + i * 8);
      float f[8];
      unpack8(raw, f);
#pragma unroll
      for (int e = 0; e < 8; e += 2) {
        const f32x2_t gq = gelu_pk(f32x2_t{f[e], f[e + 1]});
        v[i * 8 + e] = gq.x; v[i * 8 + e + 1] = gq.y;
      }
    }
    float sm = 0.f;
#pragma unroll
    for (int e = 0; e < 64; ++e) sm += v[e];
    sm += __shfl_xor(sm, 1); sm += __shfl_xor(sm, 2);
    const float mean = sm * (1.f / 256.f);
    float q = 0.f;
#pragma unroll
    for (int e = 0; e < 64; ++e) { v[e] -= mean; q += v[e] * v[e]; }
    q += __shfl_xor(q, 1); q += __shfl_xor(q, 2);
    const float rstd = rsqrtf(q * (1.f / 256.f) + 1e-5f);
    const float* lng = p.gmlp_ln_g + layer * 256 + qd * 64;
    const float* lnb = p.gmlp_ln_b + layer * 256 + qd * 64;
#pragma unroll
    for (int e = 0; e < 64; e += 4) {
      const float4 gg = *(const float4*)(lng + e), bb = *(const float4*)(lnb + e);
      u16* dst = vT + (qd * 64 + e) * 136 + pr;
      dst[0] = f2bf(v[e] * rstd * gg.x + bb.x);
      dst[136] = f2bf(v[e + 1] * rstd * gg.y + bb.y);
      dst[272] = f2bf(v[e + 2] * rstd * gg.z + bb.z);
      dst[408] = f2bf(v[e + 3] * rstd * gg.w + bb.w);
    }
  }
  __syncthreads();
  const int g = wave & 3, half = wave >> 2;
  const float* ws = p.gmlp_ws + (size_t)(layer * 4 + g) * 128 * 128;
  f32x4 acc[4][4];
#pragma unroll
  for (int ct = 0; ct < 4; ++ct)
#pragma unroll
    for (int rt = 0; rt < 4; ++rt) acc[ct][rt] = f32x4{0.f, 0.f, 0.f, 0.f};
#pragma unroll 1
  for (int ks = 0; ks < 4; ++ks) {
    bf16x8 vf[4];
#pragma unroll
    for (int ct = 0; ct < 4; ++ct) vf[ct] = *(const bf16x8*)(vT + (g * 64 + ct * 16 + l15) * 136 + ks * 32 + lq * 8);
#pragma unroll
    for (int rt = 0; rt < 4; ++rt) {
      const float* wr = ws + (size_t)(half * 64 + rt * 16 + l15) * 128 + ks * 32 + lq * 8;
      const float4 w0 = *(const float4*)wr, w1 = *(const float4*)(wr + 4);
      uint4 pk;
      pk.x = pack2(w0.x, w0.y); pk.y = pack2(w0.z, w0.w); pk.z = pack2(w1.x, w1.y); pk.w = pack2(w1.z, w1.w);
      const bf16x8 wf = __builtin_bit_cast(bf16x8, pk);
#pragma unroll
      for (int ct = 0; ct < 4; ++ct) acc[ct][rt] = MFMA16(vf[ct], wf, acc[ct][rt]);
    }
  }
  const float* bs = p.gmlp_bs + (size_t)(layer * 4 + g) * 128;
  const float* og = p.gmlp_out_g + layer * 256;
#pragma unroll
  for (int rt = 0; rt < 4; ++rt) {
    const int pr = half * 64 + rt * 16 + l15;
    const float bias = bs[pr];
    const u16* zr = p.z + (size_t)(grow0 + pr) * ZW + ZGU + g * 64 + lq * 4;
    float ss = 0.f;
#pragma unroll
    for (int ct = 0; ct < 4; ++ct) {
      const uint2 ur = *(const uint2*)(zr + ct * 16);
      const f32x2_t u01 = gelu_pk(f32x2_t{__uint_as_float(ur.x << 16), __uint_as_float(ur.x & 0xffff0000u)});
      const f32x2_t u23 = gelu_pk(f32x2_t{__uint_as_float(ur.y << 16), __uint_as_float(ur.y & 0xffff0000u)});
      f32x4 val = acc[ct][rt];
      val[0] = u01.x * (val[0] + bias); val[1] = u01.y * (val[1] + bias);
      val[2] = u23.x * (val[2] + bias); val[3] = u23.y * (val[3] + bias);
      acc[ct][rt] = val;
      ss += val[0] * val[0] + val[1] * val[1] + val[2] * val[2] + val[3] * val[3];
    }
    ss += __shfl_xor(ss, 16); ss += __shfl_xor(ss, 32);
    if (lq == 0) rowss[g * 128 + pr] = ss;
  }
  __syncthreads();
#pragma unroll
  for (int rt = 0; rt < 4; ++rt) {
    const int pr = half * 64 + rt * 16 + l15;
    const float tot = rowss[pr] + rowss[128 + pr] + rowss[256 + pr] + rowss[384 + pr];
    const float rstd = rsqrtf(tot * (1.f / 256.f) + 1e-6f);
#pragma unroll
    for (int ct = 0; ct < 4; ++ct) {
      const int c = g * 64 + ct * 16 + lq * 4;
      const float4 gg = *(const float4*)(og + c);
      uint2 o;
      o.x = pack2(acc[ct][rt][0] * rstd * gg.x, acc[ct][rt][1] * rstd * gg.y);
      o.y = pack2(acc[ct][rt][2] * rstd * gg.z, acc[ct][rt][3] * rstd * gg.w);
      *(uint2*)(p.cat + (size_t)(grow0 + pr) * DM + 256 + c) = o;
    }
  }
  __syncthreads();
}

DI int gla_row(int b, int c, int s) { return c < 4 ? (M_LAT + b * TC + c * 64 + s) : (b * TL + (c - 4) * 64 + s); }
DI int gla_slot(int c, int dir) { return dir == 0 ? c : (c < 4 ? 3 - c : 39 - c); }

DI void gla_cum2(const Params& p, int layer, int b, int h, int c, float* cum2, int tid) {
  const int lane = tid & 63, wave = tid >> 6;
  {
    const int s = tid >> 2, d0 = (tid & 3) * 8;
    const u16* zr = p.z + (size_t)gla_row(b, c, s) * ZW + h * 32 + d0;
    float zf[8], zb[8];
    unpack8(*(const uint4*)(zr + ZGF), zf);
    unpack8(*(const uint4*)(zr + ZGB), zb);
    const float* baf = p.gla_ba + (size_t)(layer * 2 + 0) * 128 + h * 32 + d0;
    const float* bab = p.gla_ba + (size_t)(layer * 2 + 1) * 128 + h * 32 + d0;
#pragma unroll
    for (int e = 0; e < 8; ++e) {
      cum2[s * 32 + d0 + e] = logsigmoid_f(zf[e] + baf[e]) * (1.f / 16.f);
      cum2[2048 + s * 32 + d0 + e] = logsigmoid_f(zb[e] + bab[e]) * (1.f / 16.f);
    }
  }
  __syncthreads();
  {
    float v[16];
#pragma unroll
    for (int i = 0; i < 16; ++i) {
      const int dir = i >> 3, d = wave * 8 + (i & 7);
      const int s = dir ? 63 - lane : lane;
      v[i] = cum2[dir * 2048 + s * 32 + d];
    }
#pragma unroll
    for (int i = 0; i < 16; ++i) v[i] = wave_incl_scan(v[i]);
#pragma unroll
    for (int i = 0; i < 16; ++i) {
      const int dir = i >> 3, d = wave * 8 + (i & 7);
      const int s = dir ? 63 - lane : lane;
      cum2[dir * 2048 + s * 32 + d] = v[i];
    }
  }
  __syncthreads();
}

DI void gla_stage_vt(const Params& p, int b, int h, int c, u16* Vt, int tid) {
#pragma unroll
  for (int i = 0; i < 2; ++i) {
    const int cc = tid + 256 * i, s = cc >> 3, ch = cc & 7;
    const uint4 vv = *(const uint4*)(p.z + (size_t)gla_row(b, c, s) * ZW + ZV + h * 64 + ch * 8);
    u16* vt = Vt + (ch * 8) * 72 + s;
    vt[0 * 72] = (u16)(vv.x & 0xffff); vt[1 * 72] = (u16)(vv.x >> 16);
    vt[2 * 72] = (u16)(vv.y & 0xffff); vt[3 * 72] = (u16)(vv.y >> 16);
    vt[4 * 72] = (u16)(vv.z & 0xffff); vt[5 * 72] = (u16)(vv.z >> 16);
    vt[6 * 72] = (u16)(vv.w & 0xffff); vt[7 * 72] = (u16)(vv.w >> 16);
  }
}

constexpr int GLA_SUB_BYTES = 56320;

DI void gla_a_item(const Params& p, int layer, int pi, char* smem) {
  const int tid0 = opaque_tid();
  const int tid = tid0 & 255, sub = tid0 >> 8;
  const int lane = tid & 63, wave = tid >> 6, l15 = lane & 15, lq = lane >> 4;
  const int item = 2 * pi + sub;
  char* base = smem + sub * GLA_SUB_BYTES;
  float* cum2 = (float*)base;
  u16* ktT = (u16*)(base + 16384);
  u16* Vt = (u16*)(base + 16384 + 9216);
  const int c = item % NSLOT, h = (item / NSLOT) & 3, b = item / (NSLOT * 4);
  const int s = tid >> 2, d0 = (tid & 3) * 8;
  const uint4 kraw = *(const uint4*)(p.z + (size_t)gla_row(b, c, s) * ZW + ZK + h * 32 + d0);
  gla_stage_vt(p, b, h, c, Vt, tid);
  gla_cum2(p, layer, b, h, c, cum2, tid);
  {
    float* cg = p.cumbuf + (size_t)item * 4096;
#pragma unroll
    for (int i = 0; i < 4; ++i) *(float4*)(cg + (i * 256 + tid) * 4) = *(const float4*)(cum2 + (i * 256 + tid) * 4);
  }
  const size_t sidx0 = ((size_t)((b * 4 + h) * 2 + 0) * NSLOT + gla_slot(c, 0));
  const size_t sidx1 = ((size_t)((b * 4 + h) * 2 + 1) * NSLOT + gla_slot(c, 1));
  {
    float kf[8];
    unpack8(kraw, kf);
#pragma unroll
    for (int e = 0; e < 8; ++e) {
      ktT[(d0 + e) * 72 + s] = f2bf(kf[e] * __expf(cum2[63 * 32 + d0 + e] - cum2[s * 32 + d0 + e]));
      ktT[2304 + (d0 + e) * 72 + s] = f2bf(kf[e] * __expf(cum2[2048 + d0 + e] - cum2[2048 + s * 32 + d0 + e]));
    }
    if (tid < 32) p.Dd[sidx0 * 32 + tid] = __expf(cum2[63 * 32 + tid]);
    else if (tid < 64) p.Dd[sidx1 * 32 + tid - 32] = __expf(cum2[2048 + tid - 32]);
  }
  __syncthreads();
#pragma unroll
  for (int dir = 0; dir < 2; ++dir) {
    float* Lp = p.L + (dir ? sidx1 : sidx0) * 2048;
#pragma unroll
    for (int dt = 0; dt < 2; ++dt) {
      f32x4 acc = f32x4{0.f, 0.f, 0.f, 0.f};
#pragma unroll
      for (int ks = 0; ks < 2; ++ks) {
        const bf16x8 a = *(const bf16x8*)(ktT + dir * 2304 + (dt * 16 + l15) * 72 + ks * 32 + lq * 8);
        const bf16x8 bb = *(const bf16x8*)(Vt + (wave * 16 + l15) * 72 + ks * 32 + lq * 8);
        acc = MFMA16(a, bb, acc);
      }
#pragma unroll
      for (int j = 0; j < 4; ++j) Lp[(dt * 16 + lq * 4 + j) * 64 + wave * 16 + l15] = acc[j];
    }
  }
  __syncthreads();
}

DI void phase_gla_b(const Params& p) {
  const int total = NB * 4 * 2 * 2048;
  for (int idx = blockIdx.x * NT + threadIdx.x; idx < total; idx += gridDim.x * NT) {
    const int chain = idx >> 11, de = idx & 2047, d = de >> 6;
    float* Lp = p.L + (size_t)chain * NSLOT * 2048 + de;
    const float* Dp = p.Dd + (size_t)chain * NSLOT * 32 + d;
    float loc[NSLOT], dec[NSLOT];
#pragma unroll
    for (int sl = 0; sl < NSLOT; ++sl) { loc[sl] = Lp[(size_t)sl * 2048]; dec[sl] = Dp[sl * 32]; }
    float S = 0.f;
#pragma unroll
    for (int sl = 0; sl < NSLOT; ++sl) {
      Lp[(size_t)sl * 2048] = S;
      S = dec[sl] * S + loc[sl];
    }
  }
}

DI void gla_c_item(const Params& p, int layer, int pi, char* smem) {
  const int tid0 = opaque_tid();
  const int tid = tid0 & 255, sub = tid0 >> 8;
  const int lane = tid & 63, wave = tid >> 6, l15 = lane & 15, lq = lane >> 4;
  const int item = 2 * pi + sub;
  char* base = smem + sub * GLA_SUB_BYTES;
  float* cum2 = (float*)base;
  u16* qt = (u16*)(base + 16384);
  u16* kh = (u16*)(base + 16384 + 10240);
  u16* St = (u16*)(base + 16384 + 20480);
  u16* Vt = (u16*)(base + 16384 + 30720);
  const int c = item % NSLOT, h = (item / NSLOT) & 3, b = item / (NSLOT * 4);
  const int s = tid >> 2, d0 = (tid & 3) * 8;
  const u16* zr = p.z + (size_t)gla_row(b, c, s) * ZW + h * 32 + d0;
  const uint4 qraw = *(const uint4*)(zr + ZQ), kraw = *(const uint4*)(zr + ZK);
  const int sd = tid >> 3, se0 = (tid & 7) * 8;
  const float* Lp0 = p.L + ((size_t)((b * 4 + h) * 2 + 0) * NSLOT + gla_slot(c, 0)) * 2048 + sd * 64 + se0;
  const float* Lp1 = p.L + ((size_t)((b * 4 + h) * 2 + 1) * NSLOT + gla_slot(c, 1)) * 2048 + sd * 64 + se0;
  const float4 sf0 = *(const float4*)Lp0, sf1 = *(const float4*)(Lp0 + 4), sb0 = *(const float4*)Lp1, sb1 = *(const float4*)(Lp1 + 4);
  const float* cg = p.cumbuf + (size_t)item * 4096 + s * 32 + d0;
  float cvv[2][8];
  *(float4*)&cvv[0][0] = *(const float4*)cg;          *(float4*)&cvv[0][4] = *(const float4*)(cg + 4);
  *(float4*)&cvv[1][0] = *(const float4*)(cg + 2048); *(float4*)&cvv[1][4] = *(const float4*)(cg + 2052);
  gla_stage_vt(p, b, h, c, Vt, tid);
  {
    float qf[8], kf[8];
    unpack8(qraw, qf);
    unpack8(kraw, kf);
#pragma unroll
    for (int dir = 0; dir < 2; ++dir) {
      float qo[8], ko[8];
#pragma unroll
      for (int e = 0; e < 8; ++e) {
        const float cv = cvv[dir][e];
        qo[e] = qf[e] * 0.17677669529663687f * __expf(cv);
        ko[e] = kf[e] * __expf(-cv);
      }
      *(uint4*)(qt + dir * 2560 + s * 40 + d0) = make_uint4(pack2(qo[0], qo[1]), pack2(qo[2], qo[3]), pack2(qo[4], qo[5]), pack2(qo[6], qo[7]));
      *(uint4*)(kh + dir * 2560 + s * 40 + d0) = make_uint4(pack2(ko[0], ko[1]), pack2(ko[2], ko[3]), pack2(ko[4], ko[5]), pack2(ko[6], ko[7]));
    }
    St[(se0 + 0) * 40 + sd] = f2bf(sf0.x); St[(se0 + 1) * 40 + sd] = f2bf(sf0.y); St[(se0 + 2) * 40 + sd] = f2bf(sf0.z); St[(se0 + 3) * 40 + sd] = f2bf(sf0.w);
    St[(se0 + 4) * 40 + sd] = f2bf(sf1.x); St[(se0 + 5) * 40 + sd] = f2bf(sf1.y); St[(se0 + 6) * 40 + sd] = f2bf(sf1.z); St[(se0 + 7) * 40 + sd] = f2bf(sf1.w);
    u16* St1 = St + 2560;
    St1[(se0 + 0) * 40 + sd] = f2bf(sb0.x); St1[(se0 + 1) * 40 + sd] = f2bf(sb0.y); St1[(se0 + 2) * 40 + sd] = f2bf(sb0.z); St1[(se0 + 3) * 40 + sd] = f2bf(sb0.w);
    St1[(se0 + 4) * 40 + sd] = f2bf(sb1.x); St1[(se0 + 5) * 40 + sd] = f2bf(sb1.y); St1[(se0 + 6) * 40 + sd] = f2bf(sb1.z); St1[(se0 + 7) * 40 + sd] = f2bf(sb1.w);
  }
  __syncthreads();
  f32x4 oT[4], aT[4];
#pragma unroll
  for (int i = 0; i < 4; ++i) { oT[i] = f32x4{0.f, 0.f, 0.f, 0.f}; aT[i] = f32x4{0.f, 0.f, 0.f, 0.f}; }
  const int tq = 16 * wave + l15;
#pragma unroll
  for (int dir = 0; dir < 2; ++dir) {
    const bf16x8 qb = *(const bf16x8*)(qt + dir * 2560 + tq * 40 + lq * 8);
#pragma unroll
    for (int st = 0; st < 4; ++st) {
      const bf16x8 ka = *(const bf16x8*)(kh + dir * 2560 + (st * 16 + l15) * 40 + lq * 8);
      f32x4 sv = f32x4{0.f, 0.f, 0.f, 0.f};
      sv = MFMA16(ka, qb, sv);
#pragma unroll
      for (int j = 0; j < 4; ++j) {
        const int si = st * 16 + lq * 4 + j;
        const bool valid = dir ? (si >= tq) : (si <= tq);
        aT[st][j] += valid ? sv[j] : 0.f;
      }
    }
#pragma unroll
    for (int et = 0; et < 4; ++et) {
      const bf16x8 sa = *(const bf16x8*)(St + dir * 2560 + (et * 16 + l15) * 40 + lq * 8);
      oT[et] = MFMA16(sa, qb, oT[et]);
    }
  }
#pragma unroll
  for (int kk = 0; kk < 2; ++kk) {
    const uint4 t4 = make_uint4(pack2(aT[2 * kk][0], aT[2 * kk][1]), pack2(aT[2 * kk][2], aT[2 * kk][3]),
                                pack2(aT[2 * kk + 1][0], aT[2 * kk + 1][1]), pack2(aT[2 * kk + 1][2], aT[2 * kk + 1][3]));
    const bf16x8 pb = __builtin_bit_cast(bf16x8, t4);
#pragma unroll
    for (int et = 0; et < 4; ++et) {
      const u16* vrow = Vt + (et * 16 + l15) * 72 + lq * 4 + (2 * kk) * 16;
      const uint2 lo = *(const uint2*)vrow;
      const uint2 hi = *(const uint2*)(vrow + 16);
      const bf16x8 va = __builtin_bit_cast(bf16x8, make_uint4(lo.x, lo.y, hi.x, hi.y));
      oT[et] = MFMA16(va, pb, oT[et]);
    }
  }
  float ss = 0.f;
#pragma unroll
  for (int et = 0; et < 4; ++et)
#pragma unroll
    for (int j = 0; j < 4; ++j) ss += oT[et][j] * oT[et][j];
  ss += __shfl_xor(ss, 16);
  ss += __shfl_xor(ss, 32);
  const float rstd = rsqrtf(ss * (1.f / 64.f) + 1e-6f);
  const int row = gla_row(b, c, tq);
#pragma unroll
  for (int et = 0; et < 4; ++et) {
    const int e0 = et * 16 + lq * 4;
    const uint2 ogv = *(const uint2*)(p.z + (size_t)row * ZW + ZOG + h * 64 + e0);
    const float og0 = __uint_as_float(ogv.x << 16), og1 = __uint_as_float(ogv.x & 0xffff0000u);
    const float og2 = __uint_as_float(ogv.y << 16), og3 = __uint_as_float(ogv.y & 0xffff0000u);
    const float4 gn = *(const float4*)(p.gla_norm + layer * 64 + e0);
    uint2 o;
    o.x = pack2(oT[et][0] * rstd * gn.x * silu_f(og0), oT[et][1] * rstd * gn.y * silu_f(og1));
    o.y = pack2(oT[et][2] * rstd * gn.z * silu_f(og2), oT[et][3] * rstd * gn.w * silu_f(og3));
    *(uint2*)(p.cat + (size_t)row * DM + h * 64 + e0) = o;
  }
  __syncthreads();
}

DI void swa_norm_rows(const Params& p, int layer, int Mrows) {
  const int tid = threadIdx.x, lane = tid & 63, wave = tid >> 6;
  const int sub = lane >> 4, l16 = lane & 15;
  const float* g = p.swa_out_g + layer * 512 + l16 * 32;
  for (int row = (blockIdx.x * 8 + wave) * 4 + sub; row < Mrows; row += gridDim.x * 32) {
    u16* cp = p.cat + (size_t)row * DM + 512 + l16 * 32;
    uint4 raw[4];
#pragma unroll
    for (int i = 0; i < 4; ++i) raw[i] = *(const uint4*)(cp + i * 8);
    float f[32];
    float ss = 0.f;
#pragma unroll
    for (int i = 0; i < 4; ++i) {
      unpack8(raw[i], f + i * 8);
#pragma unroll
      for (int e = 0; e < 8; ++e) ss += f[i * 8 + e] * f[i * 8 + e];
    }
    ss += __shfl_xor(ss, 1); ss += __shfl_xor(ss, 2); ss += __shfl_xor(ss, 4); ss += __shfl_xor(ss, 8);
    const float rstd = rsqrtf(ss * (1.f / 512.f) + 1e-6f);
#pragma unroll
    for (int i = 0; i < 4; ++i) {
      const float4 g0 = *(const float4*)(g + i * 8), g1 = *(const float4*)(g + i * 8 + 4);
      uint4 o;
      o.x = pack2(f[i * 8 + 0] * rstd * g0.x, f[i * 8 + 1] * rstd * g0.y); o.y = pack2(f[i * 8 + 2] * rstd * g0.z, f[i * 8 + 3] * rstd * g0.w);
      o.z = pack2(f[i * 8 + 4] * rstd * g1.x, f[i * 8 + 5] * rstd * g1.y); o.w = pack2(f[i * 8 + 6] * rstd * g1.z, f[i * 8 + 7] * rstd * g1.w);
      *(uint4*)(cp + i * 8) = o;
    }
  }
}

DI void phase_mix_a(const Params& p, int layer, char* smem) {
  const bool need_ctx = layer == 0;
  const int n_swa = 1024, n_swac = need_ctx ? 128 : 0, n_gm = need_ctx ? 288 : 256, n_gla = NB * 4 * NSLOT / 2;
  const int total = n_swa + n_swac + n_gm + n_gla;
  for (int item = blockIdx.x; item < total; item += gridDim.x) {
    int it = item;
    if (it < n_swa) { swa_item(p, layer, it, false, smem); continue; }
    it -= n_swa;
    if (it < n_swac) { swa_item(p, layer, it, true, smem); continue; }
    it -= n_swac;
    if (it < n_gm) { gmlp_item(p, layer, it, smem); continue; }
    it -= n_gm;
    gla_a_item(p, layer, it, smem);
  }
}

DI void phase_mix_c(const Params& p, int layer, char* smem) {
  const bool need_ctx = layer == 0;
  const int n_gla = NB * 4 * NSLOT / 2;
  for (int item = blockIdx.x; item < n_gla; item += gridDim.x) {
    const int c = (2 * item) % NSLOT;
    if (!need_ctx && c < 4) continue;
    gla_c_item(p, layer, item, smem);
  }
  swa_norm_rows(p, layer, need_ctx ? M_ALL : M_LAT);
}


#define XB_TMO      128
#define XB_XCNT(j)  (256  + 64 * (j))
#define XB_XSUB(j)  (1280 + 64 * (j))
#define XB_XGEN(j)  (2304 + 64 * (j))
#define XB_TOP      3328
#define XB_TOPGEN   3392
#define XCD_BAR_WORDS 3456
#define XB_SPIN_CAP (1u << 22)
#define LAS __attribute__((address_space(3)))
DI unsigned xb_ld(unsigned* p) { return __hip_atomic_load(p, __ATOMIC_RELAXED, __HIP_MEMORY_SCOPE_AGENT); }
DI unsigned xb_add(unsigned* p, unsigned v) { return __hip_atomic_fetch_add(p, v, __ATOMIC_RELAXED, __HIP_MEMORY_SCOPE_AGENT); }
DI unsigned xb_xcc_id() { return (unsigned)__builtin_amdgcn_s_getreg((3 << 11) | 20) & 0xFu; }
#define XB_SPIN(cond, bar) do { unsigned _sp = 0; while (cond) { __builtin_amdgcn_s_sleep(1); \
    if ((++_sp & 255u) == 0u) { if (xb_ld(&(bar)[XB_TMO])) break; if (_sp > XB_SPIN_CAP) { atomicAdd(&(bar)[XB_TMO], 1u); break; } } } } while (0)
struct XcdBarrier { unsigned* bar; unsigned x; volatile LAS unsigned* st; };
DI XcdBarrier xcd_barrier_post(unsigned* bar, volatile LAS unsigned* st) {
  XcdBarrier b; b.bar = bar; b.x = xb_xcc_id(); b.st = st;
  if (threadIdx.x == 0) (void)xb_add(&bar[XB_XCNT(b.x)], 1u);
  return b;
}
DI void xcd_barrier_complete(unsigned* bar, unsigned x, unsigned& nloc, unsigned& nx) {
  const unsigned G = gridDim.x * gridDim.y * gridDim.z;
  unsigned sum, cnt, mine, sp = 0u;
  for (;;) {
    sum = 0u; cnt = 0u; mine = 0u;
#pragma unroll
    for (unsigned j = 0; j < 16; ++j) { const unsigned c = xb_ld(&bar[XB_XCNT(j)]); sum += c; cnt += (c > 0u) ? 1u : 0u; mine = (j == x) ? c : mine; }
    if (sum == G) break;
    __builtin_amdgcn_s_sleep(1);
    if ((++sp & 255u) == 0u) { if (xb_ld(&bar[XB_TMO])) break; if (sp > XB_SPIN_CAP) { atomicAdd(&bar[XB_TMO], 1u); break; } }
  }
  nloc = mine > 0u ? mine : 1u; nx = cnt > 0u ? cnt : 1u;
}
DI void xcd_barrier(const XcdBarrier& b) {
  asm volatile("s_waitcnt vmcnt(0)" ::: "memory");
  __syncthreads();
  if (threadIdx.x == 0) {
    unsigned* bar = b.bar;
    __builtin_amdgcn_s_waitcnt(0);
    unsigned nloc = b.st[0], nx = b.st[1];
    if (nloc == 0u) { xcd_barrier_complete(bar, b.x, nloc, nx); b.st[0] = nloc; b.st[1] = nx; }
    const unsigned old = xb_add(&bar[XB_XSUB(b.x)], 1u);
    const unsigned gen = old / nloc;
    if (old + 1u == (gen + 1u) * nloc) {
      __builtin_amdgcn_fence(__ATOMIC_RELEASE, "agent");
      asm volatile("s_waitcnt vmcnt(0)" ::: "memory");
      const unsigned og = xb_add(&bar[XB_TOP], 1u);
      const unsigned tg = og / nx;
      if (og + 1u == (tg + 1u) * nx) xb_add(&bar[XB_TOPGEN], 1u);
      else XB_SPIN(xb_ld(&bar[XB_TOPGEN]) == tg, bar);
      __builtin_amdgcn_fence(__ATOMIC_ACQUIRE, "agent");
      xb_add(&bar[XB_XGEN(b.x)], 1u);
      asm volatile("s_waitcnt vmcnt(0)" ::: "memory");
    } else {
      XB_SPIN(xb_ld(&bar[XB_XGEN(b.x)]) == gen, bar);
      __builtin_amdgcn_fence(__ATOMIC_ACQUIRE, "agent");
      asm volatile("s_waitcnt vmcnt(0)" ::: "memory");
    }
  }
  __syncthreads();
}

constexpr int N_STEPS = 2 + 2 * 9;

DI void run_step(const Params& p, int step, char* smem) {
  if (step == 0) { phase_prep(p, smem, 0); return; }
  if (step == 1) { phase_rows(p, 0, M_ALL, 0, 0, 0, nullptr, true, 0, 0, p.n1_pre); return; }
  const int l = (step - 2) / 9, ph = (step - 2) % 9;
  const int Mo = l == 0 ? M_ALL : M_LAT;
  switch (ph) {
    case 0: if (l == 0) phase_gemm<2>(p.h, p.WinT + (size_t)l * ZW * DM, M_ALL, ZW, DM, p.z, ZW, smem, p.rope, p.vT);
            else phase_gemm<3>(p.h, p.WinT + (size_t)l * ZW * DM, M_ALL, ZW, DM, p.z, ZW, smem, p.rope, p.vT);
            break;
    case 1: phase_mix_a(p, l, smem); break;
    case 2: phase_gla_b(p); break;
    case 3: phase_mix_c(p, l, smem); break;
    case 4: phase_gemm<0>(p.cat, p.WoutT + (size_t)l * DM * DM, Mo, DM, DM, p.y, DM, smem); break;
    case 5: phase_rows(p, 1, Mo, l == 0 ? 1 : 2, l, 2, p.n1_post + l * DM, true, l, 3, p.n2_pre + l * DM); break;
    case 6: phase_gemm<1>(p.h, p.WguT + (size_t)l * 2 * DFF * DM, Mo, 2 * DFF, DM, p.act, DFF, smem); break;
    case 7: phase_gemm<0>(p.act, p.WdT + (size_t)l * DM * DFF, Mo, DM, DFF, p.y, DM, smem);
            if (l == 0) phase_prep(p, smem, 1);
            break;
    case 8: phase_rows(p, 1, Mo, l == 0 ? 2 : 3, l, 5, p.n2_post + l * DM, l == 0, l + 1, 0, p.n1_pre + (l + 1 < 2 ? l + 1 : 1) * DM); break;
  }
}

template <int S>
DI void run_one(const Params& p, int step_begin, int step_end, int use_cg, const XcdBarrier& xb, char* smem) {
  if (step_begin <= S && S < step_end) {
    run_step(p, S, smem);
    if (S + 1 < step_end) {
      if (use_cg) cg::this_grid().sync();
      else xcd_barrier(xb);
    }
  }
}

__global__ void __launch_bounds__(NT, 2) fwd_kernel(Params p_unused, int step_begin, int step_end, int use_cg) {
  __shared__ __attribute__((aligned(16))) char smem[SMEM_BYTES + 16];
  uint4& xb_words = *(uint4*)(smem + SMEM_BYTES);
  const Params& p = *(const Params*)__builtin_amdgcn_kernarg_segment_ptr();
  if (threadIdx.x == 0) xb_words = make_uint4(0u, 0u, 0u, 0u);
  __syncthreads();
  XcdBarrier xb = xcd_barrier_post(p.bar, (volatile LAS unsigned*)&xb_words);
  run_one<0>(p, step_begin, step_end, use_cg, xb, smem);  run_one<1>(p, step_begin, step_end, use_cg, xb, smem);
  run_one<2>(p, step_begin, step_end, use_cg, xb, smem);  run_one<3>(p, step_begin, step_end, use_cg, xb, smem);
  run_one<4>(p, step_begin, step_end, use_cg, xb, smem);  run_one<5>(p, step_begin, step_end, use_cg, xb, smem);
  run_one<6>(p, step_begin, step_end, use_cg, xb, smem);  run_one<7>(p, step_begin, step_end, use_cg, xb, smem);
  run_one<8>(p, step_begin, step_end, use_cg, xb, smem);  run_one<9>(p, step_begin, step_end, use_cg, xb, smem);
  run_one<10>(p, step_begin, step_end, use_cg, xb, smem); run_one<11>(p, step_begin, step_end, use_cg, xb, smem);
  run_one<12>(p, step_begin, step_end, use_cg, xb, smem); run_one<13>(p, step_begin, step_end, use_cg, xb, smem);
  run_one<14>(p, step_begin, step_end, use_cg, xb, smem); run_one<15>(p, step_begin, step_end, use_cg, xb, smem);
  run_one<16>(p, step_begin, step_end, use_cg, xb, smem); run_one<17>(p, step_begin, step_end, use_cg, xb, smem);
  run_one<18>(p, step_begin, step_end, use_cg, xb, smem); run_one<19>(p, step_begin, step_end, use_cg, xb, smem);
}

extern "C" void kernel_launch(void* const* d_in, const int* in_sizes, int n_in, void* d_out, int out_size, void* d_ws,
                              size_t ws_size, hipStream_t stream) {
  static int grid_blocks = 0;
  if (!grid_blocks) {
    int dev = 0, cus = 0, per_cu = 0;
    hipGetDevice(&dev);
    hipDeviceGetAttribute(&cus, hipDeviceAttributeMultiprocessorCount, dev);
    hipOccupancyMaxActiveBlocksPerMultiprocessor(&per_cu, fwd_kernel, NT, 0);
    if (per_cu < 1) per_cu = 1;
    if (per_cu > 1) per_cu = 1;
    grid_blocks = cus * per_cu;
  }
  Params p{};
  const float** fp = (const float**)&p;
  for (int i = 0; i < 24; ++i) fp[i] = (const float*)d_in[i];
  p.out = (float*)d_out;
  char* w = (char*)d_ws;
  size_t off = 0;
  auto take = [&](size_t bytes) { char* r = w + off; off += (bytes + 255) & ~(size_t)255; return r; };
  p.WinT = (u16*)take((size_t)2 * ZW * DM * 2);
  p.WoutT = (u16*)take((size_t)2 * DM * DM * 2);
  p.WguT = (u16*)take((size_t)2 * 2 * DFF * DM * 2);
  p.WdT = (u16*)take((size_t)2 * DM * DFF * 2);
  p.mod = (float*)take((size_t)2 * 17 * 6144 * 4);
  p.rope = (float*)take((size_t)TL * 32 * 2 * 4);
  p.h = (u16*)take((size_t)M_ALL * DM * 2);
  p.z = (u16*)take((size_t)M_ALL * ZW * 2);
  p.cat = (u16*)take((size_t)M_ALL * DM * 2);
  p.act = p.z;
  p.y = p.h;
  p.xr = (u16*)take((size_t)M_LAT * DM * 2);
  p.xc = (u16*)take((size_t)M_CTX * DM * 2);
  p.L = (float*)take((size_t)NB * 4 * 2 * NSLOT * 2048 * 4);
  p.Dd = (float*)take((size_t)NB * 4 * 2 * NSLOT * 32 * 4);
  p.bar = (unsigned*)take((size_t)XCD_BAR_WORDS * 4);
  p.vT = (u16*)take((size_t)288 * 2 * 64 * 128 * 2);
  p.cumbuf = (float*)p.h;
  if (off > ws_size) { fprintf(stderr, "workspace too small: need %zu have %zu\n", off, ws_size); return; }
#if MK_ONE_LAUNCH
  int sb = 0, se = N_STEPS, use_cg = 0;
  void* args[] = {&p, &sb, &se, &use_cg};
  (void)hipMemsetAsync(p.bar, 0, (size_t)XCD_BAR_WORDS * 4, stream);
  hipError_t e = hipLaunchCooperativeKernel((void*)fwd_kernel, dim3(grid_blocks), dim3(NT), args, 0, stream);
  if (e != hipSuccess) fprintf(stderr, "cooperative launch failed: %s (grid %d)\n", hipGetErrorString(e), grid_blocks);
#else
  for (int s = 0; s < N_STEPS; ++s) fwd_kernel<<<grid_blocks, NT, 0, stream>>>(p, s, s + 1, 0);
#endif
}
```

```cpp
#include <hip/hip_runtime.h>
#include <hip/hip_cooperative_groups.h>
#include <cstdio>
namespace cg = cooperative_groups;

#ifndef MK_ONE_LAUNCH
#define MK_ONE_LAUNCH 1
#endif

#define DI __device__ __forceinline__
typedef unsigned short u16;
using bf16x8 = __attribute__((ext_vector_type(8))) short;
using f32x4 = __attribute__((ext_vector_type(4))) float;
#define MFMA16(a, b, c) __builtin_amdgcn_mfma_f32_16x16x32_bf16((a), (b), (c), 0, 0, 0)

constexpr int NT = 512;
constexpr int ST = 256;
constexpr int DM = 1024;
constexpr int NB = 16;
constexpr int TL = 2048;
constexpr int TC = 256;
constexpr int M_LAT = NB * TL;
constexpr int M_CTX = NB * TC;
constexpr int M_ALL = M_LAT + M_CTX;
constexpr int ZW = 2304;
constexpr int IN_COLS = 2080;
constexpr int DFF = 2816;
constexpr int ZQ = 0, ZK = 128, ZV = 256, ZOG = 512, ZGU = 768, ZGV = 1024, ZSQ = 1280, ZSK = 1792, ZSV = 1920, ZGF = 2048, ZGB = 2176;
constexpr int NSLOT = 36;
constexpr int SMEM_BYTES = 147456;

struct Params {
  const float *x, *c, *ctx, *c_ctx, *mod_w, *mod_b, *n1_pre, *n1_post, *n2_pre, *n2_post, *w_in, *w_out,
      *gla_wa2, *gla_ba, *gla_norm, *gmlp_ln_g, *gmlp_ln_b, *gmlp_ws, *gmlp_bs, *gmlp_out_g, *swa_sink, *swa_out_g,
      *ffn_w_gu, *ffn_w_down;
  float* out;
  u16 *WinT, *WoutT, *WguT, *WdT;
  float *mod, *rope, *cumbuf;
  u16 *h, *z, *cat, *y, *act;
  u16 *xc, *xr; float *L, *Dd;
  unsigned* bar;
  u16* vT;
};

DI u16 f2bf(float f) { const __bf16 hv = (__bf16)f; return __builtin_bit_cast(u16, hv); }
DI float bf2f(u16 h) { return __uint_as_float(((unsigned)h) << 16); }
typedef __bf16 bf16x2_t __attribute__((ext_vector_type(2)));
typedef float f32x2_t __attribute__((ext_vector_type(2)));
DI unsigned pack2(float a, float b) { f32x2_t v = {a, b}; bf16x2_t r = __builtin_convertvector(v, bf16x2_t); return __builtin_bit_cast(unsigned, r); }
DI f32x2_t gelu_pk(f32x2_t v) {
  const f32x2_t av = __builtin_elementwise_abs(v), d = av * 0.2316418882f + 1.0f;
  f32x2_t t; t.x = __builtin_amdgcn_rcpf(d.x); t.y = __builtin_amdgcn_rcpf(d.y);
  f32x2_t q = t * 0.5307027145f + (-0.7265760135f); q = q * t + 0.7107068705f; q = q * t + (-0.142248368f); q = q * t + 0.127414796f; q = q * t;
  const f32x2_t s = (v * v) * (-0.72134752044f);
  f32x2_t e; e.x = __builtin_amdgcn_exp2f(s.x); e.y = __builtin_amdgcn_exp2f(s.y);
  const f32x2_t m = v * (q * e), r = v - m;
  f32x2_t o; o.x = v.x < 0.f ? m.x : r.x; o.y = v.y < 0.f ? m.y : r.y; return o;
}
DI int opaque_tid() { int t = threadIdx.x; asm volatile("" : "+v"(t)); return t; }
template <int CTRL, int ROWMASK>
DI float dpp_acc(float v) { const int t = __builtin_amdgcn_update_dpp(0, __float_as_int(v), CTRL, ROWMASK, 0xf, false); return v + __int_as_float(t); }
DI float wave_incl_scan(float v) {
  v = dpp_acc<0x111, 0xf>(v); v = dpp_acc<0x112, 0xf>(v); v = dpp_acc<0x114, 0xf>(v); v = dpp_acc<0x118, 0xf>(v);
  v = dpp_acc<0x142, 0xa>(v); v = dpp_acc<0x143, 0xc>(v);
  return v;
}
DI float wave_sum(float v) { return __int_as_float(__builtin_amdgcn_readlane(__float_as_int(wave_incl_scan(v)), 63)); }
DI float silu_f(float x) { return x * __builtin_amdgcn_rcpf(1.f + __expf(-x)); }
DI float gelu_f(float x) { return 0.5f * x * (1.f + erff(x * 0.70710678118654752f)); }
DI float logsigmoid_f(float z) { return fminf(z, 0.f) - __logf(1.f + __expf(-fabsf(z))); }
DI void unpack8(const uint4& v, float* f) {
  f[0] = __uint_as_float(v.x << 16); f[1] = __uint_as_float(v.x & 0xffff0000u);
  f[2] = __uint_as_float(v.y << 16); f[3] = __uint_as_float(v.y & 0xffff0000u);
  f[4] = __uint_as_float(v.z << 16); f[5] = __uint_as_float(v.z & 0xffff0000u);
  f[6] = __uint_as_float(v.w << 16); f[7] = __uint_as_float(v.w & 0xffff0000u);
}

DI int colmap_win(int n) { return n < 768 ? n : n + 32; }
DI int colmap_gu(int n) { int pn = n >> 8, w = n & 255; return pn * 128 + (w & 127) + ((w & 128) ? DFF : 0); }

template <int CM>
DI void transpose_tile(const float* __restrict__ src, int ld_src, int k0, int n0, u16* __restrict__ dst, int K, float* tile) {
  const int tid = threadIdx.x & 255;
  {
    const int j = tid & 63, i0 = tid >> 6;
    const int n = n0 + j;
    const int col = CM == 1 ? colmap_win(n) : (CM == 2 ? colmap_gu(n) : n);
#pragma unroll
    for (int ii = 0; ii < 16; ++ii) {
      const int k = i0 + 4 * ii;
      tile[k * 65 + j] = src[(size_t)(k0 + k) * ld_src + col];
    }
  }
  __syncthreads();
  {
    const int kk = tid & 63, nn0 = tid >> 6;
#pragma unroll
    for (int ii = 0; ii < 16; ++ii) {
      const int n = nn0 + 4 * ii;
      dst[(size_t)(n0 + n) * K + k0 + kk] = f2bf(tile[kk * 65 + n]);
    }
  }
  __syncthreads();
}

DI void phase_prep(const Params& p, char* smem, int part) {
  const int sub = threadIdx.x >> 8;
  float* sf = (float*)smem + sub * 4352;
  float* stab = (float*)smem + 2 * 4352;
  const int tid = threadIdx.x & 255, lane = tid & 63, wave = tid >> 6;
  constexpr int N_TR_L = 512 + 256 + 1408 + 704;
  constexpr int N_TR = 2 * N_TR_L;
  constexpr int N_FOLD = 64, N_MOD = 192, N_ROPE = 256;
  constexpr int N_ALL = N_TR + N_FOLD + N_MOD + N_ROPE;
  constexpr int P_TRF = (N_TR_L + 32) / 2;
  const int nitems = part == 0 ? (N_MOD + P_TRF + N_ROPE / 2) : P_TRF;
  const int skip = (part == 1 && gridDim.x > 128) ? 64 : 0;
  const int bid = (int)blockIdx.x - skip;
  const int nb = (int)gridDim.x - skip;
  if (bid < 0) return;
  for (int pi = bid; pi < nitems; pi += nb) {
    int item;
    if (part == 0) {
      if (pi < N_MOD) item = N_TR + N_FOLD + pi;
      else if (pi < N_MOD + P_TRF) { const int q = 2 * (pi - N_MOD) + sub; item = q < N_TR_L ? q : N_TR + (q - N_TR_L); }
      else item = N_TR + N_FOLD + N_MOD + 2 * (pi - N_MOD - P_TRF) + sub;
    } else {
      const int q = 2 * pi + sub;
      item = q < N_TR_L ? N_TR_L + q : N_TR + 32 + (q - N_TR_L);
    }
    if (item < N_TR) {
      const int l = item / N_TR_L;
      int r = item - l * N_TR_L;
      if (r < 512) {
        transpose_tile<1>(p.w_in + (size_t)l * DM * IN_COLS, IN_COLS, (r >> 5) * 64, (r & 31) * 64, p.WinT + (size_t)l * ZW * DM, DM, sf);
      } else if (r < 768) {
        r -= 512;
        transpose_tile<0>(p.w_out + (size_t)l * DM * DM, DM, (r >> 4) * 64, (r & 15) * 64, p.WoutT + (size_t)l * DM * DM, DM, sf);
      } else if (r < 2176) {
        r -= 768;
        transpose_tile<2>(p.ffn_w_gu + (size_t)l * DM * 2 * DFF, 2 * DFF, (r / 88) * 64, (r % 88) * 64, p.WguT + (size_t)l * 2 * DFF * DM, DM, sf);
      } else {
        r -= 2176;
        transpose_tile<0>(p.ffn_w_down + (size_t)l * DFF * DM, DM, (r >> 4) * 64, (r & 15) * 64, p.WdT + (size_t)l * DM * DFF, DFF, sf);
      }
    } else if (item < N_TR + N_FOLD) {
      const int idx = item - N_TR;
      const int l = idx >> 5, dir = (idx >> 4) & 1, k0 = (idx & 15) * 64;
      float* wa = sf;
      float* cd = sf + 2048;
      const float* wa2 = p.gla_wa2 + (size_t)(l * 2 + dir) * 16 * 128;
      for (int i = tid; i < 2048; i += ST) wa[i] = wa2[i];
      for (int i = tid; i < 1024; i += ST) {
        const int kk = i >> 4, r = i & 15;
        cd[kk * 17 + r] = p.w_in[(size_t)l * DM * IN_COLS + (size_t)(k0 + kk) * IN_COLS + 768 + dir * 16 + r];
      }
      __syncthreads();
      const int kk = tid & 63, jg = tid >> 6;
      u16* dst = p.WinT + (size_t)l * ZW * DM;
      for (int jj = 0; jj < 32; ++jj) {
        const int j = jg * 32 + jj;
        float s = 0.f;
#pragma unroll
        for (int r = 0; r < 16; ++r) s += cd[kk * 17 + r] * wa[r * 128 + j];
        dst[(size_t)(ZGF + dir * 128 + j) * DM + k0 + kk] = f2bf(s);
      }
      __syncthreads();
    } else if (item < N_TR + N_FOLD + N_MOD) {
      const int cgi = item - N_TR - N_FOLD;
      const int gc = cgi * 64 + lane;
      const int l = gc / 6144, n = gc - l * 6144;
      for (int i = threadIdx.x; i < 17 * 1024; i += NT) {
        const float v = i < 16 * 1024 ? p.c[i] : p.c_ctx[i - 16 * 1024];
        stab[i] = silu_f(v);
      }
      __syncthreads();
      float acc[17];
#pragma unroll
      for (int r = 0; r < 17; ++r) acc[r] = 0.f;
      const float* W = p.mod_w + (size_t)l * DM * 6144 + n;
      const int kb = (threadIdx.x >> 6) * 128;
#pragma unroll 4
      for (int k = kb; k < kb + 128; ++k) {
        const float wv = W[(size_t)k * 6144];
#pragma unroll
        for (int r = 0; r < 17; ++r) acc[r] += stab[r * 1024 + k] * wv;
      }
      __syncthreads();
#pragma unroll
      for (int r = 0; r < 17; ++r) sf[(wave * 17 + r) * 64 + lane] = acc[r];
      __syncthreads();
      for (int o = threadIdx.x; o < 17 * 64; o += NT) {
        const int r = o >> 6, ln = o & 63;
        const float* s0 = (const float*)smem;
        float s = 0.f;
#pragma unroll
        for (int w8 = 0; w8 < 8; ++w8) s += s0[(w8 >> 2) * 4352 + ((w8 & 3) * 17 + r) * 64 + ln];
        const int nn = cgi * 64 + ln - l * 6144;
        p.mod[(size_t)(l * 17 + r) * 6144 + nn] = s + p.mod_b[l * 6144 + nn];
      }
      __syncthreads();
    } else {
      const int idx = item - N_TR - N_FOLD - N_MOD;
      const int e = idx * 256 + tid;
      const int t = e >> 5, f = e & 31;
      const int fi = f & 15;
      const float inv = powf(10000.f, -(float)(2 * fi) / 32.f);
      const float pos = f < 16 ? (float)(t >> 6) : (float)(t & 63);
      const float ang = pos * inv;
      p.rope[e * 2 + 0] = cosf(ang);
      p.rope[e * 2 + 1] = sinf(ang);
    }
  }
}

DI void rows_chunk(const Params& p, int mode, int row0, int nrows, int mrow, const void* xin, bool xin_bf, void* xout, bool xout_bf,
                   int l_in, int gate_idx, const float* gpost, bool write_h, int l_out, int sh_idx, const float* gpre, int lane) {
  float4 G[4], A[4], Sh[4];
#pragma unroll
  for (int i = 0; i < 4; ++i) {
    const int c0 = lane * 4 + 256 * i;
    if (mode == 1) {
      const float4 g = *(const float4*)(gpost + c0);
      const float4 gt = *(const float4*)(p.mod + (size_t)(l_in * 17 + mrow) * 6144 + gate_idx * 1024 + c0);
      G[i] = make_float4(g.x * gt.x, g.y * gt.y, g.z * gt.z, g.w * gt.w);
    }
    if (write_h) {
      const float* sh = p.mod + (size_t)(l_out * 17 + mrow) * 6144 + sh_idx * 1024 + c0;
      const float4 g = *(const float4*)(gpre + c0);
      const float4 s = *(const float4*)(sh + 1024);
      Sh[i] = *(const float4*)sh;
      A[i] = make_float4(g.x * (1.f + s.x), g.y * (1.f + s.y), g.z * (1.f + s.z), g.w * (1.f + s.w));
    }
  }
  float4 xn[4]; uint2 xb[4]; uint2 yn[4];
#define ROWS_LOAD(R) do { \
    const u16* yr_ = p.y + (size_t)(row0 + (R)) * DM + lane * 4; \
    _Pragma("unroll") for (int i = 0; i < 4; ++i) { \
      if (xin_bf) xb[i] = *(const uint2*)((const u16*)xin + (size_t)(R) * DM + lane * 4 + 256 * i); \
      else xn[i] = *(const float4*)((const float*)xin + (size_t)(R) * DM + lane * 4 + 256 * i); \
      if (mode == 1) yn[i] = *(const uint2*)(yr_ + 256 * i); } } while (0)
  ROWS_LOAD(0);
  for (int r = 0; r < nrows; ++r) {
    float4 xv[4]; uint2 yu[4];
#pragma unroll
    for (int i = 0; i < 4; ++i) {
      if (xin_bf) {
        xv[i].x = __uint_as_float(xb[i].x << 16); xv[i].y = __uint_as_float(xb[i].x & 0xffff0000u);
        xv[i].z = __uint_as_float(xb[i].y << 16); xv[i].w = __uint_as_float(xb[i].y & 0xffff0000u);
      } else xv[i] = xn[i];
      yu[i] = yn[i];
    }
    if (r + 1 < nrows) ROWS_LOAD(r + 1);
    if (mode == 1) {
      float4 yv[4];
      float ss = 0.f;
#pragma unroll
      for (int i = 0; i < 4; ++i) {
        yv[i].x = __uint_as_float(yu[i].x << 16); yv[i].y = __uint_as_float(yu[i].x & 0xffff0000u);
        yv[i].z = __uint_as_float(yu[i].y << 16); yv[i].w = __uint_as_float(yu[i].y & 0xffff0000u);
        ss += yv[i].x * yv[i].x + yv[i].y * yv[i].y + yv[i].z * yv[i].z + yv[i].w * yv[i].w;
      }
      ss = wave_sum(ss);
      const float rstd = rsqrtf(ss * (1.f / DM) + 1e-6f);
#pragma unroll
      for (int i = 0; i < 4; ++i) {
        xv[i].x += G[i].x * (yv[i].x * rstd);
        xv[i].y += G[i].y * (yv[i].y * rstd);
        xv[i].z += G[i].z * (yv[i].z * rstd);
        xv[i].w += G[i].w * (yv[i].w * rstd);
        if (xout_bf) {
          uint2 o; o.x = pack2(xv[i].x, xv[i].y); o.y = pack2(xv[i].z, xv[i].w);
          *(uint2*)((u16*)xout + (size_t)r * DM + lane * 4 + 256 * i) = o;
          xv[i].x = __uint_as_float(o.x << 16); xv[i].y = __uint_as_float(o.x & 0xffff0000u);
          xv[i].z = __uint_as_float(o.y << 16); xv[i].w = __uint_as_float(o.y & 0xffff0000u);
        } else {
          *(float4*)((float*)xout + (size_t)r * DM + lane * 4 + 256 * i) = xv[i];
        }
      }
    }
    if (write_h) {
      float ss = 0.f;
#pragma unroll
      for (int i = 0; i < 4; ++i) ss += xv[i].x * xv[i].x + xv[i].y * xv[i].y + xv[i].z * xv[i].z + xv[i].w * xv[i].w;
      ss = wave_sum(ss);
      const float rstd = rsqrtf(ss * (1.f / DM) + 1e-6f);
      u16* hr = p.h + (size_t)(row0 + r) * DM + lane * 4;
#pragma unroll
      for (int i = 0; i < 4; ++i) {
        uint2 o;
        o.x = pack2(xv[i].x * rstd * A[i].x + Sh[i].x, xv[i].y * rstd * A[i].y + Sh[i].y);
        o.y = pack2(xv[i].z * rstd * A[i].z + Sh[i].z, xv[i].w * rstd * A[i].w + Sh[i].w);
        *(uint2*)(hr + 256 * i) = o;
      }
    }
  }
#undef ROWS_LOAD
}

DI void phase_rows(const Params& p, int mode, int Mrows, int stage, int l_in, int gate_idx, const float* gpost,
                   bool write_h, int l_out, int sh_idx, const float* gpre) {
  const int tid = threadIdx.x, lane = tid & 63, wave = tid >> 6;
  const int nw = gridDim.x * 8;
  const bool xin_bf = stage >= 2, xout_bf = stage != 3;
  for (int ch = blockIdx.x * 8 + wave; ch < M_LAT / 16; ch += nw) {
    const int row0 = ch * 16;
    const void* xin = xin_bf ? (const void*)(p.xr + (size_t)row0 * DM) : (const void*)(p.x + (size_t)row0 * DM);
    void* xout = xout_bf ? (void*)(p.xr + (size_t)row0 * DM) : (void*)(p.out + (size_t)row0 * DM);
    rows_chunk(p, mode, row0, 16, row0 >> 11, xin, xin_bf, xout, xout_bf, l_in, gate_idx, gpost, write_h, l_out, sh_idx, gpre, lane);
  }
  if (Mrows > M_LAT) {
    for (int ch = blockIdx.x * 8 + wave; ch < M_CTX / 2; ch += nw) {
      const int rc = ch * 2;
      const void* xin = xin_bf ? (const void*)(p.xc + (size_t)rc * DM) : (const void*)(p.ctx + (size_t)rc * DM);
      rows_chunk(p, mode, M_LAT + rc, 2, 16, xin, xin_bf, (void*)(p.xc + (size_t)rc * DM), true, l_in, gate_idx, gpost, write_h, l_out, sh_idx, gpre, lane);
    }
  }
}

namespace pg8 {
#define PG8_LAS __attribute__((address_space(3)))
typedef unsigned short bf16_t;
typedef short bf16x8 __attribute__((ext_vector_type(8)));
typedef float f32x4 __attribute__((ext_vector_type(4)));
typedef unsigned u32x4 __attribute__((ext_vector_type(4)));
constexpr int BM = 256, BK = 64, HALF = 128, HTB = HALF * BK * 2  , STAGE_BYTES = 8 * HTB, NXCD = 8, WGM = 4;

__host__ __device__ __forceinline__ int lds_byte(int r, int c) { const int st = (r >> 4) * 2 + (c >> 5), rr = r & 15, cc = c & 31, ob = rr * 64 + cc * 2; return st * 1024 + (ob ^ (((ob >> 9) & 1) << 5)); }
__host__ __device__ __forceinline__ void stage_rc(int b, int& R, int& C) { const int st = b / 1024, sb = b % 1024, swz = sb ^ (((sb >> 9) & 1) << 5); R = (st >> 1) * 16 + swz / 64; C = (st & 1) * 32 + (swz % 64) / 2; }
__host__ __device__ __forceinline__ int perm32(int rho) { const int n = rho >> 4, i = rho & 15; return 8 * (i >> 2) + 4 * n + (i & 3); }

struct Unit { int pm, pn; };
struct Gemm { const bf16_t* A; const bf16_t* Bt; int M, N, K; };

struct StaticOrder {
    int nM, nN, nwg, G, c;
    __host__ __device__ void init(int M, int N, int G_, int c_) { nM = M / BM; nN = N / BM; nwg = nM * nN; G = G_; c = c_; }
    __host__ __device__ bool next(int i, Unit& u) const {
        const long L = (long)i * G + c; if (L >= nwg) return false;
        int wgid = (int)L; { const int q = nwg / NXCD, r = nwg % NXCD, xcd = wgid % NXCD, off = wgid / NXCD; wgid = (xcd < r ? xcd * (q + 1) : r * (q + 1) + (xcd - r) * q) + off; }
        const int nig = WGM * nN, gid = wgid / nig, fm = gid * WGM, gsz = (nM - fm) < WGM ? (nM - fm) : WGM;
        u.pm = fm + ((wgid % nig) % gsz); u.pn = (wgid % nig) / gsz; return true;
    }
    __device__ __forceinline__ void a_ready(const Unit&) const {}
    __device__ __forceinline__ void done(const Unit&) const {}
};
__device__ __forceinline__ unsigned cvt_pk_bf16(float lo, float hi) { return pack2(lo, hi); }

struct InProjLastOrder : StaticOrder {
    __host__ __device__ void init2(int G_, int c_) { init(32768, 2304, G_, c_); }
    __host__ __device__ bool next(int i, Unit& u) const {
        const long L = (long)i * G + c;
        if (L < nwg) return StaticOrder::next(i, u);
        const int j = (int)(L - nwg); if (j >= 64) return false;
        const int k = j & 3; u.pm = 128 + (j >> 2); u.pn = k < 2 ? k : k + 5; return true;
    }
};
struct EpiStoreBf16 {
    static constexpr bool PERM = true, AFTER_DRAIN = false;
    bf16_t* O; int ldc;
    __device__ __forceinline__ void operator()(const f32x4 (&acc)[2][2][4][2], const Unit& u, int wr, int wc, int fr, int fq) const {
        const int row0 = u.pm * BM + wr * 64 + fr, col0 = u.pn * BM + wc * 32 + 8 * fq;
#pragma unroll
        for (int ai = 0; ai < 2; ++ai)
#pragma unroll
            for (int m = 0; m < 4; ++m) { bf16_t* rowp = O + (size_t)(row0 + ai * HALF + m * 16) * ldc + col0;
#pragma unroll
                for (int bj = 0; bj < 2; ++bj) { const f32x4 v0 = acc[ai][bj][m][0], v1 = acc[ai][bj][m][1];
                    u32x4 w; w.x = cvt_pk_bf16(v0[0], v0[1]); w.y = cvt_pk_bf16(v0[2], v0[3]); w.z = cvt_pk_bf16(v1[0], v1[1]); w.w = cvt_pk_bf16(v1[2], v1[3]);
                    *(u32x4*)(rowp + bj * HALF) = w; } }
    }
};
struct EpiInProj {
    static constexpr bool PERM = true, AFTER_DRAIN = false;
    bf16_t* O; int ldc; const float* rope; bf16_t* vT;
    static __device__ __forceinline__ void rot(f32x4& v0, f32x4& v1, const f32x4 (&c)[4], float sg) {
        const float q0 = __shfl_xor(v0[0], 32), q1 = __shfl_xor(v0[1], 32), q2 = __shfl_xor(v0[2], 32), q3 = __shfl_xor(v0[3], 32);
        const float r0 = __shfl_xor(v1[0], 32), r1 = __shfl_xor(v1[1], 32), r2 = __shfl_xor(v1[2], 32), r3 = __shfl_xor(v1[3], 32);
        v0[0] = v0[0] * c[0][0] + sg * q0 * c[0][1]; v0[1] = v0[1] * c[0][2] + sg * q1 * c[0][3];
        v0[2] = v0[2] * c[1][0] + sg * q2 * c[1][1]; v0[3] = v0[3] * c[1][2] + sg * q3 * c[1][3];
        v1[0] = v1[0] * c[2][0] + sg * r0 * c[2][1]; v1[1] = v1[1] * c[2][2] + sg * r1 * c[2][3];
        v1[2] = v1[2] * c[3][0] + sg * r2 * c[3][1]; v1[3] = v1[3] * c[3][2] + sg * r3 * c[3][3];
    }
    __device__ __forceinline__ void emit(f32x4 v0, f32x4 v1, const Unit& u, int row, int col0, int bj, int wc, int fq, bool lat, bool dorot, const f32x4 (&c)[4], float sg) const {
        constexpr float QS = 0.125f * 1.4426950408889634f;
        if (u.pn == 7 && bj == 1) {
            const int blk = lat ? (row >> 7) : (256 + ((row - 32768) >> 7));
            const int d0 = wc * 32 + 8 * fq;
            bf16_t* vp = vT + ((size_t)(blk * 2 + (d0 >> 6)) * 64 + (d0 & 63)) * 128 + (row & 127);
#pragma unroll
            for (int j = 0; j < 4; ++j) { vp[j * 128] = f2bf(v0[j]); vp[(4 + j) * 128] = f2bf(v1[j]); }
            return;
        }
        if (dorot) rot(v0, v1, c, sg);
        if (u.pn < 7) { v0 *= QS; v1 *= QS; }
        u32x4 w; w.x = cvt_pk_bf16(v0[0], v0[1]); w.y = cvt_pk_bf16(v0[2], v0[3]); w.z = cvt_pk_bf16(v1[0], v1[1]); w.w = cvt_pk_bf16(v1[2], v1[3]);
        *(u32x4*)(O + (size_t)row * ldc + col0 + bj * HALF) = w;
    }
    __device__ __forceinline__ void operator()(const f32x4 (&acc)[2][2][4][2], const Unit& u, int wr, int wc, int fr, int fq) const {
        const int row0 = u.pm * BM + wr * 64 + fr, col0 = u.pn * BM + wc * 32 + 8 * fq;
        const bool swa = (u.pn >= 5) && (u.pn <= 7);
        if (!swa) {
#pragma unroll
            for (int ai = 0; ai < 2; ++ai)
#pragma unroll
                for (int m = 0; m < 4; ++m) { bf16_t* rowp = O + (size_t)(row0 + ai * HALF + m * 16) * ldc + col0;
#pragma unroll
                    for (int bj = 0; bj < 2; ++bj) { const f32x4 v0 = acc[ai][bj][m][0], v1 = acc[ai][bj][m][1];
                        u32x4 w; w.x = cvt_pk_bf16(v0[0], v0[1]); w.y = cvt_pk_bf16(v0[2], v0[3]); w.z = cvt_pk_bf16(v1[0], v1[1]); w.w = cvt_pk_bf16(v1[2], v1[3]);
                        *(u32x4*)(rowp + bj * HALF) = w; } }
            return;
        }
        const bool lat = u.pm < 128;
        const float sg = (fq < 2) ? -1.f : 1.f;
        if (wc & 1) {
#pragma unroll
            for (int m = 0; m < 4; ++m) {
                f32x4 c[4];
                if (lat) { const float* rp = rope + ((size_t)(16 * m + fr) * 32 + 16 + 8 * (fq & 1)) * 2;
#pragma unroll
                    for (int k = 0; k < 4; ++k) c[k] = *(const f32x4*)(rp + 4 * k); }
#pragma unroll
                for (int ai = 0; ai < 2; ++ai)
#pragma unroll
                    for (int bj = 0; bj < 2; ++bj) emit(acc[ai][bj][m][0], acc[ai][bj][m][1], u, row0 + ai * HALF + m * 16, col0, bj, wc, fq, lat, lat, c, sg);
                __builtin_amdgcn_sched_barrier(0);
            }
        } else {
#pragma unroll
            for (int ai = 0; ai < 2; ++ai) {
                f32x4 c[4];
                if (lat) { const float* rp = rope + ((size_t)((row0 + ai * HALF) & 2047) * 32 + 8 * (fq & 1)) * 2;
#pragma unroll
                    for (int k = 0; k < 4; ++k) c[k] = *(const f32x4*)(rp + 4 * k); }
#pragma unroll
                for (int m = 0; m < 4; ++m)
#pragma unroll
                    for (int bj = 0; bj < 2; ++bj) emit(acc[ai][bj][m][0], acc[ai][bj][m][1], u, row0 + ai * HALF + m * 16, col0, bj, wc, fq, lat, lat, c, sg);
                __builtin_amdgcn_sched_barrier(0);
            }
        }
    }
};
struct EpiSwiglu {
    static constexpr bool PERM = true, AFTER_DRAIN = false;
    bf16_t* O; int ldc;
    __device__ __forceinline__ void operator()(const f32x4 (&acc)[2][2][4][2], const Unit& u, int wr, int wc, int fr, int fq) const {
        const int row0 = u.pm * BM + wr * 64 + fr, col0 = u.pn * HALF + wc * 32 + 8 * fq;
#pragma unroll
        for (int ai = 0; ai < 2; ++ai)
#pragma unroll
            for (int m = 0; m < 4; ++m) { bf16_t* rowp = O + (size_t)(row0 + ai * HALF + m * 16) * ldc + col0;
                float r[8];
#pragma unroll
                for (int n = 0; n < 2; ++n)
#pragma unroll
                    for (int j = 0; j < 4; ++j) { const float g = acc[ai][0][m][n][j], up = acc[ai][1][m][n][j]; r[n * 4 + j] = g * up * __builtin_amdgcn_rcpf(1.f + __builtin_amdgcn_exp2f(g * -1.4426950408889634f)); }
                u32x4 w; w.x = cvt_pk_bf16(r[0], r[1]); w.y = cvt_pk_bf16(r[2], r[3]); w.z = cvt_pk_bf16(r[4], r[5]); w.w = cvt_pk_bf16(r[6], r[7]);
                *(u32x4*)rowp = w; }
    }
};

template <class Epi, class Sched, bool STAMP = false>
__device__ __forceinline__ void gemm_phase(PG8_LAS unsigned char* lds, const Gemm g, const Sched& S, const Epi& E, unsigned long long* stamps) {
    const int tid = threadIdx.x, wid = __builtin_amdgcn_readfirstlane(tid >> 6), lane = tid & 63, wr = wid >> 2, wc = wid & 3, fr = lane & 15, fq = lane >> 4;
    const int K = g.K, nt = K / BK;
    int ts_lo = 0, ts_hi = 0, nts = 0; const unsigned long long rt_entry = STAMP ? (unsigned long long)wall_clock64() : 0ull;
#define PG8_STAMP() do { if (STAMP && wid == 0 && nts < 64) { const unsigned long long _c = (unsigned long long)clock64(); \
        ts_lo = (lane == nts) ? (int)(unsigned)_c : ts_lo; ts_hi = (lane == nts) ? (int)(unsigned)(_c >> 32) : ts_hi; ++nts; } } while (0)
    PG8_STAMP();
    unsigned voffA[2], voffB[2];
#pragma unroll
    for (int i = 0; i < 2; ++i) { int R, C; stage_rc(tid * 16 + i * 8192, R, C); const int Rb = Epi::PERM ? ((R & ~31) + perm32(R & 31)) : R;
        voffA[i] = (unsigned)(R * K + C) * 2u; voffB[i] = (unsigned)(Rb * K + C) * 2u; }
    const size_t kstep = (size_t)(BK * 2);
    const size_t hstep = (size_t)HALF * K * 2;
    const size_t tstep = 2 * hstep;
    const unsigned ldsw = (unsigned)wid * 1024u;
    const int aoff = lds_byte(wr * 64 + fr, fq * 8), boff = lds_byte(wc * 32 + fr, fq * 8);
#define PG8_SA(b, h) (((b) * 2 + (h)) * HTB)
#define PG8_SB(b, h) ((4 + (b) * 2 + (h)) * HTB)
#define PG8_STAGE(bufoff, gbase, voff) do { _Pragma("unroll") for (int _i = 0; _i < 2; ++_i) \
        __builtin_amdgcn_global_load_lds((const unsigned*)((const char*)(gbase) + (voff)[_i]), (PG8_LAS unsigned*)(lds + (bufoff) + ldsw + _i * 8192), 16, 0, 0); } while (0)
#define PG8_LDA(dst, b, h) do { _Pragma("unroll") for (int m = 0; m < 4; ++m) _Pragma("unroll") for (int k = 0; k < 2; ++k) dst[m][k] = *(const PG8_LAS bf16x8*)(lds + PG8_SA(b, h) + aoff + m * 2048 + k * 1024); } while (0)
#define PG8_LDB(dst, b, h) do { _Pragma("unroll") for (int n = 0; n < 2; ++n) _Pragma("unroll") for (int k = 0; k < 2; ++k) dst[n][k] = *(const PG8_LAS bf16x8*)(lds + PG8_SB(b, h) + boff + n * 2048 + k * 1024); } while (0)
#define PG8_MMA(ai, bj, At, Bt) do { __builtin_amdgcn_s_setprio(1); _Pragma("unroll") for (int m = 0; m < 4; ++m) _Pragma("unroll") for (int n = 0; n < 2; ++n) _Pragma("unroll") for (int k = 0; k < 2; ++k) \
        acc[ai][bj][m][n] = __builtin_amdgcn_mfma_f32_16x16x32_bf16(Bt[n][k], At[m][k], acc[ai][bj][m][n], 0, 0, 0); __builtin_amdgcn_s_setprio(0); } while (0)
#define PG8_WAIT_V(n) asm volatile("s_waitcnt vmcnt(" #n ")" ::: "memory")
#define PG8_WAIT_L(n) asm volatile("s_waitcnt lgkmcnt(" #n ")" ::: "memory")
#define PG8_BAR __builtin_amdgcn_s_barrier()
#define PG8_SCHED __builtin_amdgcn_sched_barrier(0)
    Unit cur, nxt; int ui = 0;
    if (!S.next(0, cur)) return;
    f32x4 acc[2][2][4][2];
#pragma unroll
    for (int a = 0; a < 2; ++a)
#pragma unroll
        for (int b = 0; b < 2; ++b)
#pragma unroll
            for (int m = 0; m < 4; ++m)
#pragma unroll
                for (int n = 0; n < 2; ++n) acc[a][b][m][n] = (f32x4){0.f, 0.f, 0.f, 0.f};
    bf16x8 At[4][2], B0[2][2], B1[2][2];
    const char* cA = (const char*)g.A + (size_t)cur.pm * tstep; const char* cB = (const char*)g.Bt + (size_t)cur.pn * tstep;
    S.a_ready(cur);
    PG8_STAGE(PG8_SB(0, 0), cB, voffB); PG8_STAGE(PG8_SA(0, 0), cA, voffA); PG8_STAGE(PG8_SB(0, 1), cB + hstep, voffB); PG8_STAGE(PG8_SA(0, 1), cA + hstep, voffA);
    if (wr == 1) PG8_BAR;
    PG8_WAIT_V(4); PG8_BAR;
    PG8_STAGE(PG8_SB(1, 0), cB + kstep, voffB); PG8_STAGE(PG8_SA(1, 0), cA + kstep, voffA); PG8_STAGE(PG8_SB(1, 1), cB + hstep + kstep, voffB);
    PG8_WAIT_V(6); PG8_BAR;
    PG8_STAMP();
    for (;;) {
        const bool has_next = S.next(ui + 1, nxt);
        const char* nA = has_next ? (const char*)g.A + (size_t)nxt.pm * tstep : cA; const char* nB = has_next ? (const char*)g.Bt + (size_t)nxt.pn * tstep : cB;
        for (int t = 0; t < nt; t += 2) {
            const bool last = (t == nt - 2);
            const char* a1 = cA + (size_t)(t + 1) * kstep;
            const char* a2 = last ? nA : cA + (size_t)(t + 2) * kstep; const char* b2 = last ? nB : cB + (size_t)(t + 2) * kstep;
            const char* a3 = a2 + kstep; const char* b3 = b2 + kstep;
            if (last && has_next) S.a_ready(nxt);
            PG8_LDB(B0, 0, 0); PG8_SCHED; PG8_LDA(At, 0, 0); PG8_STAGE(PG8_SA(1, 1), a1 + hstep, voffA);
            PG8_WAIT_L(8); PG8_BAR; PG8_WAIT_L(0); PG8_MMA(0, 0, At, B0); PG8_BAR; PG8_SCHED;
            PG8_LDB(B1, 0, 1); PG8_STAGE(PG8_SB(0, 0), b2, voffB);
            PG8_BAR; PG8_WAIT_L(0); PG8_MMA(0, 1, At, B1); PG8_BAR;
            PG8_LDA(At, 0, 1); PG8_STAGE(PG8_SA(0, 0), a2, voffA);
            PG8_BAR; PG8_WAIT_L(0); PG8_MMA(1, 0, At, B0); PG8_BAR; PG8_SCHED;
            PG8_STAGE(PG8_SB(0, 1), b2 + hstep, voffB);
            PG8_WAIT_V(6); PG8_BAR; PG8_MMA(1, 1, At, B1); PG8_BAR;
            PG8_LDB(B0, 1, 0); PG8_SCHED; PG8_LDA(At, 1, 0); PG8_STAGE(PG8_SA(0, 1), a2 + hstep, voffA);
            PG8_WAIT_L(8); PG8_BAR; PG8_WAIT_L(0); PG8_MMA(0, 0, At, B0); PG8_BAR; PG8_SCHED;
            PG8_LDB(B1, 1, 1); PG8_STAGE(PG8_SB(1, 0), b3, voffB);
            PG8_BAR; PG8_WAIT_L(0); PG8_MMA(0, 1, At, B1); PG8_BAR;
            PG8_LDA(At, 1, 1); PG8_STAGE(PG8_SA(1, 0), a3, voffA);
            PG8_BAR; PG8_WAIT_L(0); PG8_MMA(1, 0, At, B0); PG8_BAR; PG8_SCHED;
            PG8_STAGE(PG8_SB(1, 1), b3 + hstep, voffB);
            PG8_WAIT_V(6); PG8_BAR; PG8_MMA(1, 1, At, B1); PG8_BAR;
        }
        PG8_STAMP();
        if constexpr (!Epi::AFTER_DRAIN) { E(acc, cur, wr, wc, fr, fq); S.done(cur); }
        PG8_STAMP();
        if (!has_next) break;
#pragma unroll
        for (int a = 0; a < 2; ++a)
#pragma unroll
            for (int b = 0; b < 2; ++b)
#pragma unroll
                for (int m = 0; m < 4; ++m)
#pragma unroll
                    for (int n = 0; n < 2; ++n) acc[a][b][m][n] = (f32x4){0.f, 0.f, 0.f, 0.f};
        cur = nxt; cA = nA; cB = nB; ++ui;
    }
    PG8_WAIT_V(0);
    if (wr == 0) PG8_BAR;
    PG8_BAR;
    if constexpr (Epi::AFTER_DRAIN) { E.fused(acc, cur, wr, wc, fr, fq, lds, wid, lane); S.done(cur); }
    PG8_STAMP();
    if (STAMP && wid == 0) { stamps[lane] = lane < nts ? (((unsigned long long)(unsigned)ts_hi << 32) | (unsigned)ts_lo) : 0ull;
        if (lane == 62) stamps[62] = rt_entry; if (lane == 63) stamps[63] = (unsigned long long)wall_clock64(); }
#undef PG8_STAMP
#undef PG8_SA
#undef PG8_SB
#undef PG8_STAGE
#undef PG8_LDA
#undef PG8_LDB
#undef PG8_MMA
#undef PG8_WAIT_V
#undef PG8_WAIT_L
#undef PG8_BAR
#undef PG8_SCHED
}
}

template <int EPI>
DI void phase_gemm(const u16* A, const u16* Bt, int M, int N, int K, u16* C, int ldc, char* smem, const float* rope = nullptr, u16* vT = nullptr) {
  pg8::Gemm g; g.A = A; g.Bt = Bt; g.M = M; g.N = N; g.K = K;
  pg8::StaticOrder S; S.init(M, N, (int)gridDim.x, (int)blockIdx.x);
  if (EPI == 3) { pg8::InProjLastOrder S2; S2.init2((int)gridDim.x, (int)blockIdx.x);
    pg8::EpiInProj E; E.O = C; E.ldc = ldc; E.rope = rope; E.vT = vT; pg8::gemm_phase<pg8::EpiInProj, pg8::InProjLastOrder, false>((PG8_LAS unsigned char*)smem, g, S2, E, nullptr); }
  else if (EPI == 2) { pg8::EpiInProj E; E.O = C; E.ldc = ldc; E.rope = rope; E.vT = vT; pg8::gemm_phase<pg8::EpiInProj, pg8::StaticOrder, false>((PG8_LAS unsigned char*)smem, g, S, E, nullptr); }
  else if (EPI == 0) { pg8::EpiStoreBf16 E; E.O = C; E.ldc = ldc; pg8::gemm_phase<pg8::EpiStoreBf16, pg8::StaticOrder, false>((PG8_LAS unsigned char*)smem, g, S, E, nullptr); }
  else { pg8::EpiSwiglu E; E.O = C; E.ldc = ldc; pg8::gemm_phase<pg8::EpiSwiglu, pg8::StaticOrder, false>((PG8_LAS unsigned char*)smem, g, S, E, nullptr); }
  __syncthreads();
}

DI void swa_item(const Params& p, int layer, int pi, bool ctxq, char* smem) {
  const int tid = opaque_tid(), lane = tid & 63, wave = tid >> 6, w4 = wave & 3;
  const int w4u = __builtin_amdgcn_readfirstlane(w4);
  const int l15 = lane & 15, lq = lane >> 4;
  const int hq = (pi & 3) * 2 + (wave >> 2);
  const int g = hq >> 2;
  int b, n;
  if (!ctxq) { n = (pi >> 2) & 15; b = pi >> 6; } else { n = (pi >> 2) & 1; b = pi >> 3; }
  const int qrow0 = (ctxq ? (M_LAT + b * TC + n * 128) : (b * TL + n * 128)) + w4 * 32;
  const int ctxrow0 = M_LAT + b * TC;
  bf16x8 Q[2][2];
#pragma unroll
  for (int rt = 0; rt < 2; ++rt)
#pragma unroll
    for (int ks = 0; ks < 2; ++ks)
      Q[rt][ks] = *(const bf16x8*)(p.z + (size_t)(qrow0 + rt * 16 + l15) * ZW + ZSQ + hq * 64 + ks * 32 + lq * 8);
  const float sink = p.swa_sink[layer * 8 + hq] * 1.4426950408889634f;
  float mrun[2], lrun[2];
  f32x4 O[4][2];
#pragma unroll
  for (int rt = 0; rt < 2; ++rt) {
    mrun[rt] = sink; lrun[rt] = (lq == 0) ? 1.f : 0.f;
#pragma unroll
    for (int dt = 0; dt < 4; ++dt) O[dt][rt] = f32x4{0.f, 0.f, 0.f, 0.f};
  }
  uint4 kreg0, kreg1, vreg0, vreg1;
#define SWA_LOAD_TILE(KT) do { \
    int krow0_, blk_; \
    if ((KT) < 3) { const int nk_ = n + (KT) - 1; krow0_ = b * TL + nk_ * 128; blk_ = b * 16 + nk_; } \
    else { krow0_ = ctxrow0 + ((KT) - 3) * 128; blk_ = 256 + b * 2 + ((KT) - 3); } \
    const u16* kb_ = p.z + (size_t)krow0_ * ZW + ZSK + g * 64; \
    const u16* vb_ = p.vT + (size_t)(blk_ * 2 + g) * 64 * 128; \
    kreg0 = *(const uint4*)(kb_ + (size_t)(tid >> 3) * ZW + (tid & 7) * 8); \
    kreg1 = *(const uint4*)(kb_ + (size_t)((tid + 512) >> 3) * ZW + (tid & 7) * 8); \
    vreg0 = *(const uint4*)(vb_ + (tid >> 4) * 128 + (tid & 15) * 8); \
    vreg1 = *(const uint4*)(vb_ + ((tid + 512) >> 4) * 128 + (tid & 15) * 8); \
  } while (0)
  int kt = ctxq ? 3 : (n == 0 ? 1 : 0);
  SWA_LOAD_TILE(kt);
  int buf = 0;
  while (kt < 5) {
    u16* Ks = (u16*)smem + buf * (128 * 72 + 64 * 136);
    u16* Vt = Ks + 128 * 72;
    *(uint4*)(Ks + (tid >> 3) * 72 + (tid & 7) * 8) = kreg0;
    *(uint4*)(Ks + ((tid + 512) >> 3) * 72 + (tid & 7) * 8) = kreg1;
    *(uint4*)(Vt + (tid >> 4) * 136 + (tid & 15) * 8) = vreg0;
    *(uint4*)(Vt + ((tid + 512) >> 4) * 136 + (tid & 15) * 8) = vreg1;
    __syncthreads();
    const int ktn = (kt == 1 && n == 15 && !ctxq) ? 3 : kt + 1;
    if (ktn < 5) SWA_LOAD_TILE(ktn);
#pragma unroll 1
    for (int hf = 0; hf < 2; ++hf) {
      f32x4 S[4][2];
#pragma unroll
      for (int c4 = 0; c4 < 4; ++c4) {
        const u16* kr = Ks + ((hf * 4 + c4) * 16 + l15) * 72 + lq * 8;
        const bf16x8 k0 = *(const bf16x8*)kr;
        const bf16x8 k1 = *(const bf16x8*)(kr + 32);
#pragma unroll
        for (int rt = 0; rt < 2; ++rt) {
          f32x4 s = f32x4{0.f, 0.f, 0.f, 0.f};
          s = MFMA16(k0, Q[rt][0], s);
          s = MFMA16(k1, Q[rt][1], s);
          S[c4][rt] = s;
        }
      }
      if (kt == 0 || kt == 2) {
        const bool prev = kt == 0;
#pragma unroll
        for (int rt = 0; rt < 2; ++rt) {
          const int dq = 2 * w4u + rt;
#pragma unroll
          for (int c4 = 0; c4 < 4; ++c4) {
            const int ct = hf * 4 + c4;
            if (prev ? (ct < dq) : (ct > dq)) {
              S[c4][rt] = f32x4{-1e30f, -1e30f, -1e30f, -1e30f};
            } else if (ct == dq) {
#pragma unroll
              for (int j = 0; j < 4; ++j) {
                const bool valid = prev ? (lq * 4 + j >= l15) : (lq * 4 + j <= l15);
                if (!valid) S[c4][rt][j] = -1e30f;
              }
            }
          }
        }
      }
      unsigned Pk[4][2][2];
#pragma unroll
      for (int rt = 0; rt < 2; ++rt) {
        float mx = S[0][rt][0];
#pragma unroll
        for (int c4 = 0; c4 < 4; ++c4)
#pragma unroll
          for (int j = 0; j < 4; ++j) mx = fmaxf(mx, S[c4][rt][j]);
        mx = fmaxf(mx, __shfl_xor(mx, 16));
        mx = fmaxf(mx, __shfl_xor(mx, 32));
        if (__builtin_amdgcn_ballot_w64(mx - mrun[rt] > 6.f) != 0ull) {
          const float mnew = fmaxf(mrun[rt], mx);
          const float alpha = __builtin_amdgcn_exp2f(mrun[rt] - mnew);
          mrun[rt] = mnew;
          lrun[rt] *= alpha;
#pragma unroll
          for (int dt = 0; dt < 4; ++dt) O[dt][rt] *= alpha;
        }
        const float mref = mrun[rt];
        float rs = 0.f;
#pragma unroll
        for (int c4 = 0; c4 < 4; ++c4) {
          float pv[4];
#pragma unroll
          for (int j = 0; j < 4; ++j) { pv[j] = __builtin_amdgcn_exp2f(S[c4][rt][j] - mref); rs += pv[j]; }
          Pk[c4][rt][0] = pack2(pv[0], pv[1]);
          Pk[c4][rt][1] = pack2(pv[2], pv[3]);
        }
        lrun[rt] += rs;
      }
#pragma unroll
      for (int kk = 0; kk < 2; ++kk) {
        bf16x8 pb[2];
#pragma unroll
        for (int rt = 0; rt < 2; ++rt) {
          uint4 t4 = make_uint4(Pk[2 * kk][rt][0], Pk[2 * kk][rt][1], Pk[2 * kk + 1][rt][0], Pk[2 * kk + 1][rt][1]);
          pb[rt] = __builtin_bit_cast(bf16x8, t4);
        }
#pragma unroll
        for (int dt = 0; dt < 4; ++dt) {
          const u16* vrow = Vt + (dt * 16 + l15) * 136 + lq * 4 + (hf * 4 + 2 * kk) * 16;
          const uint2 lo = *(const uint2*)(vrow);
          const uint2 hi = *(const uint2*)(vrow + 16);
          const bf16x8 va = __builtin_bit_cast(bf16x8, make_uint4(lo.x, lo.y, hi.x, hi.y));
#pragma unroll
          for (int rt = 0; rt < 2; ++rt) O[dt][rt] = MFMA16(va, pb[rt], O[dt][rt]);
        }
      }
    }
    kt = ktn; buf ^= 1;
  }
#pragma unroll
  for (int rt = 0; rt < 2; ++rt) {
    float l = lrun[rt];
    l += __shfl_xor(l, 16);
    l += __shfl_xor(l, 32);
    const float inv = 1.f / l;
    const int row = qrow0 + rt * 16 + l15;
#pragma unroll
    for (int dt = 0; dt < 4; ++dt) {
      uint2 o;
      o.x = pack2(O[dt][rt][0] * inv, O[dt][rt][1] * inv);
      o.y = pack2(O[dt][rt][2] * inv, O[dt][rt][3] * inv);
      *(uint2*)(p.cat + (size_t)row * DM + 512 + hq * 64 + dt * 16 + lq * 4) = o;
    }
  }
  __syncthreads();
}

DI void gmlp_item(const Params& p, int layer, int ci, char* smem) {
  const int tid = opaque_tid(), lane = tid & 63, wave = tid >> 6;
  const int l15 = lane & 15, lq = lane >> 4;
  u16* vT = (u16*)smem;
  float* rowss = (float*)(smem + 256 * 136 * 2);
  const int grow0 = ci * 128;
  {
    const int pr = tid >> 2, qd = tid & 3;
    const u16* zr = p.z + (size_t)(grow0 + pr) * ZW + ZGV + qd * 64;
    float v[64];
#pragma unroll
    for (int i = 0; i < 8; ++i) {
      const uint4 raw = *(const uint4*)(zr + i * 8);
      float f[8];
      unpack8(raw, f);
#pragma unroll
      for (int e = 0; e < 8; e += 2) {
        const f32x2_t gq = gelu_pk(f32x2_t{f[e], f[e + 1]});
        v[i * 8 + e] = gq.x; v[i * 8 + e + 1] = gq.y;
      }
    }
    float sm = 0.f;
#pragma unroll
    for (int e = 0; e < 64; ++e) sm += v[e];
    sm += __shfl_xor(sm, 1); sm += __shfl_xor(sm, 2);
    const float mean = sm * (1.f / 256.f);
    float q = 0.f;
#pragma unroll
    for (int e = 0; e < 64; ++e) { v[e] -= mean; q += v[e] * v[e]; }
    q += __shfl_xor(q, 1); q += __shfl_xor(q, 2);
    const float rstd = rsqrtf(q * (1.f / 256.f) + 1e-5f);
    const float* lng = p.gmlp_ln_g + layer * 256 + qd * 64;
    const float* lnb = p.gmlp_ln_b + layer * 256 + qd * 64;
#pragma unroll
    for (int e = 0; e < 64; e += 4) {
      const float4 gg = *(const float4*)(lng + e), bb = *(const float4*)(lnb + e);
      u16* dst = vT + (qd * 64 + e) * 136 + pr;
      dst[0] = f2bf(v[e] * rstd * gg.x + bb.x);
      dst[136] = f2bf(v[e + 1] * rstd * gg.y + bb.y);
      dst[272] = f2bf(v[e + 2] * rstd * gg.z + bb.z);
      dst[408] = f2bf(v[e + 3] * rstd * gg.w + bb.w);
    }
  }
  __syncthreads();
  const int g = wave & 3, half = wave >> 2;
  const float* ws = p.gmlp_ws + (size_t)(layer * 4 + g) * 128 * 128;
  f32x4 acc[4][4];
#pragma unroll
  for (int ct = 0; ct < 4; ++ct)
#pragma unroll
    for (int rt = 0; rt < 4; ++rt) acc[ct][rt] = f32x4{0.f, 0.f, 0.f, 0.f};
#pragma unroll 1
  for (int ks = 0; ks < 4; ++ks) {
    bf16x8 vf[4];
#pragma unroll
    for (int ct = 0; ct < 4; ++ct) vf[ct] = *(const bf16x8*)(vT + (g * 64 + ct * 16 + l15) * 136 + ks * 32 + lq * 8);
#pragma unroll
    for (int rt = 0; rt < 4; ++rt) {
      const float* wr = ws + (size_t)(half * 64 + rt * 16 + l15) * 128 + ks * 32 + lq * 8;
      const float4 w0 = *(const float4*)wr, w1 = *(const float4*)(wr + 4);
      uint4 pk;
      pk.x = pack2(w0.x, w0.y); pk.y = pack2(w0.z, w0.w); pk.z = pack2(w1.x, w1.y); pk.w = pack2(w1.z, w1.w);
      const bf16x8 wf = __builtin_bit_cast(bf16x8, pk);
#pragma unroll
      for (int ct = 0; ct < 4; ++ct) acc[ct][rt] = MFMA16(vf[ct], wf, acc[ct][rt]);
    }
  }
  const float* bs = p.gmlp_bs + (size_t)(layer * 4 + g) * 128;
  const float* og = p.gmlp_out_g + layer * 256;
#pragma unroll
  for (int rt = 0; rt < 4; ++rt) {
    const int pr = half * 64 + rt * 16 + l15;
    const float bias = bs[pr];
    const u16* zr = p.z + (size_t)(grow0 + pr) * ZW + ZGU + g * 64 + lq * 4;
    float ss = 0.f;
#pragma unroll
    for (int ct = 0; ct < 4; ++ct) {
      const uint2 ur = *(const uint2*)(zr + ct * 16);
      const f32x2_t u01 = gelu_pk(f32x2_t{__uint_as_float(ur.x << 16), __uint_as_float(ur.x & 0xffff0000u)});
      const f32x2_t u23 = gelu_pk(f32x2_t{__uint_as_float(ur.y << 16), __uint_as_float(ur.y & 0xffff0000u)});
      f32x4 val = acc[ct][rt];
      val[0] = u01.x * (val[0] + bias); val[1] = u01.y * (val[1] + bias);
      val[2] = u23.x * (val[2] + bias); val[3] = u23.y * (val[3] + bias);
      acc[ct][rt] = val;
      ss += val[0] * val[0] + val[1] * val[1] + val[2] * val[2] + val[3] * val[3];
    }
    ss += __shfl_xor(ss, 16); ss += __shfl_xor(ss, 32);
    if (lq == 0) rowss[g * 128 + pr] = ss;
  }
  __syncthreads();
#pragma unroll
  for (int rt = 0; rt < 4; ++rt) {
    const int pr = half * 64 + rt * 16 + l15;
    const float tot = rowss[pr] + rowss[128 + pr] + rowss[256 + pr] + rowss[384 + pr];
    const float rstd = rsqrtf(tot * (1.f / 256.f) + 1e-6f);
#pragma unroll
    for (int ct = 0; ct < 4; ++ct) {
      const int c = g * 64 + ct * 16 + lq * 4;
      const float4 gg = *(const float4*)(og + c);
      uint2 o;
      o.x = pack2(acc[ct][rt][0] * rstd * gg.x, acc[ct][rt][1] * rstd * gg.y);
      o.y = pack2(acc[ct][rt][2] * rstd * gg.z, acc[ct][rt][3] * rstd * gg.w);
      *(uint2*)(p.cat + (size_t)(grow0 + pr) * DM + 256 + c) = o;
    }
  }
  __syncthreads();
}

DI int gla_row(int b, int c, int s) { return c < 4 ? (M_LAT + b * TC + c * 64 + s) : (b * TL + (c - 4) * 64 + s); }
DI int gla_slot(int c, int dir) { return dir == 0 ? c : (c < 4 ? 3 - c : 39 - c); }

DI void gla_cum2(const Params& p, int layer, int b, int h, int c, float* cum2, int tid) {
  const int lane = tid & 63, wave = tid >> 6;
  {
    const int s = tid >> 2, d0 = (tid & 3) * 8;
    const u16* zr = p.z + (size_t)gla_row(b, c, s) * ZW + h * 32 + d0;
    float zf[8], zb[8];
    unpack8(*(const uint4*)(zr + ZGF), zf);
    unpack8(*(const uint4*)(zr + ZGB), zb);
    const float* baf = p.gla_ba + (size_t)(layer * 2 + 0) * 128 + h * 32 + d0;
    const float* bab = p.gla_ba + (size_t)(layer * 2 + 1) * 128 + h * 32 + d0;
#pragma unroll
    for (int e = 0; e < 8; ++e) {
      cum2[s * 32 + d0 + e] = logsigmoid_f(zf[e] + baf[e]) * (1.f / 16.f);
      cum2[2048 + s * 32 + d0 + e] = logsigmoid_f(zb[e] + bab[e]) * (1.f / 16.f);
    }
  }
  __syncthreads();
  {
    float v[16];
#pragma unroll
    for (int i = 0; i < 16; ++i) {
      const int dir = i >> 3, d = wave * 8 + (i & 7);
      const int s = dir ? 63 - lane : lane;
      v[i] = cum2[dir * 2048 + s * 32 + d];
    }
#pragma unroll
    for (int i = 0; i < 16; ++i) v[i] = wave_incl_scan(v[i]);
#pragma unroll
    for (int i = 0; i < 16; ++i) {
      const int dir = i >> 3, d = wave * 8 + (i & 7);
      const int s = dir ? 63 - lane : lane;
      cum2[dir * 2048 + s * 32 + d] = v[i];
    }
  }
  __syncthreads();
}

DI void gla_stage_vt(const Params& p, int b, int h, int c, u16* Vt, int tid) {
#pragma unroll
  for (int i = 0; i < 2; ++i) {
    const int cc = tid + 256 * i, s = cc >> 3, ch = cc & 7;
    const uint4 vv = *(const uint4*)(p.z + (size_t)gla_row(b, c, s) * ZW + ZV + h * 64 + ch * 8);
    u16* vt = Vt + (ch * 8) * 72 + s;
    vt[0 * 72] = (u16)(vv.x & 0xffff); vt[1 * 72] = (u16)(vv.x >> 16);
    vt[2 * 72] = (u16)(vv.y & 0xffff); vt[3 * 72] = (u16)(vv.y >> 16);
    vt[4 * 72] = (u16)(vv.z & 0xffff); vt[5 * 72] = (u16)(vv.z >> 16);
    vt[6 * 72] = (u16)(vv.w & 0xffff); vt[7 * 72] = (u16)(vv.w >> 16);
  }
}

constexpr int GLA_SUB_BYTES = 56320;

DI void gla_a_item(const Params& p, int layer, int pi, char* smem) {
  const int tid0 = opaque_tid();
  const int tid = tid0 & 255, sub = tid0 >> 8;
  const int lane = tid & 63, wave = tid >> 6, l15 = lane & 15, lq = lane >> 4;
  const int item = 2 * pi + sub;
  char* base = smem + sub * GLA_SUB_BYTES;
  float* cum2 = (float*)base;
  u16* ktT = (u16*)(base + 16384);
  u16* Vt = (u16*)(base + 16384 + 9216);
  const int c = item % NSLOT, h = (item / NSLOT) & 3, b = item / (NSLOT * 4);
  const int s = tid >> 2, d0 = (tid & 3) * 8;
  const uint4 kraw = *(const uint4*)(p.z + (size_t)gla_row(b, c, s) * ZW + ZK + h * 32 + d0);
  gla_stage_vt(p, b, h, c, Vt, tid);
  gla_cum2(p, layer, b, h, c, cum2, tid);
  {
    float* cg = p.cumbuf + (size_t)item * 4096;
#pragma unroll
    for (int i = 0; i < 4; ++i) *(float4*)(cg + (i * 256 + tid) * 4) = *(const float4*)(cum2 + (i * 256 + tid) * 4);
  }
  const size_t sidx0 = ((size_t)((b * 4 + h) * 2 + 0) * NSLOT + gla_slot(c, 0));
  const size_t sidx1 = ((size_t)((b * 4 + h) * 2 + 1) * NSLOT + gla_slot(c, 1));
  {
    float kf[8];
    unpack8(kraw, kf);
#pragma unroll
    for (int e = 0; e < 8; ++e) {
      ktT[(d0 + e) * 72 + s] = f2bf(kf[e] * __expf(cum2[63 * 32 + d0 + e] - cum2[s * 32 + d0 + e]));
      ktT[2304 + (d0 + e) * 72 + s] = f2bf(kf[e] * __expf(cum2[2048 + d0 + e] - cum2[2048 + s * 32 + d0 + e]));
    }
    if (tid < 32) p.Dd[sidx0 * 32 + tid] = __expf(cum2[63 * 32 + tid]);
    else if (tid < 64) p.Dd[sidx1 * 32 + tid - 32] = __expf(cum2[2048 + tid - 32]);
  }
  __syncthreads();
#pragma unroll
  for (int dir = 0; dir < 2; ++dir) {
    float* Lp = p.L + (dir ? sidx1 : sidx0) * 2048;
#pragma unroll
    for (int dt = 0; dt < 2; ++dt) {
      f32x4 acc = f32x4{0.f, 0.f, 0.f, 0.f};
#pragma unroll
      for (int ks = 0; ks < 2; ++ks) {
        const bf16x8 a = *(const bf16x8*)(ktT + dir * 2304 + (dt * 16 + l15) * 72 + ks * 32 + lq * 8);
        const bf16x8 bb = *(const bf16x8*)(Vt + (wave * 16 + l15) * 72 + ks * 32 + lq * 8);
        acc = MFMA16(a, bb, acc);
      }
#pragma unroll
      for (int j = 0; j < 4; ++j) Lp[(dt * 16 + lq * 4 + j) * 64 + wave * 16 + l15] = acc[j];
    }
  }
  __syncthreads();
}

DI void phase_gla_b(const Params& p) {
  const int total = NB * 4 * 2 * 2048;
  for (int idx = blockIdx.x * NT + threadIdx.x; idx < total; idx += gridDim.x * NT) {
    const int chain = idx >> 11, de = idx & 2047, d = de >> 6;
    float* Lp = p.L + (size_t)chain * NSLOT * 2048 + de;
    const float* Dp = p.Dd + (size_t)chain * NSLOT * 32 + d;
    float loc[NSLOT], dec[NSLOT];
#pragma unroll
    for (int sl = 0; sl < NSLOT; ++sl) { loc[sl] = Lp[(size_t)sl * 2048]; dec[sl] = Dp[sl * 32]; }
    float S = 0.f;
#pragma unroll
    for (int sl = 0; sl < NSLOT; ++sl) {
      Lp[(size_t)sl * 2048] = S;
      S = dec[sl] * S + loc[sl];
    }
  }
}

DI void gla_c_item(const Params& p, int layer, int pi, char* smem) {
  const int tid0 = opaque_tid();
  const int tid = tid0 & 255, sub = tid0 >> 8;
  const int lane = tid & 63, wave = tid >> 6, l15 = lane & 15, lq = lane >> 4;
  const int item = 2 * pi + sub;
  char* base = smem + sub * GLA_SUB_BYTES;
  float* cum2 = (float*)base;
  u16* qt = (u16*)(base + 16384);
  u16* kh = (u16*)(base + 16384 + 10240);
  u16* St = (u16*)(base + 16384 + 20480);
  u16* Vt = (u16*)(base + 16384 + 30720);
  const int c = item % NSLOT, h = (item / NSLOT) & 3, b = item / (NSLOT * 4);
  const int s = tid >> 2, d0 = (tid & 3) * 8;
  const u16* zr = p.z + (size_t)gla_row(b, c, s) * ZW + h * 32 + d0;
  const uint4 qraw = *(const uint4*)(zr + ZQ), kraw = *(const uint4*)(zr + ZK);
  const int sd = tid >> 3, se0 = (tid & 7) * 8;
  const float* Lp0 = p.L + ((size_t)((b * 4 + h) * 2 + 0) * NSLOT + gla_slot(c, 0)) * 2048 + sd * 64 + se0;
  const float* Lp1 = p.L + ((size_t)((b * 4 + h) * 2 + 1) * NSLOT + gla_slot(c, 1)) * 2048 + sd * 64 + se0;
  const float4 sf0 = *(const float4*)Lp0, sf1 = *(const float4*)(Lp0 + 4), sb0 = *(const float4*)Lp1, sb1 = *(const float4*)(Lp1 + 4);
  const float* cg = p.cumbuf + (size_t)item * 4096 + s * 32 + d0;
  float cvv[2][8];
  *(float4*)&cvv[0][0] = *(const float4*)cg;          *(float4*)&cvv[0][4] = *(const float4*)(cg + 4);
  *(float4*)&cvv[1][0] = *(const float4*)(cg + 2048); *(float4*)&cvv[1][4] = *(const float4*)(cg + 2052);
  gla_stage_vt(p, b, h, c, Vt, tid);
  {
    float qf[8], kf[8];
    unpack8(qraw, qf);
    unpack8(kraw, kf);
#pragma unroll
    for (int dir = 0; dir < 2; ++dir) {
      float qo[8], ko[8];
#pragma unroll
      for (int e = 0; e < 8; ++e) {
        const float cv = cvv[dir][e];
        qo[e] = qf[e] * 0.17677669529663687f * __expf(cv);
        ko[e] = kf[e] * __expf(-cv);
      }
      *(uint4*)(qt + dir * 2560 + s * 40 + d0) = make_uint4(pack2(qo[0], qo[1]), pack2(qo[2], qo[3]), pack2(qo[4], qo[5]), pack2(qo[6], qo[7]));
      *(uint4*)(kh + dir * 2560 + s * 40 + d0) = make_uint4(pack2(ko[0], ko[1]), pack2(ko[2], ko[3]), pack2(ko[4], ko[5]), pack2(ko[6], ko[7]));
    }
    St[(se0 + 0) * 40 + sd] = f2bf(sf0.x); St[(se0 + 1) * 40 + sd] = f2bf(sf0.y); St[(se0 + 2) * 40 + sd] = f2bf(sf0.z); St[(se0 + 3) * 40 + sd] = f2bf(sf0.w);
    St[(se0 + 4) * 40 + sd] = f2bf(sf1.x); St[(se0 + 5) * 40 + sd] = f2bf(sf1.y); St[(se0 + 6) * 40 + sd] = f2bf(sf1.z); St[(se0 + 7) * 40 + sd] = f2bf(sf1.w);
    u16* St1 = St + 2560;
    St1[(se0 + 0) * 40 + sd] = f2bf(sb0.x); St1[(se0 + 1) * 40 + sd] = f2bf(sb0.y); St1[(se0 + 2) * 40 + sd] = f2bf(sb0.z); St1[(se0 + 3) * 40 + sd] = f2bf(sb0.w);
    St1[(se0 + 4) * 40 + sd] = f2bf(sb1.x); St1[(se0 + 5) * 40 + sd] = f2bf(sb1.y); St1[(se0 + 6) * 40 + sd] = f2bf(sb1.z); St1[(se0 + 7) * 40 + sd] = f2bf(sb1.w);
  }
  __syncthreads();
  f32x4 oT[4], aT[4];
#pragma unroll
  for (int i = 0; i < 4; ++i) { oT[i] = f32x4{0.f, 0.f, 0.f, 0.f}; aT[i] = f32x4{0.f, 0.f, 0.f, 0.f}; }
  const int tq = 16 * wave + l15;
#pragma unroll
  for (int dir = 0; dir < 2; ++dir) {
    const bf16x8 qb = *(const bf16x8*)(qt + dir * 2560 + tq * 40 + lq * 8);
#pragma unroll
    for (int st = 0; st < 4; ++st) {
      const bf16x8 ka = *(const bf16x8*)(kh + dir * 2560 + (st * 16 + l15) * 40 + lq * 8);
      f32x4 sv = f32x4{0.f, 0.f, 0.f, 0.f};
      sv = MFMA16(ka, qb, sv);
#pragma unroll
      for (int j = 0; j < 4; ++j) {
        const int si = st * 16 + lq * 4 + j;
        const bool valid = dir ? (si >= tq) : (si <= tq);
        aT[st][j] += valid ? sv[j] : 0.f;
      }
    }
#pragma unroll
    for (int et = 0; et < 4; ++et) {
      const bf16x8 sa = *(const bf16x8*)(St + dir * 2560 + (et * 16 + l15) * 40 + lq * 8);
      oT[et] = MFMA16(sa, qb, oT[et]);
    }
  }
#pragma unroll
  for (int kk = 0; kk < 2; ++kk) {
    const uint4 t4 = make_uint4(pack2(aT[2 * kk][0], aT[2 * kk][1]), pack2(aT[2 * kk][2], aT[2 * kk][3]),
                                pack2(aT[2 * kk + 1][0], aT[2 * kk + 1][1]), pack2(aT[2 * kk + 1][2], aT[2 * kk + 1][3]));
    const bf16x8 pb = __builtin_bit_cast(bf16x8, t4);
#pragma unroll
    for (int et = 0; et < 4; ++et) {
      const u16* vrow = Vt + (et * 16 + l15) * 72 + lq * 4 + (2 * kk) * 16;
      const uint2 lo = *(const uint2*)vrow;
      const uint2 hi = *(const uint2*)(vrow + 16);
      const bf16x8 va = __builtin_bit_cast(bf16x8, make_uint4(lo.x, lo.y, hi.x, hi.y));
      oT[et] = MFMA16(va, pb, oT[et]);
    }
  }
  float ss = 0.f;
#pragma unroll
  for (int et = 0; et < 4; ++et)
#pragma unroll
    for (int j = 0; j < 4; ++j) ss += oT[et][j] * oT[et][j];
  ss += __shfl_xor(ss, 16);
  ss += __shfl_xor(ss, 32);
  const float rstd = rsqrtf(ss * (1.f / 64.f) + 1e-6f);
  const int row = gla_row(b, c, tq);
#pragma unroll
  for (int et = 0; et < 4; ++et) {
    const int e0 = et * 16 + lq * 4;
    const uint2 ogv = *(const uint2*)(p.z + (size_t)row * ZW + ZOG + h * 64 + e0);
    const float og0 = __uint_as_float(ogv.x << 16), og1 = __uint_as_float(ogv.x & 0xffff0000u);
    const float og2 = __uint_as_float(ogv.y << 16), og3 = __uint_as_float(ogv.y & 0xffff0000u);
    const float4 gn = *(const float4*)(p.gla_norm + layer * 64 + e0);
    uint2 o;
    o.x = pack2(oT[et][0] * rstd * gn.x * silu_f(og0), oT[et][1] * rstd * gn.y * silu_f(og1));
    o.y = pack2(oT[et][2] * rstd * gn.z * silu_f(og2), oT[et][3] * rstd * gn.w * silu_f(og3));
    *(uint2*)(p.cat + (size_t)row * DM + h * 64 + e0) = o;
  }
  __syncthreads();
}

DI void swa_norm_rows(const Params& p, int layer, int Mrows) {
  const int tid = threadIdx.x, lane = tid & 63, wave = tid >> 6;
  const int sub = lane >> 4, l16 = lane & 15;
  const float* g = p.swa_out_g + layer * 512 + l16 * 32;
  for (int row = (blockIdx.x * 8 + wave) * 4 + sub; row < Mrows; row += gridDim.x * 32) {
    u16* cp = p.cat + (size_t)row * DM + 512 + l16 * 32;
    uint4 raw[4];
#pragma unroll
    for (int i = 0; i < 4; ++i) raw[i] = *(const uint4*)(cp + i * 8);
    float f[32];
    float ss = 0.f;
#pragma unroll
    for (int i = 0; i < 4; ++i) {
      unpack8(raw[i], f + i * 8);
#pragma unroll
      for (int e = 0; e < 8; ++e) ss += f[i * 8 + e] * f[i * 8 + e];
    }
    ss += __shfl_xor(ss, 1); ss += __shfl_xor(ss, 2); ss += __shfl_xor(ss, 4); ss += __shfl_xor(ss, 8);
    const float rstd = rsqrtf(ss * (1.f / 512.f) + 1e-6f);
#pragma unroll
    for (int i = 0; i < 4; ++i) {
      const float4 g0 = *(const float4*)(g + i * 8), g1 = *(const float4*)(g + i * 8 + 4);
      uint4 o;
      o.x = pack2(f[i * 8 + 0] * rstd * g0.x, f[i * 8 + 1] * rstd * g0.y); o.y = pack2(f[i * 8 + 2] * rstd * g0.z, f[i * 8 + 3] * rstd * g0.w);
      o.z = pack2(f[i * 8 + 4] * rstd * g1.x, f[i * 8 + 5] * rstd * g1.y); o.w = pack2(f[i * 8 + 6] * rstd * g1.z, f[i * 8 + 7] * rstd * g1.w);
      *(uint4*)(cp + i * 8) = o;
    }
  }
}

DI void phase_mix_a(const Params& p, int layer, char* smem) {
  const bool need_ctx = layer == 0;
  const int n_swa = 1024, n_swac = need_ctx ? 128 : 0, n_gm = need_ctx ? 288 : 256, n_gla = NB * 4 * NSLOT / 2;
  const int total = n_swa + n_swac + n_gm + n_gla;
  for (int item = blockIdx.x; item < total; item += gridDim.x) {
    int it = item;
    if (it < n_swa) { swa_item(p, layer, it, false, smem); continue; }
    it -= n_swa;
    if (it < n_swac) { swa_item(p, layer, it, true, smem); continue; }
    it -= n_swac;
    if (it < n_gm) { gmlp_item(p, layer, it, smem); continue; }
    it -= n_gm;
    gla_a_item(p, layer, it, smem);
  }
}

DI void phase_mix_c(const Params& p, int layer, char* smem) {
  const bool need_ctx = layer == 0;
  const int n_gla = NB * 4 * NSLOT / 2;
  for (int item = blockIdx.x; item < n_gla; item += gridDim.x) {
    const int c = (2 * item) % NSLOT;
    if (!need_ctx && c < 4) continue;
    gla_c_item(p, layer, item, smem);
  }
  swa_norm_rows(p, layer, need_ctx ? M_ALL : M_LAT);
}


#define XB_TMO      128
#define XB_XCNT(j)  (256  + 64 * (j))
#define XB_XSUB(j)  (1280 + 64 * (j))
#define XB_XGEN(j)  (2304 + 64 * (j))
#define XB_TOP      3328
#define XB_TOPGEN   3392
#define XCD_BAR_WORDS 3456
#define XB_SPIN_CAP (1u << 22)
#define LAS __attribute__((address_space(3)))
DI unsigned xb_ld(unsigned* p) { return __hip_atomic_load(p, __ATOMIC_RELAXED, __HIP_MEMORY_SCOPE_AGENT); }
DI unsigned xb_add(unsigned* p, unsigned v) { return __hip_atomic_fetch_add(p, v, __ATOMIC_RELAXED, __HIP_MEMORY_SCOPE_AGENT); }
DI unsigned xb_xcc_id() { return (unsigned)__builtin_amdgcn_s_getreg((3 << 11) | 20) & 0xFu; }
#define XB_SPIN(cond, bar) do { unsigned _sp = 0; while (cond) { __builtin_amdgcn_s_sleep(1); \
    if ((++_sp & 255u) == 0u) { if (xb_ld(&(bar)[XB_TMO])) break; if (_sp > XB_SPIN_CAP) { atomicAdd(&(bar)[XB_TMO], 1u); break; } } } } while (0)
struct XcdBarrier { unsigned* bar; unsigned x; volatile LAS unsigned* st; };
DI XcdBarrier xcd_barrier_post(unsigned* bar, volatile LAS unsigned* st) {
  XcdBarrier b; b.bar = bar; b.x = xb_xcc_id(); b.st = st;
  if (threadIdx.x == 0) (void)xb_add(&bar[XB_XCNT(b.x)], 1u);
  return b;
}
DI void xcd_barrier_complete(unsigned* bar, unsigned x, unsigned& nloc, unsigned& nx) {
  const unsigned G = gridDim.x * gridDim.y * gridDim.z;
  unsigned sum, cnt, mine, sp = 0u;
  for (;;) {
    sum = 0u; cnt = 0u; mine = 0u;
#pragma unroll
    for (unsigned j = 0; j < 16; ++j) { const unsigned c = xb_ld(&bar[XB_XCNT(j)]); sum += c; cnt += (c > 0u) ? 1u : 0u; mine = (j == x) ? c : mine; }
    if (sum == G) break;
    __builtin_amdgcn_s_sleep(1);
    if ((++sp & 255u) == 0u) { if (xb_ld(&bar[XB_TMO])) break; if (sp > XB_SPIN_CAP) { atomicAdd(&bar[XB_TMO], 1u); break; } }
  }
  nloc = mine > 0u ? mine : 1u; nx = cnt > 0u ? cnt : 1u;
}
DI void xcd_barrier(const XcdBarrier& b) {
  asm volatile("s_waitcnt vmcnt(0)" ::: "memory");
  __syncthreads();
  if (threadIdx.x == 0) {
    unsigned* bar = b.bar;
    __builtin_amdgcn_s_waitcnt(0);
    unsigned nloc = b.st[0], nx = b.st[1];
    if (nloc == 0u) { xcd_barrier_complete(bar, b.x, nloc, nx); b.st[0] = nloc; b.st[1] = nx; }
    const unsigned old = xb_add(&bar[XB_XSUB(b.x)], 1u);
    const unsigned gen = old / nloc;
    if (old + 1u == (gen + 1u) * nloc) {
      __builtin_amdgcn_fence(__ATOMIC_RELEASE, "agent");
      asm volatile("s_waitcnt vmcnt(0)" ::: "memory");
      const unsigned og = xb_add(&bar[XB_TOP], 1u);
      const unsigned tg = og / nx;
      if (og + 1u == (tg + 1u) * nx) xb_add(&bar[XB_TOPGEN], 1u);
      else XB_SPIN(xb_ld(&bar[XB_TOPGEN]) == tg, bar);
      __builtin_amdgcn_fence(__ATOMIC_ACQUIRE, "agent");
      xb_add(&bar[XB_XGEN(b.x)], 1u);
      asm volatile("s_waitcnt vmcnt(0)" ::: "memory");
    } else {
      XB_SPIN(xb_ld(&bar[XB_XGEN(b.x)]) == gen, bar);
      __builtin_amdgcn_fence(__ATOMIC_ACQUIRE, "agent");
      asm volatile("s_waitcnt vmcnt(0)" ::: "memory");
    }
  }
  __syncthreads();
}

constexpr int N_STEPS = 2 + 2 * 9;

DI void run_step(const Params& p, int step, char* smem) {
  if (step == 0) { phase_prep(p, smem, 0); return; }
  if (step == 1) { phase_rows(p, 0, M_ALL, 0, 0, 0, nullptr, true, 0, 0, p.n1_pre); return; }
  const int l = (step - 2) / 9, ph = (step - 2) % 9;
  const int Mo = l == 0 ? M_ALL : M_LAT;
  switch (ph) {
    case 0: if (l == 0) phase_gemm<2>(p.h, p.WinT + (size_t)l * ZW * DM, M_ALL, ZW, DM, p.z, ZW, smem, p.rope, p.vT);
            else phase_gemm<3>(p.h, p.WinT + (size_t)l * ZW * DM, M_ALL, ZW, DM, p.z, ZW, smem, p.rope, p.vT);
            break;
    case 1: phase_mix_a(p, l, smem); break;
    case 2: phase_gla_b(p); break;
    case 3: phase_mix_c(p, l, smem); break;
    case 4: phase_gemm<0>(p.cat, p.WoutT + (size_t)l * DM * DM, Mo, DM, DM, p.y, DM, smem); break;
    case 5: phase_rows(p, 1, Mo, l == 0 ? 1 : 2, l, 2, p.n1_post + l * DM, true, l, 3, p.n2_pre + l * DM); break;
    case 6: phase_gemm<1>(p.h, p.WguT + (size_t)l * 2 * DFF * DM, Mo, 2 * DFF, DM, p.act, DFF, smem); break;
    case 7: phase_gemm<0>(p.act, p.WdT + (size_t)l * DM * DFF, Mo, DM, DFF, p.y, DM, smem);
            if (l == 0) phase_prep(p, smem, 1);
            break;
    case 8: phase_rows(p, 1, Mo, l == 0 ? 2 : 3, l, 5, p.n2_post + l * DM, l == 0, l + 1, 0, p.n1_pre + (l + 1 < 2 ? l + 1 : 1) * DM); break;
  }
}

template <int S>
DI void run_one(const Params& p, int step_begin, int step_end, int use_cg, const XcdBarrier& xb, char* smem) {
  if (step_begin <= S && S < step_end) {
    run_step(p, S, smem);
    if (S + 1 < step_end) {
      if (use_cg) cg::this_grid().sync();
      else xcd_barrier(xb);
    }
  }
}

__global__ void __launch_bounds__(NT, 2) fwd_kernel(Params p_unused, int step_begin, int step_end, int use_cg) {
  __shared__ __attribute__((aligned(16))) char smem[SMEM_BYTES + 16];
  uint4& xb_words = *(uint4*)(smem + SMEM_BYTES);
  const Params& p = *(const Params*)__builtin_amdgcn_kernarg_segment_ptr();
  if (threadIdx.x == 0) xb_words = make_uint4(0u, 0u, 0u, 0u);
  __syncthreads();
  XcdBarrier xb = xcd_barrier_post(p.bar, (volatile LAS unsigned*)&xb_words);
  run_one<0>(p, step_begin, step_end, use_cg, xb, smem);  run_one<1>(p, step_begin, step_end, use_cg, xb, smem);
  run_one<2>(p, step_begin, step_end, use_cg, xb, smem);  run_one<3>(p, step_begin, step_end, use_cg, xb, smem);
  run_one<4>(p, step_begin, step_end, use_cg, xb, smem);  run_one<5>(p, step_begin, step_end, use_cg, xb, smem);
  run_one<6>(p, step_begin, step_end, use_cg, xb, smem);  run_one<7>(p, step_begin, step_end, use_cg, xb, smem);
  run_one<8>(p, step_begin, step_end, use_cg, xb, smem);  run_one<9>(p, step_begin, step_end, use_cg, xb, smem);
  run_one<10>(p, step_begin, step_end, use_cg, xb, smem); run_one<11>(p, step_begin, step_end, use_cg, xb, smem);
  run_one<12>(p, step_begin, step_end, use_cg, xb, smem); run_one<13>(p, step_begin, step_end, use_cg, xb, smem);
  run_one<14>(p, step_begin, step_end, use_cg, xb, smem); run_one<15>(p, step_begin, step_end, use_cg, xb, smem);
  run_one<16>(p, step_begin, step_end, use_cg, xb, smem); run_one<17>(p, step_begin, step_end, use_cg, xb, smem);
  run_one<18>(p, step_begin, step_end, use_cg, xb, smem); run_one<19>(p, step_begin, step_end, use_cg, xb, smem);
}

extern "C" void kernel_launch(void* const* d_in, const int* in_sizes, int n_in, void* d_out, int out_size, void* d_ws,
                              size_t ws_size, hipStream_t stream) {
  static int grid_blocks = 0;
  if (!grid_blocks) {
    int dev = 0, cus = 0, per_cu = 0;
    hipGetDevice(&dev);
    hipDeviceGetAttribute(&cus, hipDeviceAttributeMultiprocessorCount, dev);
    hipOccupancyMaxActiveBlocksPerMultiprocessor(&per_cu, fwd_kernel, NT, 0);
    if (per_cu < 1) per_cu = 1;
    if (per_cu > 1) per_cu = 1;
    grid_blocks = cus * per_cu;
  }
  Params p{};
  const float** fp = (const float**)&p;
  for (int i = 0; i < 24; ++i) fp[i] = (const float*)d_in[i];
  p.out = (float*)d_out;
  char* w = (char*)d_ws;
  size_t off = 0;
  auto take = [&](size_t bytes) { char* r = w + off; off += (bytes + 255) & ~(size_t)255; return r; };
  p.WinT = (u16*)take((size_t)2 * ZW * DM * 2);
  p.WoutT = (u16*)take((size_t)2 * DM * DM * 2);
  p.WguT = (u16*)take((size_t)2 * 2 * DFF * DM * 2);
  p.WdT = (u16*)take((size_t)2 * DM * DFF * 2);
  p.mod = (float*)take((size_t)2 * 17 * 6144 * 4);
  p.rope = (float*)take((size_t)TL * 32 * 2 * 4);
  p.h = (u16*)take((size_t)M_ALL * DM * 2);
  p.z = (u16*)take((size_t)M_ALL * ZW * 2);
  p.cat = (u16*)take((size_t)M_ALL * DM * 2);
  p.act = p.z;
  p.y = p.h;
  p.xr = (u16*)take((size_t)M_LAT * DM * 2);
  p.xc = (u16*)take((size_t)M_CTX * DM * 2);
  p.L = (float*)take((size_t)NB * 4 * 2 * NSLOT * 2048 * 4);
  p.Dd = (float*)take((size_t)NB * 4 * 2 * NSLOT * 32 * 4);
  p.bar = (unsigned*)take((size_t)XCD_BAR_WORDS * 4);
  p.vT = (u16*)take((size_t)288 * 2 * 64 * 128 * 2);
  p.cumbuf = (float*)p.h;
  if (off > ws_size) { fprintf(stderr, "workspace too small: need %zu have %zu\n", off, ws_size); return; }
#if MK_ONE_LAUNCH
  int sb = 0, se = N_STEPS, use_cg = 0;
  void* args[] = {&p, &sb, &se, &use_cg};
  (void)hipMemsetAsync(p.bar, 0, (size_t)XCD_BAR_WORDS * 4, stream);
  hipError_t e = hipLaunchCooperativeKernel((void*)fwd_kernel, dim3(grid_blocks), dim3(NT), args, 0, stream);
  if (e != hipSuccess) fprintf(stderr, "cooperative launch failed: %s (grid %d)\n", hipGetErrorString(e), grid_blocks);
#else
  for (int s = 0; s < N_STEPS; ++s) fwd_kernel<<<grid_blocks, NT, 0, stream>>>(p, s, s + 1, 0);
#endif
}
```

```cpp
#include <hip/hip_runtime.h>
#include <hip/hip_cooperative_groups.h>
#include <cstdio>
namespace cg = cooperative_groups;

#ifndef MK_ONE_LAUNCH
#define MK_ONE_LAUNCH 1
#endif

#define DI __device__ __forceinline__
typedef unsigned short u16;
using bf16x8 = __attribute__((ext_vector_type(8))) short;
using f32x4 = __attribute__((ext_vector_type(4))) float;
#define MFMA16(a, b, c) __builtin_amdgcn_mfma_f32_16x16x32_bf16((a), (b), (c), 0, 0, 0)

constexpr int NT = 512;
constexpr int ST = 256;
constexpr int DM = 1024;
constexpr int NB = 16;
constexpr int TL = 2048;
constexpr int TC = 256;
constexpr int M_LAT = NB * TL;
constexpr int M_CTX = NB * TC;
constexpr int M_ALL = M_LAT + M_CTX;
constexpr int ZW = 2304;
constexpr int IN_COLS = 2080;
constexpr int DFF = 2816;
constexpr int ZQ = 0, ZK = 128, ZV = 256, ZOG = 512, ZGU = 768, ZGV = 1024, ZSQ = 1280, ZSK = 1792, ZSV = 1920, ZGF = 2048, ZGB = 2176;
constexpr int NSLOT = 36;
constexpr int SMEM_BYTES = 147456;
#define XB_QCTR(j)  (3456 + 64 * (j))
#define XCD_BAR_WORDS (3456 + 64 * 4)

struct Params {
  const float *x, *c, *ctx, *c_ctx, *mod_w, *mod_b, *n1_pre, *n1_post, *n2_pre, *n2_post, *w_in, *w_out,
      *gla_wa2, *gla_ba, *gla_norm, *gmlp_ln_g, *gmlp_ln_b, *gmlp_ws, *gmlp_bs, *gmlp_out_g, *swa_sink, *swa_out_g,
      *ffn_w_gu, *ffn_w_down;
  float* out;
  u16 *WinT, *WoutT, *WguT, *WdT;
  float *mod, *rope, *cumbuf;
  u16 *h, *z, *cat, *y, *act;
  u16 *xc, *xr; float *L, *Dd;
  unsigned* bar;
  u16* vT;
};

DI u16 f2bf(float f) { const __bf16 hv = (__bf16)f; return __builtin_bit_cast(u16, hv); }
DI float bf2f(u16 h) { return __uint_as_float(((unsigned)h) << 16); }
typedef __bf16 bf16x2_t __attribute__((ext_vector_type(2)));
typedef float f32x2_t __attribute__((ext_vector_type(2)));
DI unsigned pack2(float a, float b) { f32x2_t v = {a, b}; bf16x2_t r = __builtin_convertvector(v, bf16x2_t); return __builtin_bit_cast(unsigned, r); }
DI f32x2_t gelu_pk(f32x2_t v) {
  const f32x2_t av = __builtin_elementwise_abs(v), d = av * 0.2316418882f + 1.0f;
  f32x2_t t; t.x = __builtin_amdgcn_rcpf(d.x); t.y = __builtin_amdgcn_rcpf(d.y);
  f32x2_t q = t * 0.5307027145f + (-0.7265760135f); q = q * t + 0.7107068705f; q = q * t + (-0.142248368f); q = q * t + 0.127414796f; q = q * t;
  const f32x2_t s = (v * v) * (-0.72134752044f);
  f32x2_t e; e.x = __builtin_amdgcn_exp2f(s.x); e.y = __builtin_amdgcn_exp2f(s.y);
  const f32x2_t m = v * (q * e), r = v - m;
  f32x2_t o; o.x = v.x < 0.f ? m.x : r.x; o.y = v.y < 0.f ? m.y : r.y; return o;
}
DI int opaque_tid() { int t = threadIdx.x; asm volatile("" : "+v"(t)); return t; }
template <int CTRL, int ROWMASK>
DI float dpp_acc(float v) { const int t = __builtin_amdgcn_update_dpp(0, __float_as_int(v), CTRL, ROWMASK, 0xf, false); return v + __int_as_float(t); }
DI float wave_incl_scan(float v) {
  v = dpp_acc<0x111, 0xf>(v); v = dpp_acc<0x112, 0xf>(v); v = dpp_acc<0x114, 0xf>(v); v = dpp_acc<0x118, 0xf>(v);
  v = dpp_acc<0x142, 0xa>(v); v = dpp_acc<0x143, 0xc>(v);
  return v;
}
DI float wave_sum(float v) { return __int_as_float(__builtin_amdgcn_readlane(__float_as_int(wave_incl_scan(v)), 63)); }
DI float silu_f(float x) { return x * __builtin_amdgcn_rcpf(1.f + __expf(-x)); }
DI float gelu_f(float x) { return 0.5f * x * (1.f + erff(x * 0.70710678118654752f)); }
DI float logsigmoid_f(float z) { return fminf(z, 0.f) - __logf(1.f + __expf(-fabsf(z))); }
DI void unpack8(const uint4& v, float* f) {
  f[0] = __uint_as_float(v.x << 16); f[1] = __uint_as_float(v.x & 0xffff0000u);
  f[2] = __uint_as_float(v.y << 16); f[3] = __uint_as_float(v.y & 0xffff0000u);
  f[4] = __uint_as_float(v.z << 16); f[5] = __uint_as_float(v.z & 0xffff0000u);
  f[6] = __uint_as_float(v.w << 16); f[7] = __uint_as_float(v.w & 0xffff0000u);
}

DI int colmap_win(int n) { return n < 768 ? n : n + 32; }
DI int colmap_gu(int n) { int pn = n >> 8, w = n & 255; return pn * 128 + (w & 127) + ((w & 128) ? DFF : 0); }

template <int CM>
DI void transpose_tile(const float* __restrict__ src, int ld_src, int k0, int n0, u16* __restrict__ dst, int K, float* tile) {
  const int tid = threadIdx.x & 255;
  {
    const int j = tid & 63, i0 = tid >> 6;
    const int n = n0 + j;
    const int col = CM == 1 ? colmap_win(n) : (CM == 2 ? colmap_gu(n) : n);
#pragma unroll
    for (int ii = 0; ii < 16; ++ii) {
      const int k = i0 + 4 * ii;
      tile[k * 65 + j] = src[(size_t)(k0 + k) * ld_src + col];
    }
  }
  __syncthreads();
  {
    const int kk = tid & 63, nn0 = tid >> 6;
#pragma unroll
    for (int ii = 0; ii < 16; ++ii) {
      const int n = nn0 + 4 * ii;
      dst[(size_t)(n0 + n) * K + k0 + kk] = f2bf(tile[kk * 65 + n]);
    }
  }
  __syncthreads();
}

DI void phase_prep(const Params& p, char* smem, int part) {
  const int sub = threadIdx.x >> 8;
  float* sf = (float*)smem + sub * 4352;
  float* stab = (float*)smem + 2 * 4352;
  const int tid = threadIdx.x & 255, lane = tid & 63, wave = tid >> 6;
  constexpr int N_TR_L = 512 + 256 + 1408 + 704;
  constexpr int N_TR = 2 * N_TR_L;
  constexpr int N_FOLD = 64, N_MOD = 192, N_ROPE = 256;
  constexpr int N_ALL = N_TR + N_FOLD + N_MOD + N_ROPE;
  constexpr int P_TRF = (N_TR_L + 32) / 2;
  const int nitems = part == 0 ? (N_MOD + P_TRF + N_ROPE / 2) : P_TRF;
  const int skip = (part == 1 && gridDim.x > 128) ? 64 : 0;
  const int bid = (int)blockIdx.x - skip;
  const int nb = (int)gridDim.x - skip;
  if (bid < 0) return;
  for (int pi = bid; pi < nitems; pi += nb) {
    int item;
    if (part == 0) {
      if (pi < N_MOD) item = N_TR + N_FOLD + pi;
      else if (pi < N_MOD + P_TRF) { const int q = 2 * (pi - N_MOD) + sub; item = q < N_TR_L ? q : N_TR + (q - N_TR_L); }
      else item = N_TR + N_FOLD + N_MOD + 2 * (pi - N_MOD - P_TRF) + sub;
    } else {
      const int q = 2 * pi + sub;
      item = q < N_TR_L ? N_TR_L + q : N_TR + 32 + (q - N_TR_L);
    }
    if (item < N_TR) {
      const int l = item / N_TR_L;
      int r = item - l * N_TR_L;
      if (r < 512) {
        transpose_tile<1>(p.w_in + (size_t)l * DM * IN_COLS, IN_COLS, (r >> 5) * 64, (r & 31) * 64, p.WinT + (size_t)l * ZW * DM, DM, sf);
      } else if (r < 768) {
        r -= 512;
        transpose_tile<0>(p.w_out + (size_t)l * DM * DM, DM, (r >> 4) * 64, (r & 15) * 64, p.WoutT + (size_t)l * DM * DM, DM, sf);
      } else if (r < 2176) {
        r -= 768;
        transpose_tile<2>(p.ffn_w_gu + (size_t)l * DM * 2 * DFF, 2 * DFF, (r / 88) * 64, (r % 88) * 64, p.WguT + (size_t)l * 2 * DFF * DM, DM, sf);
      } else {
        r -= 2176;
        transpose_tile<0>(p.ffn_w_down + (size_t)l * DFF * DM, DM, (r >> 4) * 64, (r & 15) * 64, p.WdT + (size_t)l * DM * DFF, DFF, sf);
      }
    } else if (item < N_TR + N_FOLD) {
      const int idx = item - N_TR;
      const int l = idx >> 5, dir = (idx >> 4) & 1, k0 = (idx & 15) * 64;
      float* wa = sf;
      float* cd = sf + 2048;
      const float* wa2 = p.gla_wa2 + (size_t)(l * 2 + dir) * 16 * 128;
      for (int i = tid; i < 2048; i += ST) wa[i] = wa2[i];
      for (int i = tid; i < 1024; i += ST) {
        const int kk = i >> 4, r = i & 15;
        cd[kk * 17 + r] = p.w_in[(size_t)l * DM * IN_COLS + (size_t)(k0 + kk) * IN_COLS + 768 + dir * 16 + r];
      }
      __syncthreads();
      const int kk = tid & 63, jg = tid >> 6;
      u16* dst = p.WinT + (size_t)l * ZW * DM;
      for (int jj = 0; jj < 32; ++jj) {
        const int j = jg * 32 + jj;
        float s = 0.f;
#pragma unroll
        for (int r = 0; r < 16; ++r) s += cd[kk * 17 + r] * wa[r * 128 + j];
        dst[(size_t)(ZGF + dir * 128 + j) * DM + k0 + kk] = f2bf(s);
      }
      __syncthreads();
    } else if (item < N_TR + N_FOLD + N_MOD) {
      const int cgi = item - N_TR - N_FOLD;
      const int gc = cgi * 64 + lane;
      const int l = gc / 6144, n = gc - l * 6144;
      for (int i = threadIdx.x; i < 17 * 1024; i += NT) {
        const float v = i < 16 * 1024 ? p.c[i] : p.c_ctx[i - 16 * 1024];
        stab[i] = silu_f(v);
      }
      __syncthreads();
      float acc[17];
#pragma unroll
      for (int r = 0; r < 17; ++r) acc[r] = 0.f;
      const float* W = p.mod_w + (size_t)l * DM * 6144 + n;
      const int kb = (threadIdx.x >> 6) * 128;
#pragma unroll 4
      for (int k = kb; k < kb + 128; ++k) {
        const float wv = W[(size_t)k * 6144];
#pragma unroll
        for (int r = 0; r < 17; ++r) acc[r] += stab[r * 1024 + k] * wv;
      }
      __syncthreads();
#pragma unroll
      for (int r = 0; r < 17; ++r) sf[(wave * 17 + r) * 64 + lane] = acc[r];
      __syncthreads();
      for (int o = threadIdx.x; o < 17 * 64; o += NT) {
        const int r = o >> 6, ln = o & 63;
        const float* s0 = (const float*)smem;
        float s = 0.f;
#pragma unroll
        for (int w8 = 0; w8 < 8; ++w8) s += s0[(w8 >> 2) * 4352 + ((w8 & 3) * 17 + r) * 64 + ln];
        const int nn = cgi * 64 + ln - l * 6144;
        p.mod[(size_t)(l * 17 + r) * 6144 + nn] = s + p.mod_b[l * 6144 + nn];
      }
      __syncthreads();
    } else {
      const int idx = item - N_TR - N_FOLD - N_MOD;
      const int e = idx * 256 + tid;
      const int t = e >> 5, f = e & 31;
      const int fi = f & 15;
      const float inv = powf(10000.f, -(float)(2 * fi) / 32.f);
      const float pos = f < 16 ? (float)(t >> 6) : (float)(t & 63);
      const float ang = pos * inv;
      p.rope[e * 2 + 0] = cosf(ang);
      p.rope[e * 2 + 1] = sinf(ang);
    }
  }
}

DI void rows_chunk(const Params& p, int mode, int row0, int nrows, int mrow, const void* xin, bool xin_bf, void* xout, bool xout_bf,
                   int l_in, int gate_idx, const float* gpost, bool write_h, int l_out, int sh_idx, const float* gpre, int lane) {
  float4 G[4], A[4], Sh[4];
#pragma unroll
  for (int i = 0; i < 4; ++i) {
    const int c0 = lane * 4 + 256 * i;
    if (mode == 1) {
      const float4 g = *(const float4*)(gpost + c0);
      const float4 gt = *(const float4*)(p.mod + (size_t)(l_in * 17 + mrow) * 6144 + gate_idx * 1024 + c0);
      G[i] = make_float4(g.x * gt.x, g.y * gt.y, g.z * gt.z, g.w * gt.w);
    }
    if (write_h) {
      const float* sh = p.mod + (size_t)(l_out * 17 + mrow) * 6144 + sh_idx * 1024 + c0;
      const float4 g = *(const float4*)(gpre + c0);
      const float4 s = *(const float4*)(sh + 1024);
      Sh[i] = *(const float4*)sh;
      A[i] = make_float4(g.x * (1.f + s.x), g.y * (1.f + s.y), g.z * (1.f + s.z), g.w * (1.f + s.w));
    }
  }
  float4 xn[4]; uint2 xb[4]; uint2 yn[4];
#define ROWS_LOAD(R) do { \
    const u16* yr_ = p.y + (size_t)(row0 + (R)) * DM + lane * 4; \
    _Pragma("unroll") for (int i = 0; i < 4; ++i) { \
      if (xin_bf) xb[i] = *(const uint2*)((const u16*)xin + (size_t)(R) * DM + lane * 4 + 256 * i); \
      else xn[i] = *(const float4*)((const float*)xin + (size_t)(R) * DM + lane * 4 + 256 * i); \
      if (mode == 1) yn[i] = *(const uint2*)(yr_ + 256 * i); } } while (0)
  ROWS_LOAD(0);
  for (int r = 0; r < nrows; ++r) {
    float4 xv[4]; uint2 yu[4];
#pragma unroll
    for (int i = 0; i < 4; ++i) {
      if (xin_bf) {
        xv[i].x = __uint_as_float(xb[i].x << 16); xv[i].y = __uint_as_float(xb[i].x & 0xffff0000u);
        xv[i].z = __uint_as_float(xb[i].y << 16); xv[i].w = __uint_as_float(xb[i].y & 0xffff0000u);
      } else xv[i] = xn[i];
      yu[i] = yn[i];
    }
    if (r + 1 < nrows) ROWS_LOAD(r + 1);
    if (mode == 1) {
      float4 yv[4];
      float ss = 0.f;
#pragma unroll
      for (int i = 0; i < 4; ++i) {
        yv[i].x = __uint_as_float(yu[i].x << 16); yv[i].y = __uint_as_float(yu[i].x & 0xffff0000u);
        yv[i].z = __uint_as_float(yu[i].y << 16); yv[i].w = __uint_as_float(yu[i].y & 0xffff0000u);
        ss += yv[i].x * yv[i].x + yv[i].y * yv[i].y + yv[i].z * yv[i].z + yv[i].w * yv[i].w;
      }
      ss = wave_sum(ss);
      const float rstd = rsqrtf(ss * (1.f / DM) + 1e-6f);
#pragma unroll
      for (int i = 0; i < 4; ++i) {
        xv[i].x += G[i].x * (yv[i].x * rstd);
        xv[i].y += G[i].y * (yv[i].y * rstd);
        xv[i].z += G[i].z * (yv[i].z * rstd);
        xv[i].w += G[i].w * (yv[i].w * rstd);
        if (xout_bf) {
          uint2 o; o.x = pack2(xv[i].x, xv[i].y); o.y = pack2(xv[i].z, xv[i].w);
          *(uint2*)((u16*)xout + (size_t)r * DM + lane * 4 + 256 * i) = o;
          xv[i].x = __uint_as_float(o.x << 16); xv[i].y = __uint_as_float(o.x & 0xffff0000u);
          xv[i].z = __uint_as_float(o.y << 16); xv[i].w = __uint_as_float(o.y & 0xffff0000u);
        } else {
          *(float4*)((float*)xout + (size_t)r * DM + lane * 4 + 256 * i) = xv[i];
        }
      }
    }
    if (write_h) {
      float ss = 0.f;
#pragma unroll
      for (int i = 0; i < 4; ++i) ss += xv[i].x * xv[i].x + xv[i].y * xv[i].y + xv[i].z * xv[i].z + xv[i].w * xv[i].w;
      ss = wave_sum(ss);
      const float rstd = rsqrtf(ss * (1.f / DM) + 1e-6f);
      u16* hr = p.h + (size_t)(row0 + r) * DM + lane * 4;
#pragma unroll
      for (int i = 0; i < 4; ++i) {
        uint2 o;
        o.x = pack2(xv[i].x * rstd * A[i].x + Sh[i].x, xv[i].y * rstd * A[i].y + Sh[i].y);
        o.y = pack2(xv[i].z * rstd * A[i].z + Sh[i].z, xv[i].w * rstd * A[i].w + Sh[i].w);
        *(uint2*)(hr + 256 * i) = o;
      }
    }
  }
#undef ROWS_LOAD
}

DI void phase_rows(const Params& p, int mode, int Mrows, int stage, int l_in, int gate_idx, const float* gpost,
                   bool write_h, int l_out, int sh_idx, const float* gpre) {
  const int tid = threadIdx.x, lane = tid & 63, wave = tid >> 6;
  const int nw = gridDim.x * 8;
  const bool xin_bf = stage >= 2, xout_bf = stage != 3;
  for (int ch = blockIdx.x * 8 + wave; ch < M_LAT / 16; ch += nw) {
    const int row0 = ch * 16;
    const void* xin = xin_bf ? (const void*)(p.xr + (size_t)row0 * DM) : (const void*)(p.x + (size_t)row0 * DM);
    void* xout = xout_bf ? (void*)(p.xr + (size_t)row0 * DM) : (void*)(p.out + (size_t)row0 * DM);
    rows_chunk(p, mode, row0, 16, row0 >> 11, xin, xin_bf, xout, xout_bf, l_in, gate_idx, gpost, write_h, l_out, sh_idx, gpre, lane);
  }
  if (Mrows > M_LAT) {
    for (int ch = blockIdx.x * 8 + wave; ch < M_CTX / 2; ch += nw) {
      const int rc = ch * 2;
      const void* xin = xin_bf ? (const void*)(p.xc + (size_t)rc * DM) : (const void*)(p.ctx + (size_t)rc * DM);
      rows_chunk(p, mode, M_LAT + rc, 2, 16, xin, xin_bf, (void*)(p.xc + (size_t)rc * DM), true, l_in, gate_idx, gpost, write_h, l_out, sh_idx, gpre, lane);
    }
  }
}

namespace pg8 {
#define PG8_LAS __attribute__((address_space(3)))
typedef unsigned short bf16_t;
typedef short bf16x8 __attribute__((ext_vector_type(8)));
typedef float f32x4 __attribute__((ext_vector_type(4)));
typedef unsigned u32x4 __attribute__((ext_vector_type(4)));
constexpr int BM = 256, BK = 64, HALF = 128, HTB = HALF * BK * 2  , STAGE_BYTES = 8 * HTB, NXCD = 8, WGM = 4;

__host__ __device__ __forceinline__ int lds_byte(int r, int c) { const int st = (r >> 4) * 2 + (c >> 5), rr = r & 15, cc = c & 31, ob = rr * 64 + cc * 2; return st * 1024 + (ob ^ (((ob >> 9) & 1) << 5)); }
__host__ __device__ __forceinline__ void stage_rc(int b, int& R, int& C) { const int st = b / 1024, sb = b % 1024, swz = sb ^ (((sb >> 9) & 1) << 5); R = (st >> 1) * 16 + swz / 64; C = (st & 1) * 32 + (swz % 64) / 2; }
__host__ __device__ __forceinline__ int perm32(int rho) { const int n = rho >> 4, i = rho & 15; return 8 * (i >> 2) + 4 * n + (i & 3); }

struct Unit { int pm, pn; };
struct Gemm { const bf16_t* A; const bf16_t* Bt; int M, N, K; };

struct StaticOrder {
    int nM, nN, nwg, G, c;
    __host__ __device__ void init(int M, int N, int G_, int c_) { nM = M / BM; nN = N / BM; nwg = nM * nN; G = G_; c = c_; }
    __host__ __device__ bool next(int i, Unit& u) const {
        const long L = (long)i * G + c; if (L >= nwg) return false;
        int wgid = (int)L; { const int q = nwg / NXCD, r = nwg % NXCD, xcd = wgid % NXCD, off = wgid / NXCD; wgid = (xcd < r ? xcd * (q + 1) : r * (q + 1) + (xcd - r) * q) + off; }
        const int nig = WGM * nN, gid = wgid / nig, fm = gid * WGM, gsz = (nM - fm) < WGM ? (nM - fm) : WGM;
        u.pm = fm + ((wgid % nig) % gsz); u.pn = (wgid % nig) / gsz; return true;
    }
    __device__ __forceinline__ void a_ready(const Unit&) const {}
    __device__ __forceinline__ void done(const Unit&) const {}
};
__device__ __forceinline__ unsigned cvt_pk_bf16(float lo, float hi) { return pack2(lo, hi); }

struct InProjLastOrder : StaticOrder {
    __host__ __device__ void init2(int G_, int c_) { init(32768, 2304, G_, c_); }
    __host__ __device__ bool next(int i, Unit& u) const {
        const long L = (long)i * G + c;
        if (L < nwg) return StaticOrder::next(i, u);
        const int j = (int)(L - nwg); if (j >= 64) return false;
        const int k = j & 3; u.pm = 128 + (j >> 2); u.pn = k < 2 ? k : k + 5; return true;
    }
};
struct EpiStoreBf16 {
    static constexpr bool PERM = true, AFTER_DRAIN = false;
    bf16_t* O; int ldc;
    __device__ __forceinline__ void operator()(const f32x4 (&acc)[2][2][4][2], const Unit& u, int wr, int wc, int fr, int fq) const {
        const int row0 = u.pm * BM + wr * 64 + fr, col0 = u.pn * BM + wc * 32 + 8 * fq;
#pragma unroll
        for (int ai = 0; ai < 2; ++ai)
#pragma unroll
            for (int m = 0; m < 4; ++m) { bf16_t* rowp = O + (size_t)(row0 + ai * HALF + m * 16) * ldc + col0;
#pragma unroll
                for (int bj = 0; bj < 2; ++bj) { const f32x4 v0 = acc[ai][bj][m][0], v1 = acc[ai][bj][m][1];
                    u32x4 w; w.x = cvt_pk_bf16(v0[0], v0[1]); w.y = cvt_pk_bf16(v0[2], v0[3]); w.z = cvt_pk_bf16(v1[0], v1[1]); w.w = cvt_pk_bf16(v1[2], v1[3]);
                    *(u32x4*)(rowp + bj * HALF) = w; } }
    }
};
struct EpiInProj {
    static constexpr bool PERM = true, AFTER_DRAIN = false;
    bf16_t* O; int ldc; const float* rope; bf16_t* vT;
    static __device__ __forceinline__ void rot(f32x4& v0, f32x4& v1, const f32x4 (&c)[4], float sg) {
        const float q0 = __shfl_xor(v0[0], 32), q1 = __shfl_xor(v0[1], 32), q2 = __shfl_xor(v0[2], 32), q3 = __shfl_xor(v0[3], 32);
        const float r0 = __shfl_xor(v1[0], 32), r1 = __shfl_xor(v1[1], 32), r2 = __shfl_xor(v1[2], 32), r3 = __shfl_xor(v1[3], 32);
        v0[0] = v0[0] * c[0][0] + sg * q0 * c[0][1]; v0[1] = v0[1] * c[0][2] + sg * q1 * c[0][3];
        v0[2] = v0[2] * c[1][0] + sg * q2 * c[1][1]; v0[3] = v0[3] * c[1][2] + sg * q3 * c[1][3];
        v1[0] = v1[0] * c[2][0] + sg * r0 * c[2][1]; v1[1] = v1[1] * c[2][2] + sg * r1 * c[2][3];
        v1[2] = v1[2] * c[3][0] + sg * r2 * c[3][1]; v1[3] = v1[3] * c[3][2] + sg * r3 * c[3][3];
    }
    __device__ __forceinline__ void emit(f32x4 v0, f32x4 v1, const Unit& u, int row, int col0, int bj, int wc, int fq, bool lat, bool dorot, const f32x4 (&c)[4], float sg) const {
        constexpr float QS = 0.125f * 1.4426950408889634f;
        if (u.pn == 7 && bj == 1) {
            const int blk = lat ? (row >> 7) : (256 + ((row - 32768) >> 7));
            const int d0 = wc * 32 + 8 * fq;
            bf16_t* vp = vT + ((size_t)(blk * 2 + (d0 >> 6)) * 64 + (d0 & 63)) * 128 + (row & 127);
#pragma unroll
            for (int j = 0; j < 4; ++j) { vp[j * 128] = f2bf(v0[j]); vp[(4 + j) * 128] = f2bf(v1[j]); }
            return;
        }
        if (dorot) rot(v0, v1, c, sg);
        if (u.pn < 7) { v0 *= QS; v1 *= QS; }
        u32x4 w; w.x = cvt_pk_bf16(v0[0], v0[1]); w.y = cvt_pk_bf16(v0[2], v0[3]); w.z = cvt_pk_bf16(v1[0], v1[1]); w.w = cvt_pk_bf16(v1[2], v1[3]);
        *(u32x4*)(O + (size_t)row * ldc + col0 + bj * HALF) = w;
    }
    __device__ __forceinline__ void operator()(const f32x4 (&acc)[2][2][4][2], const Unit& u, int wr, int wc, int fr, int fq) const {
        const int row0 = u.pm * BM + wr * 64 + fr, col0 = u.pn * BM + wc * 32 + 8 * fq;
        const bool swa = (u.pn >= 5) && (u.pn <= 7);
        if (!swa) {
#pragma unroll
            for (int ai = 0; ai < 2; ++ai)
#pragma unroll
                for (int m = 0; m < 4; ++m) { bf16_t* rowp = O + (size_t)(row0 + ai * HALF + m * 16) * ldc + col0;
#pragma unroll
                    for (int bj = 0; bj < 2; ++bj) { const f32x4 v0 = acc[ai][bj][m][0], v1 = acc[ai][bj][m][1];
                        u32x4 w; w.x = cvt_pk_bf16(v0[0], v0[1]); w.y = cvt_pk_bf16(v0[2], v0[3]); w.z = cvt_pk_bf16(v1[0], v1[1]); w.w = cvt_pk_bf16(v1[2], v1[3]);
                        *(u32x4*)(rowp + bj * HALF) = w; } }
            return;
        }
        const bool lat = u.pm < 128;
        const float sg = (fq < 2) ? -1.f : 1.f;
        if (wc & 1) {
#pragma unroll
            for (int m = 0; m < 4; ++m) {
                f32x4 c[4];
                if (lat) { const float* rp = rope + ((size_t)(16 * m + fr) * 32 + 16 + 8 * (fq & 1)) * 2;
#pragma unroll
                    for (int k = 0; k < 4; ++k) c[k] = *(const f32x4*)(rp + 4 * k); }
#pragma unroll
                for (int ai = 0; ai < 2; ++ai)
#pragma unroll
                    for (int bj = 0; bj < 2; ++bj) emit(acc[ai][bj][m][0], acc[ai][bj][m][1], u, row0 + ai * HALF + m * 16, col0, bj, wc, fq, lat, lat, c, sg);
                __builtin_amdgcn_sched_barrier(0);
            }
        } else {
#pragma unroll
            for (int ai = 0; ai < 2; ++ai) {
                f32x4 c[4];
                if (lat) { const float* rp = rope + ((size_t)((row0 + ai * HALF) & 2047) * 32 + 8 * (fq & 1)) * 2;
#pragma unroll
                    for (int k = 0; k < 4; ++k) c[k] = *(const f32x4*)(rp + 4 * k); }
#pragma unroll
                for (int m = 0; m < 4; ++m)
#pragma unroll
                    for (int bj = 0; bj < 2; ++bj) emit(acc[ai][bj][m][0], acc[ai][bj][m][1], u, row0 + ai * HALF + m * 16, col0, bj, wc, fq, lat, lat, c, sg);
                __builtin_amdgcn_sched_barrier(0);
            }
        }
    }
};
struct EpiSwiglu {
    static constexpr bool PERM = true, AFTER_DRAIN = false;
    bf16_t* O; int ldc;
    __device__ __forceinline__ void operator()(const f32x4 (&acc)[2][2][4][2], const Unit& u, int wr, int wc, int fr, int fq) const {
        const int row0 = u.pm * BM + wr * 64 + fr, col0 = u.pn * HALF + wc * 32 + 8 * fq;
#pragma unroll
        for (int ai = 0; ai < 2; ++ai)
#pragma unroll
            for (int m = 0; m < 4; ++m) { bf16_t* rowp = O + (size_t)(row0 + ai * HALF + m * 16) * ldc + col0;
                float r[8];
#pragma unroll
                for (int n = 0; n < 2; ++n)
#pragma unroll
                    for (int j = 0; j < 4; ++j) { const float g = acc[ai][0][m][n][j], up = acc[ai][1][m][n][j]; r[n * 4 + j] = g * up * __builtin_amdgcn_rcpf(1.f + __builtin_amdgcn_exp2f(g * -1.4426950408889634f)); }
                u32x4 w; w.x = cvt_pk_bf16(r[0], r[1]); w.y = cvt_pk_bf16(r[2], r[3]); w.z = cvt_pk_bf16(r[4], r[5]); w.w = cvt_pk_bf16(r[6], r[7]);
                *(u32x4*)rowp = w; }
    }
};

template <class Epi, class Sched, bool STAMP = false>
__device__ __forceinline__ void gemm_phase(PG8_LAS unsigned char* lds, const Gemm g, const Sched& S, const Epi& E, unsigned long long* stamps) {
    const int tid = threadIdx.x, wid = __builtin_amdgcn_readfirstlane(tid >> 6), lane = tid & 63, wr = wid >> 2, wc = wid & 3, fr = lane & 15, fq = lane >> 4;
    const int K = g.K, nt = K / BK;
    int ts_lo = 0, ts_hi = 0, nts = 0; const unsigned long long rt_entry = STAMP ? (unsigned long long)wall_clock64() : 0ull;
#define PG8_STAMP() do { if (STAMP && wid == 0 && nts < 64) { const unsigned long long _c = (unsigned long long)clock64(); \
        ts_lo = (lane == nts) ? (int)(unsigned)_c : ts_lo; ts_hi = (lane == nts) ? (int)(unsigned)(_c >> 32) : ts_hi; ++nts; } } while (0)
    PG8_STAMP();
    unsigned voffA[2], voffB[2];
#pragma unroll
    for (int i = 0; i < 2; ++i) { int R, C; stage_rc(tid * 16 + i * 8192, R, C); const int Rb = Epi::PERM ? ((R & ~31) + perm32(R & 31)) : R;
        voffA[i] = (unsigned)(R * K + C) * 2u; voffB[i] = (unsigned)(Rb * K + C) * 2u; }
    const size_t kstep = (size_t)(BK * 2);
    const size_t hstep = (size_t)HALF * K * 2;
    const size_t tstep = 2 * hstep;
    const unsigned ldsw = (unsigned)wid * 1024u;
    const int aoff = lds_byte(wr * 64 + fr, fq * 8), boff = lds_byte(wc * 32 + fr, fq * 8);
#define PG8_SA(b, h) (((b) * 2 + (h)) * HTB)
#define PG8_SB(b, h) ((4 + (b) * 2 + (h)) * HTB)
#define PG8_STAGE(bufoff, gbase, voff) do { _Pragma("unroll") for (int _i = 0; _i < 2; ++_i) \
        __builtin_amdgcn_global_load_lds((const unsigned*)((const char*)(gbase) + (voff)[_i]), (PG8_LAS unsigned*)(lds + (bufoff) + ldsw + _i * 8192), 16, 0, 0); } while (0)
#define PG8_LDA(dst, b, h) do { _Pragma("unroll") for (int m = 0; m < 4; ++m) _Pragma("unroll") for (int k = 0; k < 2; ++k) dst[m][k] = *(const PG8_LAS bf16x8*)(lds + PG8_SA(b, h) + aoff + m * 2048 + k * 1024); } while (0)
#define PG8_LDB(dst, b, h) do { _Pragma("unroll") for (int n = 0; n < 2; ++n) _Pragma("unroll") for (int k = 0; k < 2; ++k) dst[n][k] = *(const PG8_LAS bf16x8*)(lds + PG8_SB(b, h) + boff + n * 2048 + k * 1024); } while (0)
#define PG8_MMA(ai, bj, At, Bt) do { __builtin_amdgcn_s_setprio(1); _Pragma("unroll") for (int m = 0; m < 4; ++m) _Pragma("unroll") for (int n = 0; n < 2; ++n) _Pragma("unroll") for (int k = 0; k < 2; ++k) \
        acc[ai][bj][m][n] = __builtin_amdgcn_mfma_f32_16x16x32_bf16(Bt[n][k], At[m][k], acc[ai][bj][m][n], 0, 0, 0); __builtin_amdgcn_s_setprio(0); } while (0)
#define PG8_WAIT_V(n) asm volatile("s_waitcnt vmcnt(" #n ")" ::: "memory")
#define PG8_WAIT_L(n) asm volatile("s_waitcnt lgkmcnt(" #n ")" ::: "memory")
#define PG8_BAR __builtin_amdgcn_s_barrier()
#define PG8_SCHED __builtin_amdgcn_sched_barrier(0)
    Unit cur, nxt; int ui = 0;
    if (!S.next(0, cur)) return;
    f32x4 acc[2][2][4][2];
#pragma unroll
    for (int a = 0; a < 2; ++a)
#pragma unroll
        for (int b = 0; b < 2; ++b)
#pragma unroll
            for (int m = 0; m < 4; ++m)
#pragma unroll
                for (int n = 0; n < 2; ++n) acc[a][b][m][n] = (f32x4){0.f, 0.f, 0.f, 0.f};
    bf16x8 At[4][2], B0[2][2], B1[2][2];
    const char* cA = (const char*)g.A + (size_t)cur.pm * tstep; const char* cB = (const char*)g.Bt + (size_t)cur.pn * tstep;
    S.a_ready(cur);
    PG8_STAGE(PG8_SB(0, 0), cB, voffB); PG8_STAGE(PG8_SA(0, 0), cA, voffA); PG8_STAGE(PG8_SB(0, 1), cB + hstep, voffB); PG8_STAGE(PG8_SA(0, 1), cA + hstep, voffA);
    if (wr == 1) PG8_BAR;
    PG8_WAIT_V(4); PG8_BAR;
    PG8_STAGE(PG8_SB(1, 0), cB + kstep, voffB); PG8_STAGE(PG8_SA(1, 0), cA + kstep, voffA); PG8_STAGE(PG8_SB(1, 1), cB + hstep + kstep, voffB);
    PG8_WAIT_V(6); PG8_BAR;
    PG8_STAMP();
    for (;;) {
        const bool has_next = S.next(ui + 1, nxt);
        const char* nA = has_next ? (const char*)g.A + (size_t)nxt.pm * tstep : cA; const char* nB = has_next ? (const char*)g.Bt + (size_t)nxt.pn * tstep : cB;
        for (int t = 0; t < nt; t += 2) {
            const bool last = (t == nt - 2);
            const char* a1 = cA + (size_t)(t + 1) * kstep;
            const char* a2 = last ? nA : cA + (size_t)(t + 2) * kstep; const char* b2 = last ? nB : cB + (size_t)(t + 2) * kstep;
            const char* a3 = a2 + kstep; const char* b3 = b2 + kstep;
            if (last && has_next) S.a_ready(nxt);
            PG8_LDB(B0, 0, 0); PG8_SCHED; PG8_LDA(At, 0, 0); PG8_STAGE(PG8_SA(1, 1), a1 + hstep, voffA);
            PG8_WAIT_L(8); PG8_BAR; PG8_WAIT_L(0); PG8_MMA(0, 0, At, B0); PG8_BAR; PG8_SCHED;
            PG8_LDB(B1, 0, 1); PG8_STAGE(PG8_SB(0, 0), b2, voffB);
            PG8_BAR; PG8_WAIT_L(0); PG8_MMA(0, 1, At, B1); PG8_BAR;
            PG8_LDA(At, 0, 1); PG8_STAGE(PG8_SA(0, 0), a2, voffA);
            PG8_BAR; PG8_WAIT_L(0); PG8_MMA(1, 0, At, B0); PG8_BAR; PG8_SCHED;
            PG8_STAGE(PG8_SB(0, 1), b2 + hstep, voffB);
            PG8_WAIT_V(6); PG8_BAR; PG8_MMA(1, 1, At, B1); PG8_BAR;
            PG8_LDB(B0, 1, 0); PG8_SCHED; PG8_LDA(At, 1, 0); PG8_STAGE(PG8_SA(0, 1), a2 + hstep, voffA);
            PG8_WAIT_L(8); PG8_BAR; PG8_WAIT_L(0); PG8_MMA(0, 0, At, B0); PG8_BAR; PG8_SCHED;
            PG8_LDB(B1, 1, 1); PG8_STAGE(PG8_SB(1, 0), b3, voffB);
            PG8_BAR; PG8_WAIT_L(0); PG8_MMA(0, 1, At, B1); PG8_BAR;
            PG8_LDA(At, 1, 1); PG8_STAGE(PG8_SA(1, 0), a3, voffA);
            PG8_BAR; PG8_WAIT_L(0); PG8_MMA(1, 0, At, B0); PG8_BAR; PG8_SCHED;
            PG8_STAGE(PG8_SB(1, 1), b3 + hstep, voffB);
            PG8_WAIT_V(6); PG8_BAR; PG8_MMA(1, 1, At, B1); PG8_BAR;
        }
        PG8_STAMP();
        if constexpr (!Epi::AFTER_DRAIN) { E(acc, cur, wr, wc, fr, fq); S.done(cur); }
        PG8_STAMP();
        if (!has_next) break;
#pragma unroll
        for (int a = 0; a < 2; ++a)
#pragma unroll
            for (int b = 0; b < 2; ++b)
#pragma unroll
                for (int m = 0; m < 4; ++m)
#pragma unroll
                    for (int n = 0; n < 2; ++n) acc[a][b][m][n] = (f32x4){0.f, 0.f, 0.f, 0.f};
        cur = nxt; cA = nA; cB = nB; ++ui;
    }
    PG8_WAIT_V(0);
    if (wr == 0) PG8_BAR;
    PG8_BAR;
    if constexpr (Epi::AFTER_DRAIN) { E.fused(acc, cur, wr, wc, fr, fq, lds, wid, lane); S.done(cur); }
    PG8_STAMP();
    if (STAMP && wid == 0) { stamps[lane] = lane < nts ? (((unsigned long long)(unsigned)ts_hi << 32) | (unsigned)ts_lo) : 0ull;
        if (lane == 62) stamps[62] = rt_entry; if (lane == 63) stamps[63] = (unsigned long long)wall_clock64(); }
#undef PG8_STAMP
#undef PG8_SA
#undef PG8_SB
#undef PG8_STAGE
#undef PG8_LDA
#undef PG8_LDB
#undef PG8_MMA
#undef PG8_WAIT_V
#undef PG8_WAIT_L
#undef PG8_BAR
#undef PG8_SCHED
}
}

template <int EPI>
DI void phase_gemm(const u16* A, const u16* Bt, int M, int N, int K, u16* C, int ldc, char* smem, const float* rope = nullptr, u16* vT = nullptr) {
  pg8::Gemm g; g.A = A; g.Bt = Bt; g.M = M; g.N = N; g.K = K;
  pg8::StaticOrder S; S.init(M, N, (int)gridDim.x, (int)blockIdx.x);
  if (EPI == 3) { pg8::InProjLastOrder S2; S2.init2((int)gridDim.x, (int)blockIdx.x);
    pg8::EpiInProj E; E.O = C; E.ldc = ldc; E.rope = rope; E.vT = vT; pg8::gemm_phase<pg8::EpiInProj, pg8::InProjLastOrder, false>((PG8_LAS unsigned char*)smem, g, S2, E, nullptr); }
  else if (EPI == 2) { pg8::EpiInProj E; E.O = C; E.ldc = ldc; E.rope = rope; E.vT = vT; pg8::gemm_phase<pg8::EpiInProj, pg8::StaticOrder, false>((PG8_LAS unsigned char*)smem, g, S, E, nullptr); }
  else if (EPI == 0) { pg8::EpiStoreBf16 E; E.O = C; E.ldc = ldc; pg8::gemm_phase<pg8::EpiStoreBf16, pg8::StaticOrder, false>((PG8_LAS unsigned char*)smem, g, S, E, nullptr); }
  else { pg8::EpiSwiglu E; E.O = C; E.ldc = ldc; pg8::gemm_phase<pg8::EpiSwiglu, pg8::StaticOrder, false>((PG8_LAS unsigned char*)smem, g, S, E, nullptr); }
  __syncthreads();
}

DI void swa_item(const Params& p, int layer, int pi, bool ctxq, char* smem) {
  const int tid = opaque_tid(), lane = tid & 63, wave = tid >> 6, w4 = wave & 3;
  const int w4u = __builtin_amdgcn_readfirstlane(w4);
  const int l15 = lane & 15, lq = lane >> 4;
  const int hq = (pi & 3) * 2 + (wave >> 2);
  const int g = hq >> 2;
  int b, n;
  if (!ctxq) { n = (pi >> 2) & 15; b = pi >> 6; } else { n = (pi >> 2) & 1; b = pi >> 3; }
  const int qrow0 = (ctxq ? (M_LAT + b * TC + n * 128) : (b * TL + n * 128)) + w4 * 32;
  const int ctxrow0 = M_LAT + b * TC;
  bf16x8 Q[2][2];
#pragma unroll
  for (int rt = 0; rt < 2; ++rt)
#pragma unroll
    for (int ks = 0; ks < 2; ++ks)
      Q[rt][ks] = *(const bf16x8*)(p.z + (size_t)(qrow0 + rt * 16 + l15) * ZW + ZSQ + hq * 64 + ks * 32 + lq * 8);
  const float sink = p.swa_sink[layer * 8 + hq] * 1.4426950408889634f;
  float mrun[2], lrun[2];
  f32x4 O[4][2];
#pragma unroll
  for (int rt = 0; rt < 2; ++rt) {
    mrun[rt] = sink; lrun[rt] = (lq == 0) ? 1.f : 0.f;
#pragma unroll
    for (int dt = 0; dt < 4; ++dt) O[dt][rt] = f32x4{0.f, 0.f, 0.f, 0.f};
  }
  uint4 kreg0, kreg1, vreg0, vreg1;
#define SWA_LOAD_TILE(KT) do { \
    int krow0_, blk_; \
    if ((KT) < 3) { const int nk_ = n + (KT) - 1; krow0_ = b * TL + nk_ * 128; blk_ = b * 16 + nk_; } \
    else { krow0_ = ctxrow0 + ((KT) - 3) * 128; blk_ = 256 + b * 2 + ((KT) - 3); } \
    const u16* kb_ = p.z + (size_t)krow0_ * ZW + ZSK + g * 64; \
    const u16* vb_ = p.vT + (size_t)(blk_ * 2 + g) * 64 * 128; \
    kreg0 = *(const uint4*)(kb_ + (size_t)(tid >> 3) * ZW + (tid & 7) * 8); \
    kreg1 = *(const uint4*)(kb_ + (size_t)((tid + 512) >> 3) * ZW + (tid & 7) * 8); \
    vreg0 = *(const uint4*)(vb_ + (tid >> 4) * 128 + (tid & 15) * 8); \
    vreg1 = *(const uint4*)(vb_ + ((tid + 512) >> 4) * 128 + (tid & 15) * 8); \
  } while (0)
  int kt = ctxq ? 3 : (n == 0 ? 1 : 0);
  SWA_LOAD_TILE(kt);
  int buf = 0;
  while (kt < 5) {
    u16* Ks = (u16*)smem + buf * (128 * 72 + 64 * 136);
    u16* Vt = Ks + 128 * 72;
    *(uint4*)(Ks + (tid >> 3) * 72 + (tid & 7) * 8) = kreg0;
    *(uint4*)(Ks + ((tid + 512) >> 3) * 72 + (tid & 7) * 8) = kreg1;
    *(uint4*)(Vt + (tid >> 4) * 136 + (tid & 15) * 8) = vreg0;
    *(uint4*)(Vt + ((tid + 512) >> 4) * 136 + (tid & 15) * 8) = vreg1;
    __syncthreads();
    const int ktn = (kt == 1 && n == 15 && !ctxq) ? 3 : kt + 1;
    if (ktn < 5) SWA_LOAD_TILE(ktn);
#pragma unroll 1
    for (int hf = 0; hf < 2; ++hf) {
      f32x4 S[4][2];
#pragma unroll
      for (int c4 = 0; c4 < 4; ++c4) {
        const u16* kr = Ks + ((hf * 4 + c4) * 16 + l15) * 72 + lq * 8;
        const bf16x8 k0 = *(const bf16x8*)kr;
        const bf16x8 k1 = *(const bf16x8*)(kr + 32);
#pragma unroll
        for (int rt = 0; rt < 2; ++rt) {
          f32x4 s = f32x4{0.f, 0.f, 0.f, 0.f};
          s = MFMA16(k0, Q[rt][0], s);
          s = MFMA16(k1, Q[rt][1], s);
          S[c4][rt] = s;
        }
      }
      if (kt == 0 || kt == 2) {
        const bool prev = kt == 0;
#pragma unroll
        for (int rt = 0; rt < 2; ++rt) {
          const int dq = 2 * w4u + rt;
#pragma unroll
          for (int c4 = 0; c4 < 4; ++c4) {
            const int ct = hf * 4 + c4;
            if (prev ? (ct < dq) : (ct > dq)) {
              S[c4][rt] = f32x4{-1e30f, -1e30f, -1e30f, -1e30f};
            } else if (ct == dq) {
#pragma unroll
              for (int j = 0; j < 4; ++j) {
                const bool valid = prev ? (lq * 4 + j >= l15) : (lq * 4 + j <= l15);
                if (!valid) S[c4][rt][j] = -1e30f;
              }
            }
          }
        }
      }
      unsigned Pk[4][2][2];
#pragma unroll
      for (int rt = 0; rt < 2; ++rt) {
        float mx = S[0][rt][0];
#pragma unroll
        for (int c4 = 0; c4 < 4; ++c4)
#pragma unroll
          for (int j = 0; j < 4; ++j) mx = fmaxf(mx, S[c4][rt][j]);
        mx = fmaxf(mx, __shfl_xor(mx, 16));
        mx = fmaxf(mx, __shfl_xor(mx, 32));
        if (__builtin_amdgcn_ballot_w64(mx - mrun[rt] > 6.f) != 0ull) {
          const float mnew = fmaxf(mrun[rt], mx);
          const float alpha = __builtin_amdgcn_exp2f(mrun[rt] - mnew);
          mrun[rt] = mnew;
          lrun[rt] *= alpha;
#pragma unroll
          for (int dt = 0; dt < 4; ++dt) O[dt][rt] *= alpha;
        }
        const float mref = mrun[rt];
        float rs = 0.f;
#pragma unroll
        for (int c4 = 0; c4 < 4; ++c4) {
          float pv[4];
#pragma unroll
          for (int j = 0; j < 4; ++j) { pv[j] = __builtin_amdgcn_exp2f(S[c4][rt][j] - mref); rs += pv[j]; }
          Pk[c4][rt][0] = pack2(pv[0], pv[1]);
          Pk[c4][rt][1] = pack2(pv[2], pv[3]);
        }
        lrun[rt] += rs;
      }
#pragma unroll
      for (int kk = 0; kk < 2; ++kk) {
        bf16x8 pb[2];
#pragma unroll
        for (int rt = 0; rt < 2; ++rt) {
          uint4 t4 = make_uint4(Pk[2 * kk][rt][0], Pk[2 * kk][rt][1], Pk[2 * kk + 1][rt][0], Pk[2 * kk + 1][rt][1]);
          pb[rt] = __builtin_bit_cast(bf16x8, t4);
        }
#pragma unroll
        for (int dt = 0; dt < 4; ++dt) {
          const u16* vrow = Vt + (dt * 16 + l15) * 136 + lq * 4 + (hf * 4 + 2 * kk) * 16;
          const uint2 lo = *(const uint2*)(vrow);
          const uint2 hi = *(const uint2*)(vrow + 16);
          const bf16x8 va = __builtin_bit_cast(bf16x8, make_uint4(lo.x, lo.y, hi.x, hi.y));
#pragma unroll
          for (int rt = 0; rt < 2; ++rt) O[dt][rt] = MFMA16(va, pb[rt], O[dt][rt]);
        }
      }
    }
    kt = ktn; buf ^= 1;
  }
#pragma unroll
  for (int rt = 0; rt < 2; ++rt) {
    float l = lrun[rt];
    l += __shfl_xor(l, 16);
    l += __shfl_xor(l, 32);
    const float inv = 1.f / l;
    const int row = qrow0 + rt * 16 + l15;
#pragma unroll
    for (int dt = 0; dt < 4; ++dt) {
      uint2 o;
      o.x = pack2(O[dt][rt][0] * inv, O[dt][rt][1] * inv);
      o.y = pack2(O[dt][rt][2] * inv, O[dt][rt][3] * inv);
      *(uint2*)(p.cat + (size_t)row * DM + 512 + hq * 64 + dt * 16 + lq * 4) = o;
    }
  }
  __syncthreads();
}

DI void gmlp_item(const Params& p, int layer, int ci, char* smem) {
  const int tid = opaque_tid(), lane = tid & 63, wave = tid >> 6;
  const int l15 = lane & 15, lq = lane >> 4;
  u16* vT = (u16*)smem;
  float* rowss = (float*)(smem + 256 * 136 * 2);
  const int grow0 = ci * 128;
  {
    const int pr = tid >> 2, qd = tid & 3;
    const u16* zr = p.z + (size_t)(grow0 + pr) * ZW + ZGV + qd * 64;
    float v[64];
#pragma unroll
    for (int i = 0; i < 8; ++i) {
      const uint4 raw = *(const uint4*)(zr + i * 8);
      float f[8];
      unpack8(raw, f);
#pragma unroll
      for (int e = 0; e < 8; e += 2) {
        const f32x2_t gq = gelu_pk(f32x2_t{f[e], f[e + 1]});
        v[i * 8 + e] = gq.x; v[i * 8 + e + 1] = gq.y;
      }
    }
    float sm = 0.f;
#pragma unroll
    for (int e = 0; e < 64; ++e) sm += v[e];
    sm += __shfl_xor(sm, 1); sm += __shfl_xor(sm, 2);
    const float mean = sm * (1.f / 256.f);
    float q = 0.f;
#pragma unroll
    for (int e = 0; e < 64; ++e) { v[e] -= mean; q += v[e] * v[e]; }
    q += __shfl_xor(q, 1); q += __shfl_xor(q, 2);
    const float rstd = rsqrtf(q * (1.f / 256.f) + 1e-5f);
    const float* lng = p.gmlp_ln_g + layer * 256 + qd * 64;
    const float* lnb = p.gmlp_ln_b + layer * 256 + qd * 64;
#pragma unroll
    for (int e = 0; e < 64; e += 4) {
      const float4 gg = *(const float4*)(lng + e), bb = *(const float4*)(lnb + e);
      u16* dst = vT + (qd * 64 + e) * 136 + pr;
      dst[0] = f2bf(v[e] * rstd * gg.x + bb.x);
      dst[136] = f2bf(v[e + 1] * rstd * gg.y + bb.y);
      dst[272] = f2bf(v[e + 2] * rstd * gg.z + bb.z);
      dst[408] = f2bf(v[e + 3] * rstd * gg.w + bb.w);
    }
  }
  __syncthreads();
  const int g = wave & 3, half = wave >> 2;
  const float* ws = p.gmlp_ws + (size_t)(layer * 4 + g) * 128 * 128;
  f32x4 acc[4][4];
#pragma unroll
  for (int ct = 0; ct < 4; ++ct)
#pragma unroll
    for (int rt = 0; rt < 4; ++rt) acc[ct][rt] = f32x4{0.f, 0.f, 0.f, 0.f};
#pragma unroll 1
  for (int ks = 0; ks < 4; ++ks) {
    bf16x8 vf[4];
#pragma unroll
    for (int ct = 0; ct < 4; ++ct) vf[ct] = *(const bf16x8*)(vT + (g * 64 + ct * 16 + l15) * 136 + ks * 32 + lq * 8);
#pragma unroll
    for (int rt = 0; rt < 4; ++rt) {
      const float* wr = ws + (size_t)(half * 64 + rt * 16 + l15) * 128 + ks * 32 + lq * 8;
      const float4 w0 = *(const float4*)wr, w1 = *(const float4*)(wr + 4);
      uint4 pk;
      pk.x = pack2(w0.x, w0.y); pk.y = pack2(w0.z, w0.w); pk.z = pack2(w1.x, w1.y); pk.w = pack2(w1.z, w1.w);
      const bf16x8 wf = __builtin_bit_cast(bf16x8, pk);
#pragma unroll
      for (int ct = 0; ct < 4; ++ct) acc[ct][rt] = MFMA16(vf[ct], wf, acc[ct][rt]);
    }
  }
  const float* bs = p.gmlp_bs + (size_t)(layer * 4 + g) * 128;
  const float* og = p.gmlp_out_g + layer * 256;
#pragma unroll
  for (int rt = 0; rt < 4; ++rt) {
    const int pr = half * 64 + rt * 16 + l15;
    const float bias = bs[pr];
    const u16* zr = p.z + (size_t)(grow0 + pr) * ZW + ZGU + g * 64 + lq * 4;
    float ss = 0.f;
#pragma unroll
    for (int ct = 0; ct < 4; ++ct) {
      const uint2 ur = *(const uint2*)(zr + ct * 16);
      const f32x2_t u01 = gelu_pk(f32x2_t{__uint_as_float(ur.x << 16), __uint_as_float(ur.x & 0xffff0000u)});
      const f32x2_t u23 = gelu_pk(f32x2_t{__uint_as_float(ur.y << 16), __uint_as_float(ur.y & 0xffff0000u)});
      f32x4 val = acc[ct][rt];
      val[0] = u01.x * (val[0] + bias); val[1] = u01.y * (val[1] + bias);
      val[2] = u23.x * (val[2] + bias); val[3] = u23.y * (val[3] + bias);
      acc[ct][rt] = val;
      ss += val[0] * val[0] + val[1] * val[1] + val[2] * val[2] + val[3] * val[3];
    }
    ss += __shfl_xor(ss, 16); ss += __shfl_xor(ss, 32);
    if (lq == 0) rowss[g * 128 + pr] = ss;
  }
  __syncthreads();
#pragma unroll
  for (int rt = 0; rt < 4; ++rt) {
    const int pr = half * 64 + rt * 16 + l15;
    const float tot = rowss[pr] + rowss[128 + pr] + rowss[256 + pr] + rowss[384 + pr];
    const float rstd = rsqrtf(tot * (1.f / 256.f) + 1e-6f);
#pragma unroll
    for (int ct = 0; ct < 4; ++ct) {
      const int c = g * 64 + ct * 16 + lq * 4;
      const float4 gg = *(const float4*)(og + c);
      uint2 o;
      o.x = pack2(acc[ct][rt][0] * rstd * gg.x, acc[ct][rt][1] * rstd * gg.y);
      o.y = pack2(acc[ct][rt][2] * rstd * gg.z, acc[ct][rt][3] * rstd * gg.w);
      *(uint2*)(p.cat + (size_t)(grow0 + pr) * DM + 256 + c) = o;
    }
  }
  __syncthreads();
}

DI int gla_row(int b, int c, int s) { return c < 4 ? (M_LAT + b * TC + c * 64 + s) : (b * TL + (c - 4) * 64 + s); }
DI int gla_slot(int c, int dir) { return dir == 0 ? c : (c < 4 ? 3 - c : 39 - c); }

DI void gla_cum2(const Params& p, int layer, int b, int h, int c, float* cum2, int tid) {
  const int lane = tid & 63, wave = tid >> 6;
  {
    const int s = tid >> 2, d0 = (tid & 3) * 8;
    const u16* zr = p.z + (size_t)gla_row(b, c, s) * ZW + h * 32 + d0;
    float zf[8], zb[8];
    unpack8(*(const uint4*)(zr + ZGF), zf);
    unpack8(*(const uint4*)(zr + ZGB), zb);
    const float* baf = p.gla_ba + (size_t)(layer * 2 + 0) * 128 + h * 32 + d0;
    const float* bab = p.gla_ba + (size_t)(layer * 2 + 1) * 128 + h * 32 + d0;
#pragma unroll
    for (int e = 0; e < 8; ++e) {
      cum2[s * 32 + d0 + e] = logsigmoid_f(zf[e] + baf[e]) * (1.f / 16.f);
      cum2[2048 + s * 32 + d0 + e] = logsigmoid_f(zb[e] + bab[e]) * (1.f / 16.f);
    }
  }
  __syncthreads();
  {
    float v[16];
#pragma unroll
    for (int i = 0; i < 16; ++i) {
      const int dir = i >> 3, d = wave * 8 + (i & 7);
      const int s = dir ? 63 - lane : lane;
      v[i] = cum2[dir * 2048 + s * 32 + d];
    }
#pragma unroll
    for (int i = 0; i < 16; ++i) v[i] = wave_incl_scan(v[i]);
#pragma unroll
    for (int i = 0; i < 16; ++i) {
      const int dir = i >> 3, d = wave * 8 + (i & 7);
      const int s = dir ? 63 - lane : lane;
      cum2[dir * 2048 + s * 32 + d] = v[i];
    }
  }
  __syncthreads();
}

DI void gla_stage_vt(const Params& p, int b, int h, int c, u16* Vt, int tid) {
#pragma unroll
  for (int i = 0; i < 2; ++i) {
    const int cc = tid + 256 * i, s = cc >> 3, ch = cc & 7;
    const uint4 vv = *(const uint4*)(p.z + (size_t)gla_row(b, c, s) * ZW + ZV + h * 64 + ch * 8);
    u16* vt = Vt + (ch * 8) * 72 + s;
    vt[0 * 72] = (u16)(vv.x & 0xffff); vt[1 * 72] = (u16)(vv.x >> 16);
    vt[2 * 72] = (u16)(vv.y & 0xffff); vt[3 * 72] = (u16)(vv.y >> 16);
    vt[4 * 72] = (u16)(vv.z & 0xffff); vt[5 * 72] = (u16)(vv.z >> 16);
    vt[6 * 72] = (u16)(vv.w & 0xffff); vt[7 * 72] = (u16)(vv.w >> 16);
  }
}

constexpr int GLA_SUB_BYTES = 56320;

DI void gla_a_item(const Params& p, int layer, int pi, char* smem) {
  const int tid0 = opaque_tid();
  const int tid = tid0 & 255, sub = tid0 >> 8;
  const int lane = tid & 63, wave = tid >> 6, l15 = lane & 15, lq = lane >> 4;
  const int item = 2 * pi + sub;
  char* base = smem + sub * GLA_SUB_BYTES;
  float* cum2 = (float*)base;
  u16* ktT = (u16*)(base + 16384);
  u16* Vt = (u16*)(base + 16384 + 9216);
  const int c = item % NSLOT, h = (item / NSLOT) & 3, b = item / (NSLOT * 4);
  const int s = tid >> 2, d0 = (tid & 3) * 8;
  const uint4 kraw = *(const uint4*)(p.z + (size_t)gla_row(b, c, s) * ZW + ZK + h * 32 + d0);
  gla_stage_vt(p, b, h, c, Vt, tid);
  gla_cum2(p, layer, b, h, c, cum2, tid);
  {
    float* cg = p.cumbuf + (size_t)item * 4096;
#pragma unroll
    for (int i = 0; i < 4; ++i) *(float4*)(cg + (i * 256 + tid) * 4) = *(const float4*)(cum2 + (i * 256 + tid) * 4);
  }
  const size_t sidx0 = ((size_t)((b * 4 + h) * 2 + 0) * NSLOT + gla_slot(c, 0));
  const size_t sidx1 = ((size_t)((b * 4 + h) * 2 + 1) * NSLOT + gla_slot(c, 1));
  {
    float kf[8];
    unpack8(kraw, kf);
#pragma unroll
    for (int e = 0; e < 8; ++e) {
      ktT[(d0 + e) * 72 + s] = f2bf(kf[e] * __expf(cum2[63 * 32 + d0 + e] - cum2[s * 32 + d0 + e]));
      ktT[2304 + (d0 + e) * 72 + s] = f2bf(kf[e] * __expf(cum2[2048 + d0 + e] - cum2[2048 + s * 32 + d0 + e]));
    }
    if (tid < 32) p.Dd[sidx0 * 32 + tid] = __expf(cum2[63 * 32 + tid]);
    else if (tid < 64) p.Dd[sidx1 * 32 + tid - 32] = __expf(cum2[2048 + tid - 32]);
  }
  __syncthreads();
#pragma unroll
  for (int dir = 0; dir < 2; ++dir) {
    float* Lp = p.L + (dir ? sidx1 : sidx0) * 2048;
#pragma unroll
    for (int dt = 0; dt < 2; ++dt) {
      f32x4 acc = f32x4{0.f, 0.f, 0.f, 0.f};
#pragma unroll
      for (int ks = 0; ks < 2; ++ks) {
        const bf16x8 a = *(const bf16x8*)(ktT + dir * 2304 + (dt * 16 + l15) * 72 + ks * 32 + lq * 8);
        const bf16x8 bb = *(const bf16x8*)(Vt + (wave * 16 + l15) * 72 + ks * 32 + lq * 8);
        acc = MFMA16(a, bb, acc);
      }
#pragma unroll
      for (int j = 0; j < 4; ++j) Lp[(dt * 16 + lq * 4 + j) * 64 + wave * 16 + l15] = acc[j];
    }
  }
  __syncthreads();
}

DI void phase_gla_b(const Params& p) {
  const int total = NB * 4 * 2 * 2048;
  for (int idx = blockIdx.x * NT + threadIdx.x; idx < total; idx += gridDim.x * NT) {
    const int chain = idx >> 11, de = idx & 2047, d = de >> 6;
    float* Lp = p.L + (size_t)chain * NSLOT * 2048 + de;
    const float* Dp = p.Dd + (size_t)chain * NSLOT * 32 + d;
    float loc[NSLOT], dec[NSLOT];
#pragma unroll
    for (int sl = 0; sl < NSLOT; ++sl) { loc[sl] = Lp[(size_t)sl * 2048]; dec[sl] = Dp[sl * 32]; }
    float S = 0.f;
#pragma unroll
    for (int sl = 0; sl < NSLOT; ++sl) {
      Lp[(size_t)sl * 2048] = S;
      S = dec[sl] * S + loc[sl];
    }
  }
}

DI void gla_c_item(const Params& p, int layer, int pi, char* smem) {
  const int tid0 = opaque_tid();
  const int tid = tid0 & 255, sub = tid0 >> 8;
  const int lane = tid & 63, wave = tid >> 6, l15 = lane & 15, lq = lane >> 4;
  const int item = 2 * pi + sub;
  char* base = smem + sub * GLA_SUB_BYTES;
  float* cum2 = (float*)base;
  u16* qt = (u16*)(base + 16384);
  u16* kh = (u16*)(base + 16384 + 10240);
  u16* St = (u16*)(base + 16384 + 20480);
  u16* Vt = (u16*)(base + 16384 + 30720);
  const int c = item % NSLOT, h = (item / NSLOT) & 3, b = item / (NSLOT * 4);
  const int s = tid >> 2, d0 = (tid & 3) * 8;
  const u16* zr = p.z + (size_t)gla_row(b, c, s) * ZW + h * 32 + d0;
  const uint4 qraw = *(const uint4*)(zr + ZQ), kraw = *(const uint4*)(zr + ZK);
  const int sd = tid >> 3, se0 = (tid & 7) * 8;
  const float* Lp0 = p.L + ((size_t)((b * 4 + h) * 2 + 0) * NSLOT + gla_slot(c, 0)) * 2048 + sd * 64 + se0;
  const float* Lp1 = p.L + ((size_t)((b * 4 + h) * 2 + 1) * NSLOT + gla_slot(c, 1)) * 2048 + sd * 64 + se0;
  const float4 sf0 = *(const float4*)Lp0, sf1 = *(const float4*)(Lp0 + 4), sb0 = *(const float4*)Lp1, sb1 = *(const float4*)(Lp1 + 4);
  const float* cg = p.cumbuf + (size_t)item * 4096 + s * 32 + d0;
  float cvv[2][8];
  *(float4*)&cvv[0][0] = *(const float4*)cg;          *(float4*)&cvv[0][4] = *(const float4*)(cg + 4);
  *(float4*)&cvv[1][0] = *(const float4*)(cg + 2048); *(float4*)&cvv[1][4] = *(const float4*)(cg + 2052);
  gla_stage_vt(p, b, h, c, Vt, tid);
  {
    float qf[8], kf[8];
    unpack8(qraw, qf);
    unpack8(kraw, kf);
#pragma unroll
    for (int dir = 0; dir < 2; ++dir) {
      float qo[8], ko[8];
#pragma unroll
      for (int e = 0; e < 8; ++e) {
        const float cv = cvv[dir][e];
        qo[e] = qf[e] * 0.17677669529663687f * __expf(cv);
        ko[e] = kf[e] * __expf(-cv);
      }
      *(uint4*)(qt + dir * 2560 + s * 40 + d0) = make_uint4(pack2(qo[0], qo[1]), pack2(qo[2], qo[3]), pack2(qo[4], qo[5]), pack2(qo[6], qo[7]));
      *(uint4*)(kh + dir * 2560 + s * 40 + d0) = make_uint4(pack2(ko[0], ko[1]), pack2(ko[2], ko[3]), pack2(ko[4], ko[5]), pack2(ko[6], ko[7]));
    }
    St[(se0 + 0) * 40 + sd] = f2bf(sf0.x); St[(se0 + 1) * 40 + sd] = f2bf(sf0.y); St[(se0 + 2) * 40 + sd] = f2bf(sf0.z); St[(se0 + 3) * 40 + sd] = f2bf(sf0.w);
    St[(se0 + 4) * 40 + sd] = f2bf(sf1.x); St[(se0 + 5) * 40 + sd] = f2bf(sf1.y); St[(se0 + 6) * 40 + sd] = f2bf(sf1.z); St[(se0 + 7) * 40 + sd] = f2bf(sf1.w);
    u16* St1 = St + 2560;
    St1[(se0 + 0) * 40 + sd] = f2bf(sb0.x); St1[(se0 + 1) * 40 + sd] = f2bf(sb0.y); St1[(se0 + 2) * 40 + sd] = f2bf(sb0.z); St1[(se0 + 3) * 40 + sd] = f2bf(sb0.w);
    St1[(se0 + 4) * 40 + sd] = f2bf(sb1.x); St1[(se0 + 5) * 40 + sd] = f2bf(sb1.y); St1[(se0 + 6) * 40 + sd] = f2bf(sb1.z); St1[(se0 + 7) * 40 + sd] = f2bf(sb1.w);
  }
  __syncthreads();
  f32x4 oT[4], aT[4];
#pragma unroll
  for (int i = 0; i < 4; ++i) { oT[i] = f32x4{0.f, 0.f, 0.f, 0.f}; aT[i] = f32x4{0.f, 0.f, 0.f, 0.f}; }
  const int tq = 16 * wave + l15;
#pragma unroll
  for (int dir = 0; dir < 2; ++dir) {
    const bf16x8 qb = *(const bf16x8*)(qt + dir * 2560 + tq * 40 + lq * 8);
#pragma unroll
    for (int st = 0; st < 4; ++st) {
      const bf16x8 ka = *(const bf16x8*)(kh + dir * 2560 + (st * 16 + l15) * 40 + lq * 8);
      f32x4 sv = f32x4{0.f, 0.f, 0.f, 0.f};
      sv = MFMA16(ka, qb, sv);
#pragma unroll
      for (int j = 0; j < 4; ++j) {
        const int si = st * 16 + lq * 4 + j;
        const bool valid = dir ? (si >= tq) : (si <= tq);
        aT[st][j] += valid ? sv[j] : 0.f;
      }
    }
#pragma unroll
    for (int et = 0; et < 4; ++et) {
      const bf16x8 sa = *(const bf16x8*)(St + dir * 2560 + (et * 16 + l15) * 40 + lq * 8);
      oT[et] = MFMA16(sa, qb, oT[et]);
    }
  }
#pragma unroll
  for (int kk = 0; kk < 2; ++kk) {
    const uint4 t4 = make_uint4(pack2(aT[2 * kk][0], aT[2 * kk][1]), pack2(aT[2 * kk][2], aT[2 * kk][3]),
                                pack2(aT[2 * kk + 1][0], aT[2 * kk + 1][1]), pack2(aT[2 * kk + 1][2], aT[2 * kk + 1][3]));
    const bf16x8 pb = __builtin_bit_cast(bf16x8, t4);
#pragma unroll
    for (int et = 0; et < 4; ++et) {
      const u16* vrow = Vt + (et * 16 + l15) * 72 + lq * 4 + (2 * kk) * 16;
      const uint2 lo = *(const uint2*)vrow;
      const uint2 hi = *(const uint2*)(vrow + 16);
      const bf16x8 va = __builtin_bit_cast(bf16x8, make_uint4(lo.x, lo.y, hi.x, hi.y));
      oT[et] = MFMA16(va, pb, oT[et]);
    }
  }
  float ss = 0.f;
#pragma unroll
  for (int et = 0; et < 4; ++et)
#pragma unroll
    for (int j = 0; j < 4; ++j) ss += oT[et][j] * oT[et][j];
  ss += __shfl_xor(ss, 16);
  ss += __shfl_xor(ss, 32);
  const float rstd = rsqrtf(ss * (1.f / 64.f) + 1e-6f);
  const int row = gla_row(b, c, tq);
#pragma unroll
  for (int et = 0; et < 4; ++et) {
    const int e0 = et * 16 + lq * 4;
    const uint2 ogv = *(const uint2*)(p.z + (size_t)row * ZW + ZOG + h * 64 + e0);
    const float og0 = __uint_as_float(ogv.x << 16), og1 = __uint_as_float(ogv.x & 0xffff0000u);
    const float og2 = __uint_as_float(ogv.y << 16), og3 = __uint_as_float(ogv.y & 0xffff0000u);
    const float4 gn = *(const float4*)(p.gla_norm + layer * 64 + e0);
    uint2 o;
    o.x = pack2(oT[et][0] * rstd * gn.x * silu_f(og0), oT[et][1] * rstd * gn.y * silu_f(og1));
    o.y = pack2(oT[et][2] * rstd * gn.z * silu_f(og2), oT[et][3] * rstd * gn.w * silu_f(og3));
    *(uint2*)(p.cat + (size_t)row * DM + h * 64 + e0) = o;
  }
  __syncthreads();
}

DI void swa_norm_rows(const Params& p, int layer, int Mrows) {
  const int tid = threadIdx.x, lane = tid & 63, wave = tid >> 6;
  const int sub = lane >> 4, l16 = lane & 15;
  const float* g = p.swa_out_g + layer * 512 + l16 * 32;
  for (int row = (blockIdx.x * 8 + wave) * 4 + sub; row < Mrows; row += gridDim.x * 32) {
    u16* cp = p.cat + (size_t)row * DM + 512 + l16 * 32;
    uint4 raw[4];
#pragma unroll
    for (int i = 0; i < 4; ++i) raw[i] = *(const uint4*)(cp + i * 8);
    float f[32];
    float ss = 0.f;
#pragma unroll
    for (int i = 0; i < 4; ++i) {
      unpack8(raw[i], f + i * 8);
#pragma unroll
      for (int e = 0; e < 8; ++e) ss += f[i * 8 + e] * f[i * 8 + e];
    }
    ss += __shfl_xor(ss, 1); ss += __shfl_xor(ss, 2); ss += __shfl_xor(ss, 4); ss += __shfl_xor(ss, 8);
    const float rstd = rsqrtf(ss * (1.f / 512.f) + 1e-6f);
#pragma unroll
    for (int i = 0; i < 4; ++i) {
      const float4 g0 = *(const float4*)(g + i * 8), g1 = *(const float4*)(g + i * 8 + 4);
      uint4 o;
      o.x = pack2(f[i * 8 + 0] * rstd * g0.x, f[i * 8 + 1] * rstd * g0.y); o.y = pack2(f[i * 8 + 2] * rstd * g0.z, f[i * 8 + 3] * rstd * g0.w);
      o.z = pack2(f[i * 8 + 4] * rstd * g1.x, f[i * 8 + 5] * rstd * g1.y); o.w = pack2(f[i * 8 + 6] * rstd * g1.z, f[i * 8 + 7] * rstd * g1.w);
      *(uint4*)(cp + i * 8) = o;
    }
  }
}

DI void phase_mix_a(const Params& p, int layer, char* smem) {
  const bool need_ctx = layer == 0;
  const int n_swa = 1024, n_swac = need_ctx ? 128 : 0, n_gm = need_ctx ? 288 : 256, n_gla = NB * 4 * NSLOT / 2;
  const int total = n_swa + n_swac + n_gm + n_gla;
  unsigned* ctr = p.bar + XB_QCTR(layer);
  volatile unsigned* nxt = (volatile unsigned*)(smem + SMEM_BYTES) + 3;
  int item = blockIdx.x;
  while (item < total) {
    unsigned got = 0;
    if (threadIdx.x == 0) got = __hip_atomic_fetch_add(ctr, 1u, __ATOMIC_RELAXED, __HIP_MEMORY_SCOPE_AGENT);
    int it = item;
    if (it < n_swa) swa_item(p, layer, it, false, smem);
    else if ((it -= n_swa) < n_swac) swa_item(p, layer, it, true, smem);
    else if ((it -= n_swac) < n_gm) gmlp_item(p, layer, it, smem);
    else gla_a_item(p, layer, it - n_gm, smem);
    if (threadIdx.x == 0) *nxt = got + gridDim.x;
    __syncthreads();
    item = (int)*nxt;
    __syncthreads();
  }
}

DI void phase_mix_c(const Params& p, int layer, char* smem) {
  const bool need_ctx = layer == 0;
  const int n_gla = NB * 4 * NSLOT / 2;
  for (int item = blockIdx.x; item < n_gla; item += gridDim.x) {
    const int c = (2 * item) % NSLOT;
    if (!need_ctx && c < 4) continue;
    gla_c_item(p, layer, item, smem);
  }
  swa_norm_rows(p, layer, need_ctx ? M_ALL : M_LAT);
}


#define XB_TMO      128
#define XB_XCNT(j)  (256  + 64 * (j))
#define XB_XSUB(j)  (1280 + 64 * (j))
#define XB_XGEN(j)  (2304 + 64 * (j))
#define XB_TOP      3328
#define XB_TOPGEN   3392
#define XB_SPIN_CAP (1u << 22)
#define LAS __attribute__((address_space(3)))
DI unsigned xb_ld(unsigned* p) { return __hip_atomic_load(p, __ATOMIC_RELAXED, __HIP_MEMORY_SCOPE_AGENT); }
DI unsigned xb_add(unsigned* p, unsigned v) { return __hip_atomic_fetch_add(p, v, __ATOMIC_RELAXED, __HIP_MEMORY_SCOPE_AGENT); }
DI unsigned xb_xcc_id() { return (unsigned)__builtin_amdgcn_s_getreg((3 << 11) | 20) & 0xFu; }
#define XB_SPIN(cond, bar) do { unsigned _sp = 0; while (cond) { __builtin_amdgcn_s_sleep(1); \
    if ((++_sp & 255u) == 0u) { if (xb_ld(&(bar)[XB_TMO])) break; if (_sp > XB_SPIN_CAP) { atomicAdd(&(bar)[XB_TMO], 1u); break; } } } } while (0)
struct XcdBarrier { unsigned* bar; unsigned x; volatile LAS unsigned* st; };
DI XcdBarrier xcd_barrier_post(unsigned* bar, volatile LAS unsigned* st) {
  XcdBarrier b; b.bar = bar; b.x = xb_xcc_id(); b.st = st;
  if (threadIdx.x == 0) (void)xb_add(&bar[XB_XCNT(b.x)], 1u);
  return b;
}
DI void xcd_barrier_complete(unsigned* bar, unsigned x, unsigned& nloc, unsigned& nx) {
  const unsigned G = gridDim.x * gridDim.y * gridDim.z;
  unsigned sum, cnt, mine, sp = 0u;
  for (;;) {
    sum = 0u; cnt = 0u; mine = 0u;
#pragma unroll
    for (unsigned j = 0; j < 16; ++j) { const unsigned c = xb_ld(&bar[XB_XCNT(j)]); sum += c; cnt += (c > 0u) ? 1u : 0u; mine = (j == x) ? c : mine; }
    if (sum == G) break;
    __builtin_amdgcn_s_sleep(1);
    if ((++sp & 255u) == 0u) { if (xb_ld(&bar[XB_TMO])) break; if (sp > XB_SPIN_CAP) { atomicAdd(&bar[XB_TMO], 1u); break; } }
  }
  nloc = mine > 0u ? mine : 1u; nx = cnt > 0u ? cnt : 1u;
}
DI void xcd_barrier(const XcdBarrier& b) {
  asm volatile("s_waitcnt vmcnt(0)" ::: "memory");
  __syncthreads();
  if (threadIdx.x == 0) {
    unsigned* bar = b.bar;
    __builtin_amdgcn_s_waitcnt(0);
    unsigned nloc = b.st[0], nx = b.st[1];
    if (nloc == 0u) { xcd_barrier_complete(bar, b.x, nloc, nx); b.st[0] = nloc; b.st[1] = nx; }
    const unsigned old = xb_add(&bar[XB_XSUB(b.x)], 1u);
    const unsigned gen = old / nloc;
    if (old + 1u == (gen + 1u) * nloc) {
      __builtin_amdgcn_fence(__ATOMIC_RELEASE, "agent");
      asm volatile("s_waitcnt vmcnt(0)" ::: "memory");
      const unsigned og = xb_add(&bar[XB_TOP], 1u);
      const unsigned tg = og / nx;
      if (og + 1u == (tg + 1u) * nx) xb_add(&bar[XB_TOPGEN], 1u);
      else XB_SPIN(xb_ld(&bar[XB_TOPGEN]) == tg, bar);
      __builtin_amdgcn_fence(__ATOMIC_ACQUIRE, "agent");
      xb_add(&bar[XB_XGEN(b.x)], 1u);
      asm volatile("s_waitcnt vmcnt(0)" ::: "memory");
    } else {
      XB_SPIN(xb_ld(&bar[XB_XGEN(b.x)]) == gen, bar);
      __builtin_amdgcn_fence(__ATOMIC_ACQUIRE, "agent");
      asm volatile("s_waitcnt vmcnt(0)" ::: "memory");
    }
  }
  __syncthreads();
}

constexpr int N_STEPS = 2 + 2 * 9;

DI void run_step(const Params& p, int step, char* smem) {
  if (step == 0) { phase_prep(p, smem, 0); return; }
  if (step == 1) { phase_rows(p, 0, M_ALL, 0, 0, 0, nullptr, true, 0, 0, p.n1_pre); return; }
  const int l = (step - 2) / 9, ph = (step - 2) % 9;
  const int Mo = l == 0 ? M_ALL : M_LAT;
  switch (ph) {
    case 0: if (l == 0) phase_gemm<2>(p.h, p.WinT + (size_t)l * ZW * DM, M_ALL, ZW, DM, p.z, ZW, smem, p.rope, p.vT);
            else phase_gemm<3>(p.h, p.WinT + (size_t)l * ZW * DM, M_ALL, ZW, DM, p.z, ZW, smem, p.rope, p.vT);
            break;
    case 1: phase_mix_a(p, l, smem); break;
    case 2: phase_gla_b(p); break;
    case 3: phase_mix_c(p, l, smem); break;
    case 4: phase_gemm<0>(p.cat, p.WoutT + (size_t)l * DM * DM, Mo, DM, DM, p.y, DM, smem); break;
    case 5: phase_rows(p, 1, Mo, l == 0 ? 1 : 2, l, 2, p.n1_post + l * DM, true, l, 3, p.n2_pre + l * DM); break;
    case 6: phase_gemm<1>(p.h, p.WguT + (size_t)l * 2 * DFF * DM, Mo, 2 * DFF, DM, p.act, DFF, smem); break;
    case 7: phase_gemm<0>(p.act, p.WdT + (size_t)l * DM * DFF, Mo, DM, DFF, p.y, DM, smem);
            if (l == 0) phase_prep(p, smem, 1);
            break;
    case 8: phase_rows(p, 1, Mo, l == 0 ? 2 : 3, l, 5, p.n2_post + l * DM, l == 0, l + 1, 0, p.n1_pre + (l + 1 < 2 ? l + 1 : 1) * DM); break;
  }
}

template <int S>
DI void run_one(const Params& p, int step_begin, int step_end, int use_cg, const XcdBarrier& xb, char* smem) {
  if (step_begin <= S && S < step_end) {
    run_step(p, S, smem);
    if (S + 1 < step_end) {
      if (use_cg) cg::this_grid().sync();
      else xcd_barrier(xb);
    }
  }
}

__global__ void __launch_bounds__(NT, 2) fwd_kernel(Params p_unused, int step_begin, int step_end, int use_cg) {
  __shared__ __attribute__((aligned(16))) char smem[SMEM_BYTES + 16];
  uint4& xb_words = *(uint4*)(smem + SMEM_BYTES);
  const Params& p = *(const Params*)__builtin_amdgcn_kernarg_segment_ptr();
  if (threadIdx.x == 0) xb_words = make_uint4(0u, 0u, 0u, 0u);
  __syncthreads();
  XcdBarrier xb = xcd_barrier_post(p.bar, (volatile LAS unsigned*)&xb_words);
  run_one<0>(p, step_begin, step_end, use_cg, xb, smem);  run_one<1>(p, step_begin, step_end, use_cg, xb, smem);
  run_one<2>(p, step_begin, step_end, use_cg, xb, smem);  run_one<3>(p, step_begin, step_end, use_cg, xb, smem);
  run_one<4>(p, step_begin, step_end, use_cg, xb, smem);  run_one<5>(p, step_begin, step_end, use_cg, xb, smem);
  run_one<6>(p, step_begin, step_end, use_cg, xb, smem);  run_one<7>(p, step_begin, step_end, use_cg, xb, smem);
  run_one<8>(p, step_begin, step_end, use_cg, xb, smem);  run_one<9>(p, step_begin, step_end, use_cg, xb, smem);
  run_one<10>(p, step_begin, step_end, use_cg, xb, smem); run_one<11>(p, step_begin, step_end, use_cg, xb, smem);
  run_one<12>(p, step_begin, step_end, use_cg, xb, smem); run_one<13>(p, step_begin, step_end, use_cg, xb, smem);
  run_one<14>(p, step_begin, step_end, use_cg, xb, smem); run_one<15>(p, step_begin, step_end, use_cg, xb, smem);
  run_one<16>(p, step_begin, step_end, use_cg, xb, smem); run_one<17>(p, step_begin, step_end, use_cg, xb, smem);
  run_one<18>(p, step_begin, step_end, use_cg, xb, smem); run_one<19>(p, step_begin, step_end, use_cg, xb, smem);
}

extern "C" void kernel_launch(void* const* d_in, const int* in_sizes, int n_in, void* d_out, int out_size, void* d_ws,
                              size_t ws_size, hipStream_t stream) {
  static int grid_blocks = 0;
  if (!grid_blocks) {
    int dev = 0, cus = 0, per_cu = 0;
    hipGetDevice(&dev);
    hipDeviceGetAttribute(&cus, hipDeviceAttributeMultiprocessorCount, dev);
    hipOccupancyMaxActiveBlocksPerMultiprocessor(&per_cu, fwd_kernel, NT, 0);
    if (per_cu < 1) per_cu = 1;
    if (per_cu > 1) per_cu = 1;
    grid_blocks = cus * per_cu;
  }
  Params p{};
  const float** fp = (const float**)&p;
  for (int i = 0; i < 24; ++i) fp[i] = (const float*)d_in[i];
  p.out = (float*)d_out;
  char* w = (char*)d_ws;
  size_t off = 0;
  auto take = [&](size_t bytes) { char* r = w + off; off += (bytes + 255) & ~(size_t)255; return r; };
  p.WinT = (u16*)take((size_t)2 * ZW * DM * 2);
  p.WoutT = (u16*)take((size_t)2 * DM * DM * 2);
  p.WguT = (u16*)take((size_t)2 * 2 * DFF * DM * 2);
  p.WdT = (u16*)take((size_t)2 * DM * DFF * 2);
  p.mod = (float*)take((size_t)2 * 17 * 6144 * 4);
  p.rope = (float*)take((size_t)TL * 32 * 2 * 4);
  p.h = (u16*)take((size_t)M_ALL * DM * 2);
  p.z = (u16*)take((size_t)M_ALL * ZW * 2);
  p.cat = (u16*)take((size_t)M_ALL * DM * 2);
  p.act = p.z;
  p.y = p.h;
  p.xr = (u16*)take((size_t)M_LAT * DM * 2);
  p.xc = (u16*)take((size_t)M_CTX * DM * 2);
  p.L = (float*)take((size_t)NB * 4 * 2 * NSLOT * 2048 * 4);
  p.Dd = (float*)take((size_t)NB * 4 * 2 * NSLOT * 32 * 4);
  p.bar = (unsigned*)take((size_t)XCD_BAR_WORDS * 4);
  p.vT = (u16*)take((size_t)288 * 2 * 64 * 128 * 2);
  p.cumbuf = (float*)p.h;
  if (off > ws_size) { fprintf(stderr, "workspace too small: need %zu have %zu\n", off, ws_size); return; }
#if MK_ONE_LAUNCH
  int sb = 0, se = N_STEPS, use_cg = 0;
  void* args[] = {&p, &sb, &se, &use_cg};
  (void)hipMemsetAsync(p.bar, 0, (size_t)XCD_BAR_WORDS * 4, stream);
  hipError_t e = hipLaunchCooperativeKernel((void*)fwd_kernel, dim3(grid_blocks), dim3(NT), args, 0, stream);
  if (e != hipSuccess) fprintf(stderr, "cooperative launch failed: %s (grid %d)\n", hipGetErrorString(e), grid_blocks);
#else
  for (int s = 0; s < N_STEPS; ++s) fwd_kernel<<<grid_blocks, NT, 0, stream>>>(p, s, s + 1, 0);
#endif
}
```

```cpp
#include <hip/hip_runtime.h>
#include <hip/hip_cooperative_groups.h>
#include <cstdio>
namespace cg = cooperative_groups;

#ifndef MK_ONE_LAUNCH
#define MK_ONE_LAUNCH 1
#endif

#define DI __device__ __forceinline__
typedef unsigned short u16;
using bf16x8 = __attribute__((ext_vector_type(8))) short;
using f32x4 = __attribute__((ext_vector_type(4))) float;
#define MFMA16(a, b, c) __builtin_amdgcn_mfma_f32_16x16x32_bf16((a), (b), (c), 0, 0, 0)

constexpr int NT = 512;
constexpr int ST = 256;
constexpr int DM = 1024;
constexpr int NB = 16;
constexpr int TL = 2048;
constexpr int TC = 256;
constexpr int M_LAT = NB * TL;
constexpr int M_CTX = NB * TC;
constexpr int M_ALL = M_LAT + M_CTX;
constexpr int ZW = 2304;
constexpr int IN_COLS = 2080;
constexpr int DFF = 2816;
constexpr int ZQ = 0, ZK = 128, ZV = 256, ZOG = 512, ZGU = 768, ZGV = 1024, ZSQ = 1280, ZSK = 1792, ZSV = 1920, ZGF = 2048, ZGB = 2176;
constexpr int NSLOT = 36;
constexpr int SMEM_BYTES = 147456;
#define XB_QCTR(j)  (3456 + 64 * (j))
#define XCD_BAR_WORDS (3456 + 64 * 4)

struct Params {
  const float *x, *c, *ctx, *c_ctx, *mod_w, *mod_b, *n1_pre, *n1_post, *n2_pre, *n2_post, *w_in, *w_out,
      *gla_wa2, *gla_ba, *gla_norm, *gmlp_ln_g, *gmlp_ln_b, *gmlp_ws, *gmlp_bs, *gmlp_out_g, *swa_sink, *swa_out_g,
      *ffn_w_gu, *ffn_w_down;
  float* out;
  u16 *WinT, *WoutT, *WguT, *WdT;
  float *mod, *rope, *cumbuf;
  u16 *h, *z, *cat, *y, *act;
  u16 *xc, *xr; float *L, *Dd;
  unsigned* bar;
  u16* vT;
};

DI u16 f2bf(float f) { const __bf16 hv = (__bf16)f; return __builtin_bit_cast(u16, hv); }
DI float bf2f(u16 h) { return __uint_as_float(((unsigned)h) << 16); }
typedef __bf16 bf16x2_t __attribute__((ext_vector_type(2)));
typedef float f32x2_t __attribute__((ext_vector_type(2)));
DI unsigned pack2(float a, float b) { f32x2_t v = {a, b}; bf16x2_t r = __builtin_convertvector(v, bf16x2_t); return __builtin_bit_cast(unsigned, r); }
DI f32x2_t gelu_pk(f32x2_t v) {
  const f32x2_t av = __builtin_elementwise_abs(v), d = av * 0.2316418882f + 1.0f;
  f32x2_t t; t.x = __builtin_amdgcn_rcpf(d.x); t.y = __builtin_amdgcn_rcpf(d.y);
  f32x2_t q = t * 0.5307027145f + (-0.7265760135f); q = q * t + 0.7107068705f; q = q * t + (-0.142248368f); q = q * t + 0.127414796f; q = q * t;
  const f32x2_t s = (v * v) * (-0.72134752044f);
  f32x2_t e; e.x = __builtin_amdgcn_exp2f(s.x); e.y = __builtin_amdgcn_exp2f(s.y);
  const f32x2_t m = v * (q * e), r = v - m;
  f32x2_t o; o.x = v.x < 0.f ? m.x : r.x; o.y = v.y < 0.f ? m.y : r.y; return o;
}
DI int opaque_tid() { int t = threadIdx.x; asm volatile("" : "+v"(t)); return t; }
template <int CTRL, int ROWMASK>
DI float dpp_acc(float v) { const int t = __builtin_amdgcn_update_dpp(0, __float_as_int(v), CTRL, ROWMASK, 0xf, false); return v + __int_as_float(t); }
DI float wave_incl_scan(float v) {
  v = dpp_acc<0x111, 0xf>(v); v = dpp_acc<0x112, 0xf>(v); v = dpp_acc<0x114, 0xf>(v); v = dpp_acc<0x118, 0xf>(v);
  v = dpp_acc<0x142, 0xa>(v); v = dpp_acc<0x143, 0xc>(v);
  return v;
}
DI float wave_sum(float v) { return __int_as_float(__builtin_amdgcn_readlane(__float_as_int(wave_incl_scan(v)), 63)); }
DI float silu_f(float x) { return x * __builtin_amdgcn_rcpf(1.f + __expf(-x)); }
DI float gelu_f(float x) { return 0.5f * x * (1.f + erff(x * 0.70710678118654752f)); }
DI float logsigmoid_f(float z) { return fminf(z, 0.f) - __logf(1.f + __expf(-fabsf(z))); }
DI void unpack8(const uint4& v, float* f) {
  f[0] = __uint_as_float(v.x << 16); f[1] = __uint_as_float(v.x & 0xffff0000u);
  f[2] = __uint_as_float(v.y << 16); f[3] = __uint_as_float(v.y & 0xffff0000u);
  f[4] = __uint_as_float(v.z << 16); f[5] = __uint_as_float(v.z & 0xffff0000u);
  f[6] = __uint_as_float(v.w << 16); f[7] = __uint_as_float(v.w & 0xffff0000u);
}

DI int colmap_win(int n) { return n < 768 ? n : n + 32; }
DI int colmap_gu(int n) { int pn = n >> 8, w = n & 255; return pn * 128 + (w & 127) + ((w & 128) ? DFF : 0); }

template <int CM>
DI void transpose_tile(const float* __restrict__ src, int ld_src, int k0, int n0, u16* __restrict__ dst, int K, float* tile) {
  const int tid = threadIdx.x & 255;
  {
    const int j = tid & 63, i0 = tid >> 6;
    const int n = n0 + j;
    const int col = CM == 1 ? colmap_win(n) : (CM == 2 ? colmap_gu(n) : n);
#pragma unroll
    for (int ii = 0; ii < 16; ++ii) {
      const int k = i0 + 4 * ii;
      tile[k * 65 + j] = src[(size_t)(k0 + k) * ld_src + col];
    }
  }
  __syncthreads();
  {
    const int kk = tid & 63, nn0 = tid >> 6;
#pragma unroll
    for (int ii = 0; ii < 16; ++ii) {
      const int n = nn0 + 4 * ii;
      dst[(size_t)(n0 + n) * K + k0 + kk] = f2bf(tile[kk * 65 + n]);
    }
  }
  __syncthreads();
}

DI void phase_prep(const Params& p, char* smem, int part) {
  const int sub = threadIdx.x >> 8;
  float* sf = (float*)smem + sub * 4352;
  float* stab = (float*)smem + 2 * 4352;
  const int tid = threadIdx.x & 255, lane = tid & 63, wave = tid >> 6;
  constexpr int N_TR_L = 512 + 256 + 1408 + 704;
  constexpr int N_TR = 2 * N_TR_L;
  constexpr int N_FOLD = 64, N_MOD = 192, N_ROPE = 256;
  constexpr int N_ALL = N_TR + N_FOLD + N_MOD + N_ROPE;
  constexpr int P_TRF = (N_TR_L + 32) / 2;
  const int nitems = part == 0 ? (N_MOD + P_TRF + N_ROPE / 2) : P_TRF;
  const int skip = (part == 1 && gridDim.x > 128) ? 64 : 0;
  const int bid = (int)blockIdx.x - skip;
  const int nb = (int)gridDim.x - skip;
  if (bid < 0) return;
  unsigned* qctr = p.bar + XB_QCTR(2);
  volatile unsigned* qnxt = (volatile unsigned*)(smem + SMEM_BYTES) + 3;
  for (int pi = bid; pi < nitems; ) {
    unsigned got = 0;
    if (part == 0 && threadIdx.x == 0) got = __hip_atomic_fetch_add(qctr, 1u, __ATOMIC_RELAXED, __HIP_MEMORY_SCOPE_AGENT);
    const int pi_cur = pi;
    int item;
    if (part == 0) {
      if (pi < N_MOD) item = N_TR + N_FOLD + pi;
      else if (pi < N_MOD + P_TRF) { const int q = 2 * (pi - N_MOD) + sub; item = q < N_TR_L ? q : N_TR + (q - N_TR_L); }
      else item = N_TR + N_FOLD + N_MOD + 2 * (pi - N_MOD - P_TRF) + sub;
    } else {
      const int q = 2 * pi + sub;
      item = q < N_TR_L ? N_TR_L + q : N_TR + 32 + (q - N_TR_L);
    }
    if (item < N_TR) {
      const int l = item / N_TR_L;
      int r = item - l * N_TR_L;
      if (r < 512) {
        transpose_tile<1>(p.w_in + (size_t)l * DM * IN_COLS, IN_COLS, (r >> 5) * 64, (r & 31) * 64, p.WinT + (size_t)l * ZW * DM, DM, sf);
      } else if (r < 768) {
        r -= 512;
        transpose_tile<0>(p.w_out + (size_t)l * DM * DM, DM, (r >> 4) * 64, (r & 15) * 64, p.WoutT + (size_t)l * DM * DM, DM, sf);
      } else if (r < 2176) {
        r -= 768;
        transpose_tile<2>(p.ffn_w_gu + (size_t)l * DM * 2 * DFF, 2 * DFF, (r / 88) * 64, (r % 88) * 64, p.WguT + (size_t)l * 2 * DFF * DM, DM, sf);
      } else {
        r -= 2176;
        transpose_tile<0>(p.ffn_w_down + (size_t)l * DFF * DM, DM, (r >> 4) * 64, (r & 15) * 64, p.WdT + (size_t)l * DM * DFF, DFF, sf);
      }
    } else if (item < N_TR + N_FOLD) {
      const int idx = item - N_TR;
      const int l = idx >> 5, dir = (idx >> 4) & 1, k0 = (idx & 15) * 64;
      float* wa = sf;
      float* cd = sf + 2048;
      const float* wa2 = p.gla_wa2 + (size_t)(l * 2 + dir) * 16 * 128;
      for (int i = tid; i < 2048; i += ST) wa[i] = wa2[i];
      for (int i = tid; i < 1024; i += ST) {
        const int kk = i >> 4, r = i & 15;
        cd[kk * 17 + r] = p.w_in[(size_t)l * DM * IN_COLS + (size_t)(k0 + kk) * IN_COLS + 768 + dir * 16 + r];
      }
      __syncthreads();
      const int kk = tid & 63, jg = tid >> 6;
      u16* dst = p.WinT + (size_t)l * ZW * DM;
      for (int jj = 0; jj < 32; ++jj) {
        const int j = jg * 32 + jj;
        float s = 0.f;
#pragma unroll
        for (int r = 0; r < 16; ++r) s += cd[kk * 17 + r] * wa[r * 128 + j];
        dst[(size_t)(ZGF + dir * 128 + j) * DM + k0 + kk] = f2bf(s);
      }
      __syncthreads();
    } else if (item < N_TR + N_FOLD + N_MOD) {
      const int cgi = item - N_TR - N_FOLD;
      const int gc = cgi * 64 + lane;
      const int l = gc / 6144, n = gc - l * 6144;
      for (int i = threadIdx.x; i < 17 * 1024; i += NT) {
        const float v = i < 16 * 1024 ? p.c[i] : p.c_ctx[i - 16 * 1024];
        stab[i] = silu_f(v);
      }
      __syncthreads();
      float acc[17];
#pragma unroll
      for (int r = 0; r < 17; ++r) acc[r] = 0.f;
      const float* W = p.mod_w + (size_t)l * DM * 6144 + n;
      const int kb = (threadIdx.x >> 6) * 128;
#pragma unroll 4
      for (int k = kb; k < kb + 128; ++k) {
        const float wv = W[(size_t)k * 6144];
#pragma unroll
        for (int r = 0; r < 17; ++r) acc[r] += stab[r * 1024 + k] * wv;
      }
      __syncthreads();
#pragma unroll
      for (int r = 0; r < 17; ++r) sf[(wave * 17 + r) * 64 + lane] = acc[r];
      __syncthreads();
      for (int o = threadIdx.x; o < 17 * 64; o += NT) {
        const int r = o >> 6, ln = o & 63;
        const float* s0 = (const float*)smem;
        float s = 0.f;
#pragma unroll
        for (int w8 = 0; w8 < 8; ++w8) s += s0[(w8 >> 2) * 4352 + ((w8 & 3) * 17 + r) * 64 + ln];
        const int nn = cgi * 64 + ln - l * 6144;
        p.mod[(size_t)(l * 17 + r) * 6144 + nn] = s + p.mod_b[l * 6144 + nn];
      }
      __syncthreads();
    } else {
      const int idx = item - N_TR - N_FOLD - N_MOD;
      const int e = idx * 256 + tid;
      const int t = e >> 5, f = e & 31;
      const int fi = f & 15;
      const float inv = powf(10000.f, -(float)(2 * fi) / 32.f);
      const float pos = f < 16 ? (float)(t >> 6) : (float)(t & 63);
      const float ang = pos * inv;
      p.rope[e * 2 + 0] = cosf(ang);
      p.rope[e * 2 + 1] = sinf(ang);
    }
    if (part == 0) {
      if (threadIdx.x == 0) *qnxt = got + (unsigned)nb;
      __syncthreads();
      pi = (int)*qnxt;
      __syncthreads();
    } else pi = pi_cur + nb;
  }
}

DI void rows_chunk(const Params& p, int mode, int row0, int nrows, int mrow, const void* xin, bool xin_bf, void* xout, bool xout_bf,
                   int l_in, int gate_idx, const float* gpost, bool write_h, int l_out, int sh_idx, const float* gpre, int lane) {
  float4 G[4], A[4], Sh[4];
#pragma unroll
  for (int i = 0; i < 4; ++i) {
    const int c0 = lane * 4 + 256 * i;
    if (mode == 1) {
      const float4 g = *(const float4*)(gpost + c0);
      const float4 gt = *(const float4*)(p.mod + (size_t)(l_in * 17 + mrow) * 6144 + gate_idx * 1024 + c0);
      G[i] = make_float4(g.x * gt.x, g.y * gt.y, g.z * gt.z, g.w * gt.w);
    }
    if (write_h) {
      const float* sh = p.mod + (size_t)(l_out * 17 + mrow) * 6144 + sh_idx * 1024 + c0;
      const float4 g = *(const float4*)(gpre + c0);
      const float4 s = *(const float4*)(sh + 1024);
      Sh[i] = *(const float4*)sh;
      A[i] = make_float4(g.x * (1.f + s.x), g.y * (1.f + s.y), g.z * (1.f + s.z), g.w * (1.f + s.w));
    }
  }
  float4 xn[4]; uint2 xb[4]; uint2 yn[4];
#define ROWS_LOAD(R) do { \
    const u16* yr_ = p.y + (size_t)(row0 + (R)) * DM + lane * 4; \
    _Pragma("unroll") for (int i = 0; i < 4; ++i) { \
      if (xin_bf) xb[i] = *(const uint2*)((const u16*)xin + (size_t)(R) * DM + lane * 4 + 256 * i); \
      else xn[i] = *(const float4*)((const float*)xin + (size_t)(R) * DM + lane * 4 + 256 * i); \
      if (mode == 1) yn[i] = *(const uint2*)(yr_ + 256 * i); } } while (0)
  ROWS_LOAD(0);
  for (int r = 0; r < nrows; ++r) {
    float4 xv[4]; uint2 yu[4];
#pragma unroll
    for (int i = 0; i < 4; ++i) {
      if (xin_bf) {
        xv[i].x = __uint_as_float(xb[i].x << 16); xv[i].y = __uint_as_float(xb[i].x & 0xffff0000u);
        xv[i].z = __uint_as_float(xb[i].y << 16); xv[i].w = __uint_as_float(xb[i].y & 0xffff0000u);
      } else xv[i] = xn[i];
      yu[i] = yn[i];
    }
    if (r + 1 < nrows) ROWS_LOAD(r + 1);
    if (mode == 1) {
      float4 yv[4];
      float ss = 0.f;
#pragma unroll
      for (int i = 0; i < 4; ++i) {
        yv[i].x = __uint_as_float(yu[i].x << 16); yv[i].y = __uint_as_float(yu[i].x & 0xffff0000u);
        yv[i].z = __uint_as_float(yu[i].y << 16); yv[i].w = __uint_as_float(yu[i].y & 0xffff0000u);
        ss += yv[i].x * yv[i].x + yv[i].y * yv[i].y + yv[i].z * yv[i].z + yv[i].w * yv[i].w;
      }
      ss = wave_sum(ss);
      const float rstd = rsqrtf(ss * (1.f / DM) + 1e-6f);
#pragma unroll
      for (int i = 0; i < 4; ++i) {
        xv[i].x += G[i].x * (yv[i].x * rstd);
        xv[i].y += G[i].y * (yv[i].y * rstd);
        xv[i].z += G[i].z * (yv[i].z * rstd);
        xv[i].w += G[i].w * (yv[i].w * rstd);
        if (xout_bf) {
          uint2 o; o.x = pack2(xv[i].x, xv[i].y); o.y = pack2(xv[i].z, xv[i].w);
          *(uint2*)((u16*)xout + (size_t)r * DM + lane * 4 + 256 * i) = o;
          xv[i].x = __uint_as_float(o.x << 16); xv[i].y = __uint_as_float(o.x & 0xffff0000u);
          xv[i].z = __uint_as_float(o.y << 16); xv[i].w = __uint_as_float(o.y & 0xffff0000u);
        } else {
          *(float4*)((float*)xout + (size_t)r * DM + lane * 4 + 256 * i) = xv[i];
        }
      }
    }
    if (write_h) {
      float ss = 0.f;
#pragma unroll
      for (int i = 0; i < 4; ++i) ss += xv[i].x * xv[i].x + xv[i].y * xv[i].y + xv[i].z * xv[i].z + xv[i].w * xv[i].w;
      ss = wave_sum(ss);
      const float rstd = rsqrtf(ss * (1.f / DM) + 1e-6f);
      u16* hr = p.h + (size_t)(row0 + r) * DM + lane * 4;
#pragma unroll
      for (int i = 0; i < 4; ++i) {
        uint2 o;
        o.x = pack2(xv[i].x * rstd * A[i].x + Sh[i].x, xv[i].y * rstd * A[i].y + Sh[i].y);
        o.y = pack2(xv[i].z * rstd * A[i].z + Sh[i].z, xv[i].w * rstd * A[i].w + Sh[i].w);
        *(uint2*)(hr + 256 * i) = o;
      }
    }
  }
#undef ROWS_LOAD
}

DI void phase_rows(const Params& p, int mode, int Mrows, int stage, int l_in, int gate_idx, const float* gpost,
                   bool write_h, int l_out, int sh_idx, const float* gpre) {
  const int tid = threadIdx.x, lane = tid & 63, wave = tid >> 6;
  const int nw = gridDim.x * 8;
  const bool xin_bf = stage >= 2, xout_bf = stage != 3;
  for (int ch = blockIdx.x * 8 + wave; ch < M_LAT / 16; ch += nw) {
    const int row0 = ch * 16;
    const void* xin = xin_bf ? (const void*)(p.xr + (size_t)row0 * DM) : (const void*)(p.x + (size_t)row0 * DM);
    void* xout = xout_bf ? (void*)(p.xr + (size_t)row0 * DM) : (void*)(p.out + (size_t)row0 * DM);
    rows_chunk(p, mode, row0, 16, row0 >> 11, xin, xin_bf, xout, xout_bf, l_in, gate_idx, gpost, write_h, l_out, sh_idx, gpre, lane);
  }
  if (Mrows > M_LAT) {
    for (int ch = blockIdx.x * 8 + wave; ch < M_CTX / 2; ch += nw) {
      const int rc = ch * 2;
      const void* xin = xin_bf ? (const void*)(p.xc + (size_t)rc * DM) : (const void*)(p.ctx + (size_t)rc * DM);
      rows_chunk(p, mode, M_LAT + rc, 2, 16, xin, xin_bf, (void*)(p.xc + (size_t)rc * DM), true, l_in, gate_idx, gpost, write_h, l_out, sh_idx, gpre, lane);
    }
  }
}

namespace pg8 {
#define PG8_LAS __attribute__((address_space(3)))
typedef unsigned short bf16_t;
typedef short bf16x8 __attribute__((ext_vector_type(8)));
typedef float f32x4 __attribute__((ext_vector_type(4)));
typedef unsigned u32x4 __attribute__((ext_vector_type(4)));
constexpr int BM = 256, BK = 64, HALF = 128, HTB = HALF * BK * 2  , STAGE_BYTES = 8 * HTB, NXCD = 8, WGM = 4;

__host__ __device__ __forceinline__ int lds_byte(int r, int c) { const int st = (r >> 4) * 2 + (c >> 5), rr = r & 15, cc = c & 31, ob = rr * 64 + cc * 2; return st * 1024 + (ob ^ (((ob >> 9) & 1) << 5)); }
__host__ __device__ __forceinline__ void stage_rc(int b, int& R, int& C) { const int st = b / 1024, sb = b % 1024, swz = sb ^ (((sb >> 9) & 1) << 5); R = (st >> 1) * 16 + swz / 64; C = (st & 1) * 32 + (swz % 64) / 2; }
__host__ __device__ __forceinline__ int perm32(int rho) { const int n = rho >> 4, i = rho & 15; return 8 * (i >> 2) + 4 * n + (i & 3); }

struct Unit { int pm, pn; };
struct Gemm { const bf16_t* A; const bf16_t* Bt; int M, N, K; };

struct StaticOrder {
    int nM, nN, nwg, G, c;
    __host__ __device__ void init(int M, int N, int G_, int c_) { nM = M / BM; nN = N / BM; nwg = nM * nN; G = G_; c = c_; }
    __host__ __device__ bool next(int i, Unit& u) const {
        const long L = (long)i * G + c; if (L >= nwg) return false;
        int wgid = (int)L; { const int q = nwg / NXCD, r = nwg % NXCD, xcd = wgid % NXCD, off = wgid / NXCD; wgid = (xcd < r ? xcd * (q + 1) : r * (q + 1) + (xcd - r) * q) + off; }
        const int nig = WGM * nN, gid = wgid / nig, fm = gid * WGM, gsz = (nM - fm) < WGM ? (nM - fm) : WGM;
        u.pm = fm + ((wgid % nig) % gsz); u.pn = (wgid % nig) / gsz; return true;
    }
    __device__ __forceinline__ void a_ready(const Unit&) const {}
    __device__ __forceinline__ void done(const Unit&) const {}
};
__device__ __forceinline__ unsigned cvt_pk_bf16(float lo, float hi) { return pack2(lo, hi); }

struct InProjLastOrder : StaticOrder {
    __host__ __device__ void init2(int G_, int c_) { init(32768, 2304, G_, c_); }
    __host__ __device__ bool next(int i, Unit& u) const {
        const long L = (long)i * G + c;
        if (L < nwg) return StaticOrder::next(i, u);
        const int j = (int)(L - nwg); if (j >= 64) return false;
        const int k = j & 3; u.pm = 128 + (j >> 2); u.pn = k < 2 ? k : k + 5; return true;
    }
};
struct EpiStoreBf16 {
    static constexpr bool PERM = true, AFTER_DRAIN = false;
    bf16_t* O; int ldc;
    __device__ __forceinline__ void operator()(const f32x4 (&acc)[2][2][4][2], const Unit& u, int wr, int wc, int fr, int fq) const {
        const int row0 = u.pm * BM + wr * 64 + fr, col0 = u.pn * BM + wc * 32 + 8 * fq;
#pragma unroll
        for (int ai = 0; ai < 2; ++ai)
#pragma unroll
            for (int m = 0; m < 4; ++m) { bf16_t* rowp = O + (size_t)(row0 + ai * HALF + m * 16) * ldc + col0;
#pragma unroll
                for (int bj = 0; bj < 2; ++bj) { const f32x4 v0 = acc[ai][bj][m][0], v1 = acc[ai][bj][m][1];
                    u32x4 w; w.x = cvt_pk_bf16(v0[0], v0[1]); w.y = cvt_pk_bf16(v0[2], v0[3]); w.z = cvt_pk_bf16(v1[0], v1[1]); w.w = cvt_pk_bf16(v1[2], v1[3]);
                    *(u32x4*)(rowp + bj * HALF) = w; } }
    }
};
struct EpiInProj {
    static constexpr bool PERM = true, AFTER_DRAIN = false;
    bf16_t* O; int ldc; const float* rope; bf16_t* vT;
    static __device__ __forceinline__ void rot(f32x4& v0, f32x4& v1, const f32x4 (&c)[4], float sg) {
        const float q0 = __shfl_xor(v0[0], 32), q1 = __shfl_xor(v0[1], 32), q2 = __shfl_xor(v0[2], 32), q3 = __shfl_xor(v0[3], 32);
        const float r0 = __shfl_xor(v1[0], 32), r1 = __shfl_xor(v1[1], 32), r2 = __shfl_xor(v1[2], 32), r3 = __shfl_xor(v1[3], 32);
        v0[0] = v0[0] * c[0][0] + sg * q0 * c[0][1]; v0[1] = v0[1] * c[0][2] + sg * q1 * c[0][3];
        v0[2] = v0[2] * c[1][0] + sg * q2 * c[1][1]; v0[3] = v0[3] * c[1][2] + sg * q3 * c[1][3];
        v1[0] = v1[0] * c[2][0] + sg * r0 * c[2][1]; v1[1] = v1[1] * c[2][2] + sg * r1 * c[2][3];
        v1[2] = v1[2] * c[3][0] + sg * r2 * c[3][1]; v1[3] = v1[3] * c[3][2] + sg * r3 * c[3][3];
    }
    __device__ __forceinline__ void emit(f32x4 v0, f32x4 v1, const Unit& u, int row, int col0, int bj, int wc, int fq, bool lat, bool dorot, const f32x4 (&c)[4], float sg) const {
        constexpr float QS = 0.125f * 1.4426950408889634f;
        if (u.pn == 7 && bj == 1) {
            const int blk = lat ? (row >> 7) : (256 + ((row - 32768) >> 7));
            const int d0 = wc * 32 + 8 * fq;
            bf16_t* vp = vT + ((size_t)(blk * 2 + (d0 >> 6)) * 64 + (d0 & 63)) * 128 + (row & 127);
#pragma unroll
            for (int j = 0; j < 4; ++j) { vp[j * 128] = f2bf(v0[j]); vp[(4 + j) * 128] = f2bf(v1[j]); }
            return;
        }
        if (dorot) rot(v0, v1, c, sg);
        if (u.pn < 7) { v0 *= QS; v1 *= QS; }
        u32x4 w; w.x = cvt_pk_bf16(v0[0], v0[1]); w.y = cvt_pk_bf16(v0[2], v0[3]); w.z = cvt_pk_bf16(v1[0], v1[1]); w.w = cvt_pk_bf16(v1[2], v1[3]);
        *(u32x4*)(O + (size_t)row * ldc + col0 + bj * HALF) = w;
    }
    __device__ __forceinline__ void operator()(const f32x4 (&acc)[2][2][4][2], const Unit& u, int wr, int wc, int fr, int fq) const {
        const int row0 = u.pm * BM + wr * 64 + fr, col0 = u.pn * BM + wc * 32 + 8 * fq;
        const bool swa = (u.pn >= 5) && (u.pn <= 7);
        if (!swa) {
#pragma unroll
            for (int ai = 0; ai < 2; ++ai)
#pragma unroll
                for (int m = 0; m < 4; ++m) { bf16_t* rowp = O + (size_t)(row0 + ai * HALF + m * 16) * ldc + col0;
#pragma unroll
                    for (int bj = 0; bj < 2; ++bj) { const f32x4 v0 = acc[ai][bj][m][0], v1 = acc[ai][bj][m][1];
                        u32x4 w; w.x = cvt_pk_bf16(v0[0], v0[1]); w.y = cvt_pk_bf16(v0[2], v0[3]); w.z = cvt_pk_bf16(v1[0], v1[1]); w.w = cvt_pk_bf16(v1[2], v1[3]);
                        *(u32x4*)(rowp + bj * HALF) = w; } }
            return;
        }
        const bool lat = u.pm < 128;
        const float sg = (fq < 2) ? -1.f : 1.f;
        if (wc & 1) {
#pragma unroll
            for (int m = 0; m < 4; ++m) {
                f32x4 c[4];
                if (lat) { const float* rp = rope + ((size_t)(16 * m + fr) * 32 + 16 + 8 * (fq & 1)) * 2;
#pragma unroll
                    for (int k = 0; k < 4; ++k) c[k] = *(const f32x4*)(rp + 4 * k); }
#pragma unroll
                for (int ai = 0; ai < 2; ++ai)
#pragma unroll
                    for (int bj = 0; bj < 2; ++bj) emit(acc[ai][bj][m][0], acc[ai][bj][m][1], u, row0 + ai * HALF + m * 16, col0, bj, wc, fq, lat, lat, c, sg);
                __builtin_amdgcn_sched_barrier(0);
            }
        } else {
#pragma unroll
            for (int ai = 0; ai < 2; ++ai) {
                f32x4 c[4];
                if (lat) { const float* rp = rope + ((size_t)((row0 + ai * HALF) & 2047) * 32 + 8 * (fq & 1)) * 2;
#pragma unroll
                    for (int k = 0; k < 4; ++k) c[k] = *(const f32x4*)(rp + 4 * k); }
#pragma unroll
                for (int m = 0; m < 4; ++m)
#pragma unroll
                    for (int bj = 0; bj < 2; ++bj) emit(acc[ai][bj][m][0], acc[ai][bj][m][1], u, row0 + ai * HALF + m * 16, col0, bj, wc, fq, lat, lat, c, sg);
                __builtin_amdgcn_sched_barrier(0);
            }
        }
    }
};
struct EpiSwiglu {
    static constexpr bool PERM = true, AFTER_DRAIN = false;
    bf16_t* O; int ldc;
    __device__ __forceinline__ void operator()(const f32x4 (&acc)[2][2][4][2], const Unit& u, int wr, int wc, int fr, int fq) const {
        const int row0 = u.pm * BM + wr * 64 + fr, col0 = u.pn * HALF + wc * 32 + 8 * fq;
#pragma unroll
        for (int ai = 0; ai < 2; ++ai)
#pragma unroll
            for (int m = 0; m < 4; ++m) { bf16_t* rowp = O + (size_t)(row0 + ai * HALF + m * 16) * ldc + col0;
                float r[8];
#pragma unroll
                for (int n = 0; n < 2; ++n)
#pragma unroll
                    for (int j = 0; j < 4; ++j) { const float g = acc[ai][0][m][n][j], up = acc[ai][1][m][n][j]; r[n * 4 + j] = g * up * __builtin_amdgcn_rcpf(1.f + __builtin_amdgcn_exp2f(g * -1.4426950408889634f)); }
                u32x4 w; w.x = cvt_pk_bf16(r[0], r[1]); w.y = cvt_pk_bf16(r[2], r[3]); w.z = cvt_pk_bf16(r[4], r[5]); w.w = cvt_pk_bf16(r[6], r[7]);
                *(u32x4*)rowp = w; }
    }
};

template <class Epi, class Sched, bool STAMP = false>
__device__ __forceinline__ void gemm_phase(PG8_LAS unsigned char* lds, const Gemm g, const Sched& S, const Epi& E, unsigned long long* stamps) {
    const int tid = threadIdx.x, wid = __builtin_amdgcn_readfirstlane(tid >> 6), lane = tid & 63, wr = wid >> 2, wc = wid & 3, fr = lane & 15, fq = lane >> 4;
    const int K = g.K, nt = K / BK;
    int ts_lo = 0, ts_hi = 0, nts = 0; const unsigned long long rt_entry = STAMP ? (unsigned long long)wall_clock64() : 0ull;
#define PG8_STAMP() do { if (STAMP && wid == 0 && nts < 64) { const unsigned long long _c = (unsigned long long)clock64(); \
        ts_lo = (lane == nts) ? (int)(unsigned)_c : ts_lo; ts_hi = (lane == nts) ? (int)(unsigned)(_c >> 32) : ts_hi; ++nts; } } while (0)
    PG8_STAMP();
    unsigned voffA[2], voffB[2];
#pragma unroll
    for (int i = 0; i < 2; ++i) { int R, C; stage_rc(tid * 16 + i * 8192, R, C); const int Rb = Epi::PERM ? ((R & ~31) + perm32(R & 31)) : R;
        voffA[i] = (unsigned)(R * K + C) * 2u; voffB[i] = (unsigned)(Rb * K + C) * 2u; }
    const size_t kstep = (size_t)(BK * 2);
    const size_t hstep = (size_t)HALF * K * 2;
    const size_t tstep = 2 * hstep;
    const unsigned ldsw = (unsigned)wid * 1024u;
    const int aoff = lds_byte(wr * 64 + fr, fq * 8), boff = lds_byte(wc * 32 + fr, fq * 8);
#define PG8_SA(b, h) (((b) * 2 + (h)) * HTB)
#define PG8_SB(b, h) ((4 + (b) * 2 + (h)) * HTB)
#define PG8_STAGE(bufoff, gbase, voff) do { _Pragma("unroll") for (int _i = 0; _i < 2; ++_i) \
        __builtin_amdgcn_global_load_lds((const unsigned*)((const char*)(gbase) + (voff)[_i]), (PG8_LAS unsigned*)(lds + (bufoff) + ldsw + _i * 8192), 16, 0, 0); } while (0)
#define PG8_LDA(dst, b, h) do { _Pragma("unroll") for (int m = 0; m < 4; ++m) _Pragma("unroll") for (int k = 0; k < 2; ++k) dst[m][k] = *(const PG8_LAS bf16x8*)(lds + PG8_SA(b, h) + aoff + m * 2048 + k * 1024); } while (0)
#define PG8_LDB(dst, b, h) do { _Pragma("unroll") for (int n = 0; n < 2; ++n) _Pragma("unroll") for (int k = 0; k < 2; ++k) dst[n][k] = *(const PG8_LAS bf16x8*)(lds + PG8_SB(b, h) + boff + n * 2048 + k * 1024); } while (0)
#define PG8_MMA(ai, bj, At, Bt) do { __builtin_amdgcn_s_setprio(1); _Pragma("unroll") for (int m = 0; m < 4; ++m) _Pragma("unroll") for (int n = 0; n < 2; ++n) _Pragma("unroll") for (int k = 0; k < 2; ++k) \
        acc[ai][bj][m][n] = __builtin_amdgcn_mfma_f32_16x16x32_bf16(Bt[n][k], At[m][k], acc[ai][bj][m][n], 0, 0, 0); __builtin_amdgcn_s_setprio(0); } while (0)
#define PG8_WAIT_V(n) asm volatile("s_waitcnt vmcnt(" #n ")" ::: "memory")
#define PG8_WAIT_L(n) asm volatile("s_waitcnt lgkmcnt(" #n ")" ::: "memory")
#define PG8_BAR __builtin_amdgcn_s_barrier()
#define PG8_SCHED __builtin_amdgcn_sched_barrier(0)
    Unit cur, nxt; int ui = 0;
    if (!S.next(0, cur)) return;
    f32x4 acc[2][2][4][2];
#pragma unroll
    for (int a = 0; a < 2; ++a)
#pragma unroll
        for (int b = 0; b < 2; ++b)
#pragma unroll
            for (int m = 0; m < 4; ++m)
#pragma unroll
                for (int n = 0; n < 2; ++n) acc[a][b][m][n] = (f32x4){0.f, 0.f, 0.f, 0.f};
    bf16x8 At[4][2], B0[2][2], B1[2][2];
    const char* cA = (const char*)g.A + (size_t)cur.pm * tstep; const char* cB = (const char*)g.Bt + (size_t)cur.pn * tstep;
    S.a_ready(cur);
    PG8_STAGE(PG8_SB(0, 0), cB, voffB); PG8_STAGE(PG8_SA(0, 0), cA, voffA); PG8_STAGE(PG8_SB(0, 1), cB + hstep, voffB); PG8_STAGE(PG8_SA(0, 1), cA + hstep, voffA);
    if (wr == 1) PG8_BAR;
    PG8_WAIT_V(4); PG8_BAR;
    PG8_STAGE(PG8_SB(1, 0), cB + kstep, voffB); PG8_STAGE(PG8_SA(1, 0), cA + kstep, voffA); PG8_STAGE(PG8_SB(1, 1), cB + hstep + kstep, voffB);
    PG8_WAIT_V(6); PG8_BAR;
    PG8_STAMP();
    for (;;) {
        const bool has_next = S.next(ui + 1, nxt);
        const char* nA = has_next ? (const char*)g.A + (size_t)nxt.pm * tstep : cA; const char* nB = has_next ? (const char*)g.Bt + (size_t)nxt.pn * tstep : cB;
        for (int t = 0; t < nt; t += 2) {
            const bool last = (t == nt - 2);
            const char* a1 = cA + (size_t)(t + 1) * kstep;
            const char* a2 = last ? nA : cA + (size_t)(t + 2) * kstep; const char* b2 = last ? nB : cB + (size_t)(t + 2) * kstep;
            const char* a3 = a2 + kstep; const char* b3 = b2 + kstep;
            if (last && has_next) S.a_ready(nxt);
            PG8_LDB(B0, 0, 0); PG8_SCHED; PG8_LDA(At, 0, 0); PG8_STAGE(PG8_SA(1, 1), a1 + hstep, voffA);
            PG8_WAIT_L(8); PG8_BAR; PG8_WAIT_L(0); PG8_MMA(0, 0, At, B0); PG8_BAR; PG8_SCHED;
            PG8_LDB(B1, 0, 1); PG8_STAGE(PG8_SB(0, 0), b2, voffB);
            PG8_BAR; PG8_WAIT_L(0); PG8_MMA(0, 1, At, B1); PG8_BAR;
            PG8_LDA(At, 0, 1); PG8_STAGE(PG8_SA(0, 0), a2, voffA);
            PG8_BAR; PG8_WAIT_L(0); PG8_MMA(1, 0, At, B0); PG8_BAR; PG8_SCHED;
            PG8_STAGE(PG8_SB(0, 1), b2 + hstep, voffB);
            PG8_WAIT_V(6); PG8_BAR; PG8_MMA(1, 1, At, B1); PG8_BAR;
            PG8_LDB(B0, 1, 0); PG8_SCHED; PG8_LDA(At, 1, 0); PG8_STAGE(PG8_SA(0, 1), a2 + hstep, voffA);
            PG8_WAIT_L(8); PG8_BAR; PG8_WAIT_L(0); PG8_MMA(0, 0, At, B0); PG8_BAR; PG8_SCHED;
            PG8_LDB(B1, 1, 1); PG8_STAGE(PG8_SB(1, 0), b3, voffB);
            PG8_BAR; PG8_WAIT_L(0); PG8_MMA(0, 1, At, B1); PG8_BAR;
            PG8_LDA(At, 1, 1); PG8_STAGE(PG8_SA(1, 0), a3, voffA);
            PG8_BAR; PG8_WAIT_L(0); PG8_MMA(1, 0, At, B0); PG8_BAR; PG8_SCHED;
            PG8_STAGE(PG8_SB(1, 1), b3 + hstep, voffB);
            PG8_WAIT_V(6); PG8_BAR; PG8_MMA(1, 1, At, B1); PG8_BAR;
        }
        PG8_STAMP();
        if constexpr (!Epi::AFTER_DRAIN) { E(acc, cur, wr, wc, fr, fq); S.done(cur); }
        PG8_STAMP();
        if (!has_next) break;
#pragma unroll
        for (int a = 0; a < 2; ++a)
#pragma unroll
            for (int b = 0; b < 2; ++b)
#pragma unroll
                for (int m = 0; m < 4; ++m)
#pragma unroll
                    for (int n = 0; n < 2; ++n) acc[a][b][m][n] = (f32x4){0.f, 0.f, 0.f, 0.f};
        cur = nxt; cA = nA; cB = nB; ++ui;
    }
    PG8_WAIT_V(0);
    if (wr == 0) PG8_BAR;
    PG8_BAR;
    if constexpr (Epi::AFTER_DRAIN) { E.fused(acc, cur, wr, wc, fr, fq, lds, wid, lane); S.done(cur); }
    PG8_STAMP();
    if (STAMP && wid == 0) { stamps[lane] = lane < nts ? (((unsigned long long)(unsigned)ts_hi << 32) | (unsigned)ts_lo) : 0ull;
        if (lane == 62) stamps[62] = rt_entry; if (lane == 63) stamps[63] = (unsigned long long)wall_clock64(); }
#undef PG8_STAMP
#undef PG8_SA
#undef PG8_SB
#undef PG8_STAGE
#undef PG8_LDA
#undef PG8_LDB
#undef PG8_MMA
#undef PG8_WAIT_V
#undef PG8_WAIT_L
#undef PG8_BAR
#undef PG8_SCHED
}
}

template <int EPI>
DI void phase_gemm(const u16* A, const u16* Bt, int M, int N, int K, u16* C, int ldc, char* smem, const float* rope = nullptr, u16* vT = nullptr) {
  pg8::Gemm g; g.A = A; g.Bt = Bt; g.M = M; g.N = N; g.K = K;
  pg8::StaticOrder S; S.init(M, N, (int)gridDim.x, (int)blockIdx.x);
  if (EPI == 3) { pg8::InProjLastOrder S2; S2.init2((int)gridDim.x, (int)blockIdx.x);
    pg8::EpiInProj E; E.O = C; E.ldc = ldc; E.rope = rope; E.vT = vT; pg8::gemm_phase<pg8::EpiInProj, pg8::InProjLastOrder, false>((PG8_LAS unsigned char*)smem, g, S2, E, nullptr); }
  else if (EPI == 2) { pg8::EpiInProj E; E.O = C; E.ldc = ldc; E.rope = rope; E.vT = vT; pg8::gemm_phase<pg8::EpiInProj, pg8::StaticOrder, false>((PG8_LAS unsigned char*)smem, g, S, E, nullptr); }
  else if (EPI == 0) { pg8::EpiStoreBf16 E; E.O = C; E.ldc = ldc; pg8::gemm_phase<pg8::EpiStoreBf16, pg8::StaticOrder, false>((PG8_LAS unsigned char*)smem, g, S, E, nullptr); }
  else { pg8::EpiSwiglu E; E.O = C; E.ldc = ldc; pg8::gemm_phase<pg8::EpiSwiglu, pg8::StaticOrder, false>((PG8_LAS unsigned char*)smem, g, S, E, nullptr); }
  __syncthreads();
}

DI void swa_item(const Params& p, int layer, int pi, bool ctxq, char* smem) {
  const int tid = opaque_tid(), lane = tid & 63, wave = tid >> 6, w4 = wave & 3;
  const int w4u = __builtin_amdgcn_readfirstlane(w4);
  const int l15 = lane & 15, lq = lane >> 4;
  const int hq = (pi & 3) * 2 + (wave >> 2);
  const int g = hq >> 2;
  int b, n;
  if (!ctxq) { n = (pi >> 2) & 15; b = pi >> 6; } else { n = (pi >> 2) & 1; b = pi >> 3; }
  const int qrow0 = (ctxq ? (M_LAT + b * TC + n * 128) : (b * TL + n * 128)) + w4 * 32;
  const int ctxrow0 = M_LAT + b * TC;
  bf16x8 Q[2][2];
#pragma unroll
  for (int rt = 0; rt < 2; ++rt)
#pragma unroll
    for (int ks = 0; ks < 2; ++ks)
      Q[rt][ks] = *(const bf16x8*)(p.z + (size_t)(qrow0 + rt * 16 + l15) * ZW + ZSQ + hq * 64 + ks * 32 + lq * 8);
  const float sink = p.swa_sink[layer * 8 + hq] * 1.4426950408889634f;
  float mrun[2], lrun[2];
  f32x4 O[4][2];
#pragma unroll
  for (int rt = 0; rt < 2; ++rt) {
    mrun[rt] = sink; lrun[rt] = (lq == 0) ? 1.f : 0.f;
#pragma unroll
    for (int dt = 0; dt < 4; ++dt) O[dt][rt] = f32x4{0.f, 0.f, 0.f, 0.f};
  }
  uint4 kreg0, kreg1, vreg0, vreg1;
#define SWA_LOAD_TILE(KT) do { \
    int krow0_, blk_; \
    if ((KT) < 3) { const int nk_ = n + (KT) - 1; krow0_ = b * TL + nk_ * 128; blk_ = b * 16 + nk_; } \
    else { krow0_ = ctxrow0 + ((KT) - 3) * 128; blk_ = 256 + b * 2 + ((KT) - 3); } \
    const u16* kb_ = p.z + (size_t)krow0_ * ZW + ZSK + g * 64; \
    const u16* vb_ = p.vT + (size_t)(blk_ * 2 + g) * 64 * 128; \
    kreg0 = *(const uint4*)(kb_ + (size_t)(tid >> 3) * ZW + (tid & 7) * 8); \
    kreg1 = *(const uint4*)(kb_ + (size_t)((tid + 512) >> 3) * ZW + (tid & 7) * 8); \
    vreg0 = *(const uint4*)(vb_ + (tid >> 4) * 128 + (tid & 15) * 8); \
    vreg1 = *(const uint4*)(vb_ + ((tid + 512) >> 4) * 128 + (tid & 15) * 8); \
  } while (0)
  int kt = ctxq ? 3 : (n == 0 ? 1 : 0);
  SWA_LOAD_TILE(kt);
  int buf = 0;
  while (kt < 5) {
    u16* Ks = (u16*)smem + buf * (128 * 72 + 64 * 136);
    u16* Vt = Ks + 128 * 72;
    *(uint4*)(Ks + (tid >> 3) * 72 + (tid & 7) * 8) = kreg0;
    *(uint4*)(Ks + ((tid + 512) >> 3) * 72 + (tid & 7) * 8) = kreg1;
    *(uint4*)(Vt + (tid >> 4) * 136 + (tid & 15) * 8) = vreg0;
    *(uint4*)(Vt + ((tid + 512) >> 4) * 136 + (tid & 15) * 8) = vreg1;
    __syncthreads();
    const int ktn = (kt == 1 && n == 15 && !ctxq) ? 3 : kt + 1;
    if (ktn < 5) SWA_LOAD_TILE(ktn);
#pragma unroll 1
    for (int hf = 0; hf < 2; ++hf) {
      f32x4 S[4][2];
#pragma unroll
      for (int c4 = 0; c4 < 4; ++c4) {
        const u16* kr = Ks + ((hf * 4 + c4) * 16 + l15) * 72 + lq * 8;
        const bf16x8 k0 = *(const bf16x8*)kr;
        const bf16x8 k1 = *(const bf16x8*)(kr + 32);
#pragma unroll
        for (int rt = 0; rt < 2; ++rt) {
          f32x4 s = f32x4{0.f, 0.f, 0.f, 0.f};
          s = MFMA16(k0, Q[rt][0], s);
          s = MFMA16(k1, Q[rt][1], s);
          S[c4][rt] = s;
        }
      }
      if (kt == 0 || kt == 2) {
        const bool prev = kt == 0;
#pragma unroll
        for (int rt = 0; rt < 2; ++rt) {
          const int dq = 2 * w4u + rt;
#pragma unroll
          for (int c4 = 0; c4 < 4; ++c4) {
            const int ct = hf * 4 + c4;
            if (prev ? (ct < dq) : (ct > dq)) {
              S[c4][rt] = f32x4{-1e30f, -1e30f, -1e30f, -1e30f};
            } else if (ct == dq) {
#pragma unroll
              for (int j = 0; j < 4; ++j) {
                const bool valid = prev ? (lq * 4 + j >= l15) : (lq * 4 + j <= l15);
                if (!valid) S[c4][rt][j] = -1e30f;
              }
            }
          }
        }
      }
      unsigned Pk[4][2][2];
#pragma unroll
      for (int rt = 0; rt < 2; ++rt) {
        float mx = S[0][rt][0];
#pragma unroll
        for (int c4 = 0; c4 < 4; ++c4)
#pragma unroll
          for (int j = 0; j < 4; ++j) mx = fmaxf(mx, S[c4][rt][j]);
        mx = fmaxf(mx, __shfl_xor(mx, 16));
        mx = fmaxf(mx, __shfl_xor(mx, 32));
        if (__builtin_amdgcn_ballot_w64(mx - mrun[rt] > 6.f) != 0ull) {
          const float mnew = fmaxf(mrun[rt], mx);
          const float alpha = __builtin_amdgcn_exp2f(mrun[rt] - mnew);
          mrun[rt] = mnew;
          lrun[rt] *= alpha;
#pragma unroll
          for (int dt = 0; dt < 4; ++dt) O[dt][rt] *= alpha;
        }
        const float mref = mrun[rt];
        float rs = 0.f;
#pragma unroll
        for (int c4 = 0; c4 < 4; ++c4) {
          float pv[4];
#pragma unroll
          for (int j = 0; j < 4; ++j) { pv[j] = __builtin_amdgcn_exp2f(S[c4][rt][j] - mref); rs += pv[j]; }
          Pk[c4][rt][0] = pack2(pv[0], pv[1]);
          Pk[c4][rt][1] = pack2(pv[2], pv[3]);
        }
        lrun[rt] += rs;
      }
#pragma unroll
      for (int kk = 0; kk < 2; ++kk) {
        bf16x8 pb[2];
#pragma unroll
        for (int rt = 0; rt < 2; ++rt) {
          uint4 t4 = make_uint4(Pk[2 * kk][rt][0], Pk[2 * kk][rt][1], Pk[2 * kk + 1][rt][0], Pk[2 * kk + 1][rt][1]);
          pb[rt] = __builtin_bit_cast(bf16x8, t4);
        }
#pragma unroll
        for (int dt = 0; dt < 4; ++dt) {
          const u16* vrow = Vt + (dt * 16 + l15) * 136 + lq * 4 + (hf * 4 + 2 * kk) * 16;
          const uint2 lo = *(const uint2*)(vrow);
          const uint2 hi = *(const uint2*)(vrow + 16);
          const bf16x8 va = __builtin_bit_cast(bf16x8, make_uint4(lo.x, lo.y, hi.x, hi.y));
#pragma unroll
          for (int rt = 0; rt < 2; ++rt) O[dt][rt] = MFMA16(va, pb[rt], O[dt][rt]);
        }
      }
    }
    kt = ktn; buf ^= 1;
  }
#pragma unroll
  for (int rt = 0; rt < 2; ++rt) {
    float l = lrun[rt];
    l += __shfl_xor(l, 16);
    l += __shfl_xor(l, 32);
    const float inv = 1.f / l;
    const int row = qrow0 + rt * 16 + l15;
#pragma unroll
    for (int dt = 0; dt < 4; ++dt) {
      uint2 o;
      o.x = pack2(O[dt][rt][0] * inv, O[dt][rt][1] * inv);
      o.y = pack2(O[dt][rt][2] * inv, O[dt][rt][3] * inv);
      *(uint2*)(p.cat + (size_t)row * DM + 512 + hq * 64 + dt * 16 + lq * 4) = o;
    }
  }
  __syncthreads();
}

DI void gmlp_item(const Params& p, int layer, int ci, char* smem) {
  const int tid = opaque_tid(), lane = tid & 63, wave = tid >> 6;
  const int l15 = lane & 15, lq = lane >> 4;
  u16* vT = (u16*)smem;
  float* rowss = (float*)(smem + 256 * 136 * 2);
  const int grow0 = ci * 128;
  {
    const int pr = tid >> 2, qd = tid & 3;
    const u16* zr = p.z + (size_t)(grow0 + pr) * ZW + ZGV + qd * 64;
    float v[64];
#pragma unroll
    for (int i = 0; i < 8; ++i) {
      const uint4 raw = *(const uint4*)(zr + i * 8);
      float f[8];
      unpack8(raw, f);
#pragma unroll
      for (int e = 0; e < 8; e += 2) {
        const f32x2_t gq = gelu_pk(f32x2_t{f[e], f[e + 1]});
        v[i * 8 + e] = gq.x; v[i * 8 + e + 1] = gq.y;
      }
    }
    float sm = 0.f;
#pragma unroll
    for (int e = 0; e < 64; ++e) sm += v[e];
    sm += __shfl_xor(sm, 1); sm += __shfl_xor(sm, 2);
    const float mean = sm * (1.f / 256.f);
    float q = 0.f;
#pragma unroll
    for (int e = 0; e < 64; ++e) { v[e] -= mean; q += v[e] * v[e]; }
    q += __shfl_xor(q, 1); q += __shfl_xor(q, 2);
    const float rstd = rsqrtf(q * (1.f / 256.f) + 1e-5f);
    const float* lng = p.gmlp_ln_g + layer * 256 + qd * 64;
    const float* lnb = p.gmlp_ln_b + layer * 256 + qd * 64;
#pragma unroll
    for (int e = 0; e < 64; e += 4) {
      const float4 gg = *(const float4*)(lng + e), bb = *(const float4*)(lnb + e);
      u16* dst = vT + (qd * 64 + e) * 136 + pr;
      dst[0] = f2bf(v[e] * rstd * gg.x + bb.x);
      dst[136] = f2bf(v[e + 1] * rstd * gg.y + bb.y);
      dst[272] = f2bf(v[e + 2] * rstd * gg.z + bb.z);
      dst[408] = f2bf(v[e + 3] * rstd * gg.w + bb.w);
    }
  }
  __syncthreads();
  const int g = wave & 3, half = wave >> 2;
  const float* ws = p.gmlp_ws + (size_t)(layer * 4 + g) * 128 * 128;
  f32x4 acc[4][4];
#pragma unroll
  for (int ct = 0; ct < 4; ++ct)
#pragma unroll
    for (int rt = 0; rt < 4; ++rt) acc[ct][rt] = f32x4{0.f, 0.f, 0.f, 0.f};
#pragma unroll 1
  for (int ks = 0; ks < 4; ++ks) {
    bf16x8 vf[4];
#pragma unroll
    for (int ct = 0; ct < 4; ++ct) vf[ct] = *(const bf16x8*)(vT + (g * 64 + ct * 16 + l15) * 136 + ks * 32 + lq * 8);
#pragma unroll
    for (int rt = 0; rt < 4; ++rt) {
      const float* wr = ws + (size_t)(half * 64 + rt * 16 + l15) * 128 + ks * 32 + lq * 8;
      const float4 w0 = *(const float4*)wr, w1 = *(const float4*)(wr + 4);
      uint4 pk;
      pk.x = pack2(w0.x, w0.y); pk.y = pack2(w0.z, w0.w); pk.z = pack2(w1.x, w1.y); pk.w = pack2(w1.z, w1.w);
      const bf16x8 wf = __builtin_bit_cast(bf16x8, pk);
#pragma unroll
      for (int ct = 0; ct < 4; ++ct) acc[ct][rt] = MFMA16(vf[ct], wf, acc[ct][rt]);
    }
  }
  const float* bs = p.gmlp_bs + (size_t)(layer * 4 + g) * 128;
  const float* og = p.gmlp_out_g + layer * 256;
#pragma unroll
  for (int rt = 0; rt < 4; ++rt) {
    const int pr = half * 64 + rt * 16 + l15;
    const float bias = bs[pr];
    const u16* zr = p.z + (size_t)(grow0 + pr) * ZW + ZGU + g * 64 + lq * 4;
    float ss = 0.f;
#pragma unroll
    for (int ct = 0; ct < 4; ++ct) {
      const uint2 ur = *(const uint2*)(zr + ct * 16);
      const f32x2_t u01 = gelu_pk(f32x2_t{__uint_as_float(ur.x << 16), __uint_as_float(ur.x & 0xffff0000u)});
      const f32x2_t u23 = gelu_pk(f32x2_t{__uint_as_float(ur.y << 16), __uint_as_float(ur.y & 0xffff0000u)});
      f32x4 val = acc[ct][rt];
      val[0] = u01.x * (val[0] + bias); val[1] = u01.y * (val[1] + bias);
      val[2] = u23.x * (val[2] + bias); val[3] = u23.y * (val[3] + bias);
      acc[ct][rt] = val;
      ss += val[0] * val[0] + val[1] * val[1] + val[2] * val[2] + val[3] * val[3];
    }
    ss += __shfl_xor(ss, 16); ss += __shfl_xor(ss, 32);
    if (lq == 0) rowss[g * 128 + pr] = ss;
  }
  __syncthreads();
#pragma unroll
  for (int rt = 0; rt < 4; ++rt) {
    const int pr = half * 64 + rt * 16 + l15;
    const float tot = rowss[pr] + rowss[128 + pr] + rowss[256 + pr] + rowss[384 + pr];
    const float rstd = rsqrtf(tot * (1.f / 256.f) + 1e-6f);
#pragma unroll
    for (int ct = 0; ct < 4; ++ct) {
      const int c = g * 64 + ct * 16 + lq * 4;
      const float4 gg = *(const float4*)(og + c);
      uint2 o;
      o.x = pack2(acc[ct][rt][0] * rstd * gg.x, acc[ct][rt][1] * rstd * gg.y);
      o.y = pack2(acc[ct][rt][2] * rstd * gg.z, acc[ct][rt][3] * rstd * gg.w);
      *(uint2*)(p.cat + (size_t)(grow0 + pr) * DM + 256 + c) = o;
    }
  }
  __syncthreads();
}

DI int gla_row(int b, int c, int s) { return c < 4 ? (M_LAT + b * TC + c * 64 + s) : (b * TL + (c - 4) * 64 + s); }
DI int gla_slot(int c, int dir) { return dir == 0 ? c : (c < 4 ? 3 - c : 39 - c); }

DI void gla_cum2(const Params& p, int layer, int b, int h, int c, float* cum2, int tid) {
  const int lane = tid & 63, wave = tid >> 6;
  {
    const int s = tid >> 2, d0 = (tid & 3) * 8;
    const u16* zr = p.z + (size_t)gla_row(b, c, s) * ZW + h * 32 + d0;
    float zf[8], zb[8];
    unpack8(*(const uint4*)(zr + ZGF), zf);
    unpack8(*(const uint4*)(zr + ZGB), zb);
    const float* baf = p.gla_ba + (size_t)(layer * 2 + 0) * 128 + h * 32 + d0;
    const float* bab = p.gla_ba + (size_t)(layer * 2 + 1) * 128 + h * 32 + d0;
#pragma unroll
    for (int e = 0; e < 8; ++e) {
      cum2[s * 32 + d0 + e] = logsigmoid_f(zf[e] + baf[e]) * (1.f / 16.f);
      cum2[2048 + s * 32 + d0 + e] = logsigmoid_f(zb[e] + bab[e]) * (1.f / 16.f);
    }
  }
  __syncthreads();
  {
    float v[16];
#pragma unroll
    for (int i = 0; i < 16; ++i) {
      const int dir = i >> 3, d = wave * 8 + (i & 7);
      const int s = dir ? 63 - lane : lane;
      v[i] = cum2[dir * 2048 + s * 32 + d];
    }
#pragma unroll
    for (int i = 0; i < 16; ++i) v[i] = wave_incl_scan(v[i]);
#pragma unroll
    for (int i = 0; i < 16; ++i) {
      const int dir = i >> 3, d = wave * 8 + (i & 7);
      const int s = dir ? 63 - lane : lane;
      cum2[dir * 2048 + s * 32 + d] = v[i];
    }
  }
  __syncthreads();
}

DI void gla_stage_vt(const Params& p, int b, int h, int c, u16* Vt, int tid) {
#pragma unroll
  for (int i = 0; i < 2; ++i) {
    const int cc = tid + 256 * i, s = cc >> 3, ch = cc & 7;
    const uint4 vv = *(const uint4*)(p.z + (size_t)gla_row(b, c, s) * ZW + ZV + h * 64 + ch * 8);
    u16* vt = Vt + (ch * 8) * 72 + s;
    vt[0 * 72] = (u16)(vv.x & 0xffff); vt[1 * 72] = (u16)(vv.x >> 16);
    vt[2 * 72] = (u16)(vv.y & 0xffff); vt[3 * 72] = (u16)(vv.y >> 16);
    vt[4 * 72] = (u16)(vv.z & 0xffff); vt[5 * 72] = (u16)(vv.z >> 16);
    vt[6 * 72] = (u16)(vv.w & 0xffff); vt[7 * 72] = (u16)(vv.w >> 16);
  }
}

constexpr int GLA_SUB_BYTES = 56320;

DI void gla_a_item(const Params& p, int layer, int pi, char* smem) {
  const int tid0 = opaque_tid();
  const int tid = tid0 & 255, sub = tid0 >> 8;
  const int lane = tid & 63, wave = tid >> 6, l15 = lane & 15, lq = lane >> 4;
  const int item = 2 * pi + sub;
  char* base = smem + sub * GLA_SUB_BYTES;
  float* cum2 = (float*)base;
  u16* ktT = (u16*)(base + 16384);
  u16* Vt = (u16*)(base + 16384 + 9216);
  const int c = item % NSLOT, h = (item / NSLOT) & 3, b = item / (NSLOT * 4);
  const int s = tid >> 2, d0 = (tid & 3) * 8;
  const uint4 kraw = *(const uint4*)(p.z + (size_t)gla_row(b, c, s) * ZW + ZK + h * 32 + d0);
  gla_stage_vt(p, b, h, c, Vt, tid);
  gla_cum2(p, layer, b, h, c, cum2, tid);
  {
    float* cg = p.cumbuf + (size_t)item * 4096;
#pragma unroll
    for (int i = 0; i < 4; ++i) *(float4*)(cg + (i * 256 + tid) * 4) = *(const float4*)(cum2 + (i * 256 + tid) * 4);
  }
  const size_t sidx0 = ((size_t)((b * 4 + h) * 2 + 0) * NSLOT + gla_slot(c, 0));
  const size_t sidx1 = ((size_t)((b * 4 + h) * 2 + 1) * NSLOT + gla_slot(c, 1));
  {
    float kf[8];
    unpack8(kraw, kf);
#pragma unroll
    for (int e = 0; e < 8; ++e) {
      ktT[(d0 + e) * 72 + s] = f2bf(kf[e] * __expf(cum2[63 * 32 + d0 + e] - cum2[s * 32 + d0 + e]));
      ktT[2304 + (d0 + e) * 72 + s] = f2bf(kf[e] * __expf(cum2[2048 + d0 + e] - cum2[2048 + s * 32 + d0 + e]));
    }
    if (tid < 32) p.Dd[sidx0 * 32 + tid] = __expf(cum2[63 * 32 + tid]);
    else if (tid < 64) p.Dd[sidx1 * 32 + tid - 32] = __expf(cum2[2048 + tid - 32]);
  }
  __syncthreads();
#pragma unroll
  for (int dir = 0; dir < 2; ++dir) {
    float* Lp = p.L + (dir ? sidx1 : sidx0) * 2048;
#pragma unroll
    for (int dt = 0; dt < 2; ++dt) {
      f32x4 acc = f32x4{0.f, 0.f, 0.f, 0.f};
#pragma unroll
      for (int ks = 0; ks < 2; ++ks) {
        const bf16x8 a = *(const bf16x8*)(ktT + dir * 2304 + (dt * 16 + l15) * 72 + ks * 32 + lq * 8);
        const bf16x8 bb = *(const bf16x8*)(Vt + (wave * 16 + l15) * 72 + ks * 32 + lq * 8);
        acc = MFMA16(a, bb, acc);
      }
#pragma unroll
      for (int j = 0; j < 4; ++j) Lp[(dt * 16 + lq * 4 + j) * 64 + wave * 16 + l15] = acc[j];
    }
  }
  __syncthreads();
}

DI void phase_gla_b(const Params& p) {
  const int total = NB * 4 * 2 * 2048;
  for (int idx = blockIdx.x * NT + threadIdx.x; idx < total; idx += gridDim.x * NT) {
    const int chain = idx >> 11, de = idx & 2047, d = de >> 6;
    float* Lp = p.L + (size_t)chain * NSLOT * 2048 + de;
    const float* Dp = p.Dd + (size_t)chain * NSLOT * 32 + d;
    float loc[NSLOT], dec[NSLOT];
#pragma unroll
    for (int sl = 0; sl < NSLOT; ++sl) { loc[sl] = Lp[(size_t)sl * 2048]; dec[sl] = Dp[sl * 32]; }
    float S = 0.f;
#pragma unroll
    for (int sl = 0; sl < NSLOT; ++sl) {
      Lp[(size_t)sl * 2048] = S;
      S = dec[sl] * S + loc[sl];
    }
  }
}

DI void gla_c_item(const Params& p, int layer, int pi, char* smem) {
  const int tid0 = opaque_tid();
  const int tid = tid0 & 255, sub = tid0 >> 8;
  const int lane = tid & 63, wave = tid >> 6, l15 = lane & 15, lq = lane >> 4;
  const int item = 2 * pi + sub;
  char* base = smem + sub * GLA_SUB_BYTES;
  float* cum2 = (float*)base;
  u16* qt = (u16*)(base + 16384);
  u16* kh = (u16*)(base + 16384 + 10240);
  u16* St = (u16*)(base + 16384 + 20480);
  u16* Vt = (u16*)(base + 16384 + 30720);
  const int c = item % NSLOT, h = (item / NSLOT) & 3, b = item / (NSLOT * 4);
  const int s = tid >> 2, d0 = (tid & 3) * 8;
  const u16* zr = p.z + (size_t)gla_row(b, c, s) * ZW + h * 32 + d0;
  const uint4 qraw = *(const uint4*)(zr + ZQ), kraw = *(const uint4*)(zr + ZK);
  const int sd = tid >> 3, se0 = (tid & 7) * 8;
  const float* Lp0 = p.L + ((size_t)((b * 4 + h) * 2 + 0) * NSLOT + gla_slot(c, 0)) * 2048 + sd * 64 + se0;
  const float* Lp1 = p.L + ((size_t)((b * 4 + h) * 2 + 1) * NSLOT + gla_slot(c, 1)) * 2048 + sd * 64 + se0;
  const float4 sf0 = *(const float4*)Lp0, sf1 = *(const float4*)(Lp0 + 4), sb0 = *(const float4*)Lp1, sb1 = *(const float4*)(Lp1 + 4);
  const float* cg = p.cumbuf + (size_t)item * 4096 + s * 32 + d0;
  float cvv[2][8];
  *(float4*)&cvv[0][0] = *(const float4*)cg;          *(float4*)&cvv[0][4] = *(const float4*)(cg + 4);
  *(float4*)&cvv[1][0] = *(const float4*)(cg + 2048); *(float4*)&cvv[1][4] = *(const float4*)(cg + 2052);
  gla_stage_vt(p, b, h, c, Vt, tid);
  {
    float qf[8], kf[8];
    unpack8(qraw, qf);
    unpack8(kraw, kf);
#pragma unroll
    for (int dir = 0; dir < 2; ++dir) {
      float qo[8], ko[8];
#pragma unroll
      for (int e = 0; e < 8; ++e) {
        const float cv = cvv[dir][e];
        qo[e] = qf[e] * 0.17677669529663687f * __expf(cv);
        ko[e] = kf[e] * __expf(-cv);
      }
      *(uint4*)(qt + dir * 2560 + s * 40 + d0) = make_uint4(pack2(qo[0], qo[1]), pack2(qo[2], qo[3]), pack2(qo[4], qo[5]), pack2(qo[6], qo[7]));
      *(uint4*)(kh + dir * 2560 + s * 40 + d0) = make_uint4(pack2(ko[0], ko[1]), pack2(ko[2], ko[3]), pack2(ko[4], ko[5]), pack2(ko[6], ko[7]));
    }
    St[(se0 + 0) * 40 + sd] = f2bf(sf0.x); St[(se0 + 1) * 40 + sd] = f2bf(sf0.y); St[(se0 + 2) * 40 + sd] = f2bf(sf0.z); St[(se0 + 3) * 40 + sd] = f2bf(sf0.w);
    St[(se0 + 4) * 40 + sd] = f2bf(sf1.x); St[(se0 + 5) * 40 + sd] = f2bf(sf1.y); St[(se0 + 6) * 40 + sd] = f2bf(sf1.z); St[(se0 + 7) * 40 + sd] = f2bf(sf1.w);
    u16* St1 = St + 2560;
    St1[(se0 + 0) * 40 + sd] = f2bf(sb0.x); St1[(se0 + 1) * 40 + sd] = f2bf(sb0.y); St1[(se0 + 2) * 40 + sd] = f2bf(sb0.z); St1[(se0 + 3) * 40 + sd] = f2bf(sb0.w);
    St1[(se0 + 4) * 40 + sd] = f2bf(sb1.x); St1[(se0 + 5) * 40 + sd] = f2bf(sb1.y); St1[(se0 + 6) * 40 + sd] = f2bf(sb1.z); St1[(se0 + 7) * 40 + sd] = f2bf(sb1.w);
  }
  __syncthreads();
  f32x4 oT[4], aT[4];
#pragma unroll
  for (int i = 0; i < 4; ++i) { oT[i] = f32x4{0.f, 0.f, 0.f, 0.f}; aT[i] = f32x4{0.f, 0.f, 0.f, 0.f}; }
  const int tq = 16 * wave + l15;
#pragma unroll
  for (int dir = 0; dir < 2; ++dir) {
    const bf16x8 qb = *(const bf16x8*)(qt + dir * 2560 + tq * 40 + lq * 8);
#pragma unroll
    for (int st = 0; st < 4; ++st) {
      const bf16x8 ka = *(const bf16x8*)(kh + dir * 2560 + (st * 16 + l15) * 40 + lq * 8);
      f32x4 sv = f32x4{0.f, 0.f, 0.f, 0.f};
      sv = MFMA16(ka, qb, sv);
#pragma unroll
      for (int j = 0; j < 4; ++j) {
        const int si = st * 16 + lq * 4 + j;
        const bool valid = dir ? (si >= tq) : (si <= tq);
        aT[st][j] += valid ? sv[j] : 0.f;
      }
    }
#pragma unroll
    for (int et = 0; et < 4; ++et) {
      const bf16x8 sa = *(const bf16x8*)(St + dir * 2560 + (et * 16 + l15) * 40 + lq * 8);
      oT[et] = MFMA16(sa, qb, oT[et]);
    }
  }
#pragma unroll
  for (int kk = 0; kk < 2; ++kk) {
    const uint4 t4 = make_uint4(pack2(aT[2 * kk][0], aT[2 * kk][1]), pack2(aT[2 * kk][2], aT[2 * kk][3]),
                                pack2(aT[2 * kk + 1][0], aT[2 * kk + 1][1]), pack2(aT[2 * kk + 1][2], aT[2 * kk + 1][3]));
    const bf16x8 pb = __builtin_bit_cast(bf16x8, t4);
#pragma unroll
    for (int et = 0; et < 4; ++et) {
      const u16* vrow = Vt + (et * 16 + l15) * 72 + lq * 4 + (2 * kk) * 16;
      const uint2 lo = *(const uint2*)vrow;
      const uint2 hi = *(const uint2*)(vrow + 16);
      const bf16x8 va = __builtin_bit_cast(bf16x8, make_uint4(lo.x, lo.y, hi.x, hi.y));
      oT[et] = MFMA16(va, pb, oT[et]);
    }
  }
  float ss = 0.f;
#pragma unroll
  for (int et = 0; et < 4; ++et)
#pragma unroll
    for (int j = 0; j < 4; ++j) ss += oT[et][j] * oT[et][j];
  ss += __shfl_xor(ss, 16);
  ss += __shfl_xor(ss, 32);
  const float rstd = rsqrtf(ss * (1.f / 64.f) + 1e-6f);
  const int row = gla_row(b, c, tq);
#pragma unroll
  for (int et = 0; et < 4; ++et) {
    const int e0 = et * 16 + lq * 4;
    const uint2 ogv = *(const uint2*)(p.z + (size_t)row * ZW + ZOG + h * 64 + e0);
    const float og0 = __uint_as_float(ogv.x << 16), og1 = __uint_as_float(ogv.x & 0xffff0000u);
    const float og2 = __uint_as_float(ogv.y << 16), og3 = __uint_as_float(ogv.y & 0xffff0000u);
    const float4 gn = *(const float4*)(p.gla_norm + layer * 64 + e0);
    uint2 o;
    o.x = pack2(oT[et][0] * rstd * gn.x * silu_f(og0), oT[et][1] * rstd * gn.y * silu_f(og1));
    o.y = pack2(oT[et][2] * rstd * gn.z * silu_f(og2), oT[et][3] * rstd * gn.w * silu_f(og3));
    *(uint2*)(p.cat + (size_t)row * DM + h * 64 + e0) = o;
  }
  __syncthreads();
}

DI void swa_norm_rows(const Params& p, int layer, int Mrows) {
  const int tid = threadIdx.x, lane = tid & 63, wave = tid >> 6;
  const int sub = lane >> 4, l16 = lane & 15;
  const float* g = p.swa_out_g + layer * 512 + l16 * 32;
  for (int row = (blockIdx.x * 8 + wave) * 4 + sub; row < Mrows; row += gridDim.x * 32) {
    u16* cp = p.cat + (size_t)row * DM + 512 + l16 * 32;
    uint4 raw[4];
#pragma unroll
    for (int i = 0; i < 4; ++i) raw[i] = *(const uint4*)(cp + i * 8);
    float f[32];
    float ss = 0.f;
#pragma unroll
    for (int i = 0; i < 4; ++i) {
      unpack8(raw[i], f + i * 8);
#pragma unroll
      for (int e = 0; e < 8; ++e) ss += f[i * 8 + e] * f[i * 8 + e];
    }
    ss += __shfl_xor(ss, 1); ss += __shfl_xor(ss, 2); ss += __shfl_xor(ss, 4); ss += __shfl_xor(ss, 8);
    const float rstd = rsqrtf(ss * (1.f / 512.f) + 1e-6f);
#pragma unroll
    for (int i = 0; i < 4; ++i) {
      const float4 g0 = *(const float4*)(g + i * 8), g1 = *(const float4*)(g + i * 8 + 4);
      uint4 o;
      o.x = pack2(f[i * 8 + 0] * rstd * g0.x, f[i * 8 + 1] * rstd * g0.y); o.y = pack2(f[i * 8 + 2] * rstd * g0.z, f[i * 8 + 3] * rstd * g0.w);
      o.z = pack2(f[i * 8 + 4] * rstd * g1.x, f[i * 8 + 5] * rstd * g1.y); o.w = pack2(f[i * 8 + 6] * rstd * g1.z, f[i * 8 + 7] * rstd * g1.w);
      *(uint4*)(cp + i * 8) = o;
    }
  }
}

DI void phase_mix_a(const Params& p, int layer, char* smem) {
  const bool need_ctx = layer == 0;
  const int n_swa = 1024, n_swac = need_ctx ? 128 : 0, n_gm = need_ctx ? 288 : 256, n_gla = NB * 4 * NSLOT / 2;
  const int total = n_swa + n_swac + n_gm + n_gla;
  unsigned* ctr = p.bar + XB_QCTR(layer);
  volatile unsigned* nxt = (volatile unsigned*)(smem + SMEM_BYTES) + 3;
  int item = blockIdx.x;
  while (item < total) {
    unsigned got = 0;
    if (threadIdx.x == 0) got = __hip_atomic_fetch_add(ctr, 1u, __ATOMIC_RELAXED, __HIP_MEMORY_SCOPE_AGENT);
    int it = item;
    if (it < n_swa) swa_item(p, layer, it, false, smem);
    else if ((it -= n_swa) < n_swac) swa_item(p, layer, it, true, smem);
    else if ((it -= n_swac) < n_gm) gmlp_item(p, layer, it, smem);
    else gla_a_item(p, layer, it - n_gm, smem);
    if (threadIdx.x == 0) *nxt = got + gridDim.x;
    __syncthreads();
    item = (int)*nxt;
    __syncthreads();
  }
}

DI void phase_mix_c(const Params& p, int layer, char* smem) {
  const bool need_ctx = layer == 0;
  const int n_gla = NB * 4 * NSLOT / 2;
  for (int item = blockIdx.x; item < n_gla; item += gridDim.x) {
    const int c = (2 * item) % NSLOT;
    if (!need_ctx && c < 4) continue;
    gla_c_item(p, layer, item, smem);
  }
  swa_norm_rows(p, layer, need_ctx ? M_ALL : M_LAT);
}


#define XB_TMO      128
#define XB_XCNT(j)  (256  + 64 * (j))
#define XB_XSUB(j)  (1280 + 64 * (j))
#define XB_XGEN(j)  (2304 + 64 * (j))
#define XB_TOP      3328
#define XB_TOPGEN   3392
#define XB_SPIN_CAP (1u << 22)
#define LAS __attribute__((address_space(3)))
DI unsigned xb_ld(unsigned* p) { return __hip_atomic_load(p, __ATOMIC_RELAXED, __HIP_MEMORY_SCOPE_AGENT); }
DI unsigned xb_add(unsigned* p, unsigned v) { return __hip_atomic_fetch_add(p, v, __ATOMIC_RELAXED, __HIP_MEMORY_SCOPE_AGENT); }
DI unsigned xb_xcc_id() { return (unsigned)__builtin_amdgcn_s_getreg((3 << 11) | 20) & 0xFu; }
#define XB_SPIN(cond, bar) do { unsigned _sp = 0; while (cond) { __builtin_amdgcn_s_sleep(1); \
    if ((++_sp & 255u) == 0u) { if (xb_ld(&(bar)[XB_TMO])) break; if (_sp > XB_SPIN_CAP) { atomicAdd(&(bar)[XB_TMO], 1u); break; } } } } while (0)
struct XcdBarrier { unsigned* bar; unsigned x; volatile LAS unsigned* st; };
DI XcdBarrier xcd_barrier_post(unsigned* bar, volatile LAS unsigned* st) {
  XcdBarrier b; b.bar = bar; b.x = xb_xcc_id(); b.st = st;
  if (threadIdx.x == 0) (void)xb_add(&bar[XB_XCNT(b.x)], 1u);
  return b;
}
DI void xcd_barrier_complete(unsigned* bar, unsigned x, unsigned& nloc, unsigned& nx) {
  const unsigned G = gridDim.x * gridDim.y * gridDim.z;
  unsigned sum, cnt, mine, sp = 0u;
  for (;;) {
    sum = 0u; cnt = 0u; mine = 0u;
#pragma unroll
    for (unsigned j = 0; j < 16; ++j) { const unsigned c = xb_ld(&bar[XB_XCNT(j)]); sum += c; cnt += (c > 0u) ? 1u : 0u; mine = (j == x) ? c : mine; }
    if (sum == G) break;
    __builtin_amdgcn_s_sleep(1);
    if ((++sp & 255u) == 0u) { if (xb_ld(&bar[XB_TMO])) break; if (sp > XB_SPIN_CAP) { atomicAdd(&bar[XB_TMO], 1u); break; } }
  }
  nloc = mine > 0u ? mine : 1u; nx = cnt > 0u ? cnt : 1u;
}
DI void xcd_barrier(const XcdBarrier& b) {
  asm volatile("s_waitcnt vmcnt(0)" ::: "memory");
  __syncthreads();
  if (threadIdx.x == 0) {
    unsigned* bar = b.bar;
    __builtin_amdgcn_s_waitcnt(0);
    unsigned nloc = b.st[0], nx = b.st[1];
    if (nloc == 0u) { xcd_barrier_complete(bar, b.x, nloc, nx); b.st[0] = nloc; b.st[1] = nx; }
    const unsigned old = xb_add(&bar[XB_XSUB(b.x)], 1u);
    const unsigned gen = old / nloc;
    if (old + 1u == (gen + 1u) * nloc) {
      __builtin_amdgcn_fence(__ATOMIC_RELEASE, "agent");
      asm volatile("s_waitcnt vmcnt(0)" ::: "memory");
      const unsigned og = xb_add(&bar[XB_TOP], 1u);
      const unsigned tg = og / nx;
      if (og + 1u == (tg + 1u) * nx) xb_add(&bar[XB_TOPGEN], 1u);
      else XB_SPIN(xb_ld(&bar[XB_TOPGEN]) == tg, bar);
      __builtin_amdgcn_fence(__ATOMIC_ACQUIRE, "agent");
      xb_add(&bar[XB_XGEN(b.x)], 1u);
      asm volatile("s_waitcnt vmcnt(0)" ::: "memory");
    } else {
      XB_SPIN(xb_ld(&bar[XB_XGEN(b.x)]) == gen, bar);
      __builtin_amdgcn_fence(__ATOMIC_ACQUIRE, "agent");
      asm volatile("s_waitcnt vmcnt(0)" ::: "memory");
    }
  }
  __syncthreads();
}

constexpr int N_STEPS = 2 + 2 * 9;

DI void run_step(const Params& p, int step, char* smem) {
  if (step == 0) { phase_prep(p, smem, 0); return; }
  if (step == 1) { phase_rows(p, 0, M_ALL, 0, 0, 0, nullptr, true, 0, 0, p.n1_pre); return; }
  const int l = (step - 2) / 9, ph = (step - 2) % 9;
  const int Mo = l == 0 ? M_ALL : M_LAT;
  switch (ph) {
    case 0: if (l == 0) phase_gemm<2>(p.h, p.WinT + (size_t)l * ZW * DM, M_ALL, ZW, DM, p.z, ZW, smem, p.rope, p.vT);
            else phase_gemm<3>(p.h, p.WinT + (size_t)l * ZW * DM, M_ALL, ZW, DM, p.z, ZW, smem, p.rope, p.vT);
            break;
    case 1: phase_mix_a(p, l, smem); break;
    case 2: phase_gla_b(p); break;
    case 3: phase_mix_c(p, l, smem); break;
    case 4: phase_gemm<0>(p.cat, p.WoutT + (size_t)l * DM * DM, Mo, DM, DM, p.y, DM, smem); break;
    case 5: phase_rows(p, 1, Mo, l == 0 ? 1 : 2, l, 2, p.n1_post + l * DM, true, l, 3, p.n2_pre + l * DM); break;
    case 6: phase_gemm<1>(p.h, p.WguT + (size_t)l * 2 * DFF * DM, Mo, 2 * DFF, DM, p.act, DFF, smem); break;
    case 7: phase_gemm<0>(p.act, p.WdT + (size_t)l * DM * DFF, Mo, DM, DFF, p.y, DM, smem);
            if (l == 0) phase_prep(p, smem, 1);
            break;
    case 8: phase_rows(p, 1, Mo, l == 0 ? 2 : 3, l, 5, p.n2_post + l * DM, l == 0, l + 1, 0, p.n1_pre + (l + 1 < 2 ? l + 1 : 1) * DM); break;
  }
}

template <int S>
DI void run_one(const Params& p, int step_begin, int step_end, int use_cg, const XcdBarrier& xb, char* smem) {
  if (step_begin <= S && S < step_end) {
    run_step(p, S, smem);
    if (S + 1 < step_end) {
      if (use_cg) cg::this_grid().sync();
      else xcd_barrier(xb);
    }
  }
}

__global__ void __launch_bounds__(NT, 2) fwd_kernel(Params p_unused, int step_begin, int step_end, int use_cg) {
  __shared__ __attribute__((aligned(16))) char smem[SMEM_BYTES + 16];
  uint4& xb_words = *(uint4*)(smem + SMEM_BYTES);
  const Params& p = *(const Params*)__builtin_amdgcn_kernarg_segment_ptr();
  if (threadIdx.x == 0) xb_words = make_uint4(0u, 0u, 0u, 0u);
  __syncthreads();
  XcdBarrier xb = xcd_barrier_post(p.bar, (volatile LAS unsigned*)&xb_words);
  run_one<0>(p, step_begin, step_end, use_cg, xb, smem);  run_one<1>(p, step_begin, step_end, use_cg, xb, smem);
  run_one<2>(p, step_begin, step_end, use_cg, xb, smem);  run_one<3>(p, step_begin, step_end, use_cg, xb, smem);
  run_one<4>(p, step_begin, step_end, use_cg, xb, smem);  run_one<5>(p, step_begin, step_end, use_cg, xb, smem);
  run_one<6>(p, step_begin, step_end, use_cg, xb, smem);  run_one<7>(p, step_begin, step_end, use_cg, xb, smem);
  run_one<8>(p, step_begin, step_end, use_cg, xb, smem);  run_one<9>(p, step_begin, step_end, use_cg, xb, smem);
  run_one<10>(p, step_begin, step_end, use_cg, xb, smem); run_one<11>(p, step_begin, step_end, use_cg, xb, smem);
  run_one<12>(p, step_begin, step_end, use_cg, xb, smem); run_one<13>(p, step_begin, step_end, use_cg, xb, smem);
  run_one<14>(p, step_begin, step_end, use_cg, xb, smem); run_one<15>(p, step_begin, step_end, use_cg, xb, smem);
  run_one<16>(p, step_begin, step_end, use_cg, xb, smem); run_one<17>(p, step_begin, step_end, use_cg, xb, smem);
  run_one<18>(p, step_begin, step_end, use_cg, xb, smem); run_one<19>(p, step_begin, step_end, use_cg, xb, smem);
}

extern "C" void kernel_launch(void* const* d_in, const int* in_sizes, int n_in, void* d_out, int out_size, void* d_ws,
                              size_t ws_size, hipStream_t stream) {
  static int grid_blocks = 0;
  if (!grid_blocks) {
    int dev = 0, cus = 0, per_cu = 0;
    hipGetDevice(&dev);
    hipDeviceGetAttribute(&cus, hipDeviceAttributeMultiprocessorCount, dev);
    hipOccupancyMaxActiveBlocksPerMultiprocessor(&per_cu, fwd_kernel, NT, 0);
    if (per_cu < 1) per_cu = 1;
    if (per_cu > 1) per_cu = 1;
    grid_blocks = cus * per_cu;
  }
  Params p{};
  const float** fp = (const float**)&p;
  for (int i = 0; i < 24; ++i) fp[i] = (const float*)d_in[i];
  p.out = (float*)d_out;
  char* w = (char*)d_ws;
  size_t off = 0;
  auto take = [&](size_t bytes) { char* r = w + off; off += (bytes + 255) & ~(size_t)255; return r; };
  p.WinT = (u16*)take((size_t)2 * ZW * DM * 2);
  p.WoutT = (u16*)take((size_t)2 * DM * DM * 2);
  p.WguT = (u16*)take((size_t)2 * 2 * DFF * DM * 2);
  p.WdT = (u16*)take((size_t)2 * DM * DFF * 2);
  p.mod = (float*)take((size_t)2 * 17 * 6144 * 4);
  p.rope = (float*)take((size_t)TL * 32 * 2 * 4);
  p.h = (u16*)take((size_t)M_ALL * DM * 2);
  p.z = (u16*)take((size_t)M_ALL * ZW * 2);
  p.cat = (u16*)take((size_t)M_ALL * DM * 2);
  p.act = p.z;
  p.y = p.h;
  p.xr = (u16*)take((size_t)M_LAT * DM * 2);
  p.xc = (u16*)take((size_t)M_CTX * DM * 2);
  p.L = (float*)take((size_t)NB * 4 * 2 * NSLOT * 2048 * 4);
  p.Dd = (float*)take((size_t)NB * 4 * 2 * NSLOT * 32 * 4);
  p.bar = (unsigned*)take((size_t)XCD_BAR_WORDS * 4);
  p.vT = (u16*)take((size_t)288 * 2 * 64 * 128 * 2);
  p.cumbuf = (float*)p.h;
  if (off > ws_size) { fprintf(stderr, "workspace too small: need %zu have %zu\n", off, ws_size); return; }
#if MK_ONE_LAUNCH
  int sb = 0, se = N_STEPS, use_cg = 0;
  void* args[] = {&p, &sb, &se, &use_cg};
  (void)hipMemsetAsync(p.bar, 0, (size_t)XCD_BAR_WORDS * 4, stream);
  hipError_t e = hipLaunchCooperativeKernel((void*)fwd_kernel, dim3(grid_blocks), dim3(NT), args, 0, stream);
  if (e != hipSuccess) fprintf(stderr, "cooperative launch failed: %s (grid %d)\n", hipGetErrorString(e), grid_blocks);
#else
  for (int s = 0; s < N_STEPS; ++s) fwd_kernel<<<grid_blocks, NT, 0, stream>>>(p, s, s + 1, 0);
#endif
}
```

```cpp
#include <hip/hip_runtime.h>
#include <hip/hip_cooperative_groups.h>
#include <cstdio>
namespace cg = cooperative_groups;

#ifndef MK_ONE_LAUNCH
#define MK_ONE_LAUNCH 1
#endif

#define DI __device__ __forceinline__
typedef unsigned short u16;
using bf16x8 = __attribute__((ext_vector_type(8))) short;
using f32x4 = __attribute__((ext_vector_type(4))) float;
#define MFMA16(a, b, c) __builtin_amdgcn_mfma_f32_16x16x32_bf16((a), (b), (c), 0, 0, 0)

constexpr int NT = 512;
constexpr int ST = 256;
constexpr int DM = 1024;
constexpr int NB = 16;
constexpr int TL = 2048;
constexpr int TC = 256;
constexpr int M_LAT = NB * TL;
constexpr int M_CTX = NB * TC;
constexpr int M_ALL = M_LAT + M_CTX;
constexpr int ZW = 2304;
constexpr int IN_COLS = 2080;
constexpr int DFF = 2816;
constexpr int ZQ = 0, ZK = 128, ZV = 256, ZOG = 512, ZGU = 768, ZGV = 1024, ZSQ = 1280, ZSK = 1792, ZSV = 1920, ZGF = 2048, ZGB = 2176;
constexpr int NSLOT = 36;
constexpr int SMEM_BYTES = 147456;
#define XB_QCTR(j)  (3456 + 64 * (j))
#define XCD_BAR_WORDS (3456 + 64 * 4)

struct Params {
  const float *x, *c, *ctx, *c_ctx, *mod_w, *mod_b, *n1_pre, *n1_post, *n2_pre, *n2_post, *w_in, *w_out,
      *gla_wa2, *gla_ba, *gla_norm, *gmlp_ln_g, *gmlp_ln_b, *gmlp_ws, *gmlp_bs, *gmlp_out_g, *swa_sink, *swa_out_g,
      *ffn_w_gu, *ffn_w_down;
  float* out;
  u16 *WinT, *WoutT, *WguT, *WdT;
  float *mod, *rope, *cumbuf;
  u16 *h, *z, *cat, *y, *act;
  u16 *xc, *xr; float *L, *Dd;
  unsigned* bar;
  u16* vT;
};

DI u16 f2bf(float f) { const __bf16 hv = (__bf16)f; return __builtin_bit_cast(u16, hv); }
DI float bf2f(u16 h) { return __uint_as_float(((unsigned)h) << 16); }
typedef __bf16 bf16x2_t __attribute__((ext_vector_type(2)));
typedef float f32x2_t __attribute__((ext_vector_type(2)));
DI unsigned pack2(float a, float b) { f32x2_t v = {a, b}; bf16x2_t r = __builtin_convertvector(v, bf16x2_t); return __builtin_bit_cast(unsigned, r); }
DI f32x2_t gelu_pk(f32x2_t v) {
  const f32x2_t av = __builtin_elementwise_abs(v), d = av * 0.2316418882f + 1.0f;
  f32x2_t t; t.x = __builtin_amdgcn_rcpf(d.x); t.y = __builtin_amdgcn_rcpf(d.y);
  f32x2_t q = t * 0.5307027145f + (-0.7265760135f); q = q * t + 0.7107068705f; q = q * t + (-0.142248368f); q = q * t + 0.127414796f; q = q * t;
  const f32x2_t s = (v * v) * (-0.72134752044f);
  f32x2_t e; e.x = __builtin_amdgcn_exp2f(s.x); e.y = __builtin_amdgcn_exp2f(s.y);
  const f32x2_t m = v * (q * e), r = v - m;
  f32x2_t o; o.x = v.x < 0.f ? m.x : r.x; o.y = v.y < 0.f ? m.y : r.y; return o;
}
DI int opaque_tid() { int t = threadIdx.x; asm volatile("" : "+v"(t)); return t; }
template <int CTRL, int ROWMASK>
DI float dpp_acc(float v) { const int t = __builtin_amdgcn_update_dpp(0, __float_as_int(v), CTRL, ROWMASK, 0xf, false); return v + __int_as_float(t); }
DI float wave_incl_scan(float v) {
  v = dpp_acc<0x111, 0xf>(v); v = dpp_acc<0x112, 0xf>(v); v = dpp_acc<0x114, 0xf>(v); v = dpp_acc<0x118, 0xf>(v);
  v = dpp_acc<0x142, 0xa>(v); v = dpp_acc<0x143, 0xc>(v);
  return v;
}
DI float wave_sum(float v) { return __int_as_float(__builtin_amdgcn_readlane(__float_as_int(wave_incl_scan(v)), 63)); }
DI float silu_f(float x) { return x * __builtin_amdgcn_rcpf(1.f + __expf(-x)); }
DI float gelu_f(float x) { return 0.5f * x * (1.f + erff(x * 0.70710678118654752f)); }
DI float logsigmoid_f(float z) { return fminf(z, 0.f) - __logf(1.f + __expf(-fabsf(z))); }
DI void unpack8(const uint4& v, float* f) {
  f[0] = __uint_as_float(v.x << 16); f[1] = __uint_as_float(v.x & 0xffff0000u);
  f[2] = __uint_as_float(v.y << 16); f[3] = __uint_as_float(v.y & 0xffff0000u);
  f[4] = __uint_as_float(v.z << 16); f[5] = __uint_as_float(v.z & 0xffff0000u);
  f[6] = __uint_as_float(v.w << 16); f[7] = __uint_as_float(v.w & 0xffff0000u);
}

DI int colmap_win(int n) { return n < 768 ? n : n + 32; }
DI int colmap_gu(int n) { int pn = n >> 8, w = n & 255; return pn * 128 + (w & 127) + ((w & 128) ? DFF : 0); }

template <int CM>
DI void transpose_tile(const float* __restrict__ src, int ld_src, int k0, int n0, u16* __restrict__ dst, int K, float* tile) {
  const int tid = threadIdx.x & 255;
  {
    const int j = tid & 63, i0 = tid >> 6;
    const int n = n0 + j;
    const int col = CM == 1 ? colmap_win(n) : (CM == 2 ? colmap_gu(n) : n);
#pragma unroll
    for (int ii = 0; ii < 16; ++ii) {
      const int k = i0 + 4 * ii;
      tile[k * 65 + j] = src[(size_t)(k0 + k) * ld_src + col];
    }
  }
  __syncthreads();
  {
    const int kk = tid & 63, nn0 = tid >> 6;
#pragma unroll
    for (int ii = 0; ii < 16; ++ii) {
      const int n = nn0 + 4 * ii;
      dst[(size_t)(n0 + n) * K + k0 + kk] = f2bf(tile[kk * 65 + n]);
    }
  }
  __syncthreads();
}

DI void phase_prep(const Params& p, char* smem, int part) {
  const int sub = threadIdx.x >> 8;
  float* sf = (float*)smem + sub * 4352;
  float* stab = (float*)smem + 2 * 4352;
  const int tid = threadIdx.x & 255, lane = tid & 63, wave = tid >> 6;
  constexpr int N_TR_L = 512 + 256 + 1408 + 704;
  constexpr int N_TR = 2 * N_TR_L;
  constexpr int N_FOLD = 64, N_MOD = 192, N_ROPE = 256;
  constexpr int N_ALL = N_TR + N_FOLD + N_MOD + N_ROPE;
  constexpr int P_TRF = (N_TR_L + 32) / 2;
  const int nitems = part == 0 ? (N_MOD + P_TRF + N_ROPE / 2) : P_TRF;
  const int skip = (part == 1 && gridDim.x > 128) ? 64 : 0;
  const int bid = (int)blockIdx.x - skip;
  const int nb = (int)gridDim.x - skip;
  if (bid < 0) return;
  unsigned* qctr = p.bar + XB_QCTR(2);
  volatile unsigned* qnxt = (volatile unsigned*)(smem + SMEM_BYTES) + 3;
  for (int pi = bid; pi < nitems; ) {
    unsigned got = 0;
    if (part == 0 && threadIdx.x == 0) got = __hip_atomic_fetch_add(qctr, 1u, __ATOMIC_RELAXED, __HIP_MEMORY_SCOPE_AGENT);
    const int pi_cur = pi;
    int item;
    if (part == 0) {
      if (pi < N_MOD) item = N_TR + N_FOLD + pi;
      else if (pi < N_MOD + P_TRF) { const int q = 2 * (pi - N_MOD) + sub; item = q < N_TR_L ? q : N_TR + (q - N_TR_L); }
      else item = N_TR + N_FOLD + N_MOD + 2 * (pi - N_MOD - P_TRF) + sub;
    } else {
      const int q = 2 * pi + sub;
      item = q < N_TR_L ? N_TR_L + q : N_TR + 32 + (q - N_TR_L);
    }
    if (item < N_TR) {
      const int l = item / N_TR_L;
      int r = item - l * N_TR_L;
      if (r < 512) {
        transpose_tile<1>(p.w_in + (size_t)l * DM * IN_COLS, IN_COLS, (r >> 5) * 64, (r & 31) * 64, p.WinT + (size_t)l * ZW * DM, DM, sf);
      } else if (r < 768) {
        r -= 512;
        transpose_tile<0>(p.w_out + (size_t)l * DM * DM, DM, (r >> 4) * 64, (r & 15) * 64, p.WoutT + (size_t)l * DM * DM, DM, sf);
      } else if (r < 2176) {
        r -= 768;
        transpose_tile<2>(p.ffn_w_gu + (size_t)l * DM * 2 * DFF, 2 * DFF, (r / 88) * 64, (r % 88) * 64, p.WguT + (size_t)l * 2 * DFF * DM, DM, sf);
      } else {
        r -= 2176;
        transpose_tile<0>(p.ffn_w_down + (size_t)l * DFF * DM, DM, (r >> 4) * 64, (r & 15) * 64, p.WdT + (size_t)l * DM * DFF, DFF, sf);
      }
    } else if (item < N_TR + N_FOLD) {
      const int idx = item - N_TR;
      const int l = idx >> 5, dir = (idx >> 4) & 1, k0 = (idx & 15) * 64;
      float* wa = sf;
      float* cd = sf + 2048;
      const float* wa2 = p.gla_wa2 + (size_t)(l * 2 + dir) * 16 * 128;
      for (int i = tid; i < 2048; i += ST) wa[i] = wa2[i];
      for (int i = tid; i < 1024; i += ST) {
        const int kk = i >> 4, r = i & 15;
        cd[kk * 17 + r] = p.w_in[(size_t)l * DM * IN_COLS + (size_t)(k0 + kk) * IN_COLS + 768 + dir * 16 + r];
      }
      __syncthreads();
      const int kk = tid & 63, jg = tid >> 6;
      u16* dst = p.WinT + (size_t)l * ZW * DM;
      for (int jj = 0; jj < 32; ++jj) {
        const int j = jg * 32 + jj;
        float s = 0.f;
#pragma unroll
        for (int r = 0; r < 16; ++r) s += cd[kk * 17 + r] * wa[r * 128 + j];
        dst[(size_t)(ZGF + dir * 128 + j) * DM + k0 + kk] = f2bf(s);
      }
      __syncthreads();
    } else if (item < N_TR + N_FOLD + N_MOD) {
      const int cgi = item - N_TR - N_FOLD;
      const int gc = cgi * 64 + lane;
      const int l = gc / 6144, n = gc - l * 6144;
      for (int i = threadIdx.x; i < 17 * 1024; i += NT) {
        const float v = i < 16 * 1024 ? p.c[i] : p.c_ctx[i - 16 * 1024];
        stab[i] = silu_f(v);
      }
      __syncthreads();
      float acc[17];
#pragma unroll
      for (int r = 0; r < 17; ++r) acc[r] = 0.f;
      const float* W = p.mod_w + (size_t)l * DM * 6144 + n;
      const int kb = (threadIdx.x >> 6) * 128;
#pragma unroll 4
      for (int k = kb; k < kb + 128; ++k) {
        const float wv = W[(size_t)k * 6144];
#pragma unroll
        for (int r = 0; r < 17; ++r) acc[r] += stab[r * 1024 + k] * wv;
      }
      __syncthreads();
#pragma unroll
      for (int r = 0; r < 17; ++r) sf[(wave * 17 + r) * 64 + lane] = acc[r];
      __syncthreads();
      for (int o = threadIdx.x; o < 17 * 64; o += NT) {
        const int r = o >> 6, ln = o & 63;
        const float* s0 = (const float*)smem;
        float s = 0.f;
#pragma unroll
        for (int w8 = 0; w8 < 8; ++w8) s += s0[(w8 >> 2) * 4352 + ((w8 & 3) * 17 + r) * 64 + ln];
        const int nn = cgi * 64 + ln - l * 6144;
        p.mod[(size_t)(l * 17 + r) * 6144 + nn] = s + p.mod_b[l * 6144 + nn];
      }
      __syncthreads();
    } else {
      const int idx = item - N_TR - N_FOLD - N_MOD;
      const int e = idx * 256 + tid;
      const int t = e >> 5, f = e & 31;
      const int fi = f & 15;
      const float inv = powf(10000.f, -(float)(2 * fi) / 32.f);
      const float pos = f < 16 ? (float)(t >> 6) : (float)(t & 63);
      const float ang = pos * inv;
      p.rope[e * 2 + 0] = cosf(ang);
      p.rope[e * 2 + 1] = sinf(ang);
    }
    if (part == 0) {
      if (threadIdx.x == 0) *qnxt = got + (unsigned)nb;
      __syncthreads();
      pi = (int)*qnxt;
      __syncthreads();
    } else pi = pi_cur + nb;
  }
}

DI void rows_chunk(const Params& p, int mode, int row0, int nrows, int mrow, const void* xin, bool xin_bf, void* xout, bool xout_bf,
                   int l_in, int gate_idx, const float* gpost, bool write_h, int l_out, int sh_idx, const float* gpre, int lane) {
  float4 G[4], A[4], Sh[4];
#pragma unroll
  for (int i = 0; i < 4; ++i) {
    const int c0 = lane * 4 + 256 * i;
    if (mode == 1) {
      const float4 g = *(const float4*)(gpost + c0);
      const float4 gt = *(const float4*)(p.mod + (size_t)(l_in * 17 + mrow) * 6144 + gate_idx * 1024 + c0);
      G[i] = make_float4(g.x * gt.x, g.y * gt.y, g.z * gt.z, g.w * gt.w);
    }
    if (write_h) {
      const float* sh = p.mod + (size_t)(l_out * 17 + mrow) * 6144 + sh_idx * 1024 + c0;
      const float4 g = *(const float4*)(gpre + c0);
      const float4 s = *(const float4*)(sh + 1024);
      Sh[i] = *(const float4*)sh;
      A[i] = make_float4(g.x * (1.f + s.x), g.y * (1.f + s.y), g.z * (1.f + s.z), g.w * (1.f + s.w));
    }
  }
  float4 xn[4]; uint2 xb[4]; uint2 yn[4];
#define ROWS_LOAD(R) do { \
    const u16* yr_ = p.y + (size_t)(row0 + (R)) * DM + lane * 4; \
    _Pragma("unroll") for (int i = 0; i < 4; ++i) { \
      if (xin_bf) xb[i] = *(const uint2*)((const u16*)xin + (size_t)(R) * DM + lane * 4 + 256 * i); \
      else xn[i] = *(const float4*)((const float*)xin + (size_t)(R) * DM + lane * 4 + 256 * i); \
      if (mode == 1) yn[i] = *(const uint2*)(yr_ + 256 * i); } } while (0)
  ROWS_LOAD(0);
  for (int r = 0; r < nrows; ++r) {
    float4 xv[4]; uint2 yu[4];
#pragma unroll
    for (int i = 0; i < 4; ++i) {
      if (xin_bf) {
        xv[i].x = __uint_as_float(xb[i].x << 16); xv[i].y = __uint_as_float(xb[i].x & 0xffff0000u);
        xv[i].z = __uint_as_float(xb[i].y << 16); xv[i].w = __uint_as_float(xb[i].y & 0xffff0000u);
      } else xv[i] = xn[i];
      yu[i] = yn[i];
    }
    if (r + 1 < nrows) ROWS_LOAD(r + 1);
    if (mode == 1) {
      float4 yv[4];
      float ss = 0.f;
#pragma unroll
      for (int i = 0; i < 4; ++i) {
        yv[i].x = __uint_as_float(yu[i].x << 16); yv[i].y = __uint_as_float(yu[i].x & 0xffff0000u);
        yv[i].z = __uint_as_float(yu[i].y << 16); yv[i].w = __uint_as_float(yu[i].y & 0xffff0000u);
        ss += yv[i].x * yv[i].x + yv[i].y * yv[i].y + yv[i].z * yv[i].z + yv[i].w * yv[i].w;
      }
      ss = wave_sum(ss);
      const float rstd = rsqrtf(ss * (1.f / DM) + 1e-6f);
#pragma unroll
      for (int i = 0; i < 4; ++i) {
        xv[i].x += G[i].x * (yv[i].x * rstd);
        xv[i].y += G[i].y * (yv[i].y * rstd);
        xv[i].z += G[i].z * (yv[i].z * rstd);
        xv[i].w += G[i].w * (yv[i].w * rstd);
        if (xout_bf) {
          uint2 o; o.x = pack2(xv[i].x, xv[i].y); o.y = pack2(xv[i].z, xv[i].w);
          *(uint2*)((u16*)xout + (size_t)r * DM + lane * 4 + 256 * i) = o;
          xv[i].x = __uint_as_float(o.x << 16); xv[i].y = __uint_as_float(o.x & 0xffff0000u);
          xv[i].z = __uint_as_float(o.y << 16); xv[i].w = __uint_as_float(o.y & 0xffff0000u);
        } else {
          *(float4*)((float*)xout + (size_t)r * DM + lane * 4 + 256 * i) = xv[i];
        }
      }
    }
    if (write_h) {
      float ss = 0.f;
#pragma unroll
      for (int i = 0; i < 4; ++i) ss += xv[i].x * xv[i].x + xv[i].y * xv[i].y + xv[i].z * xv[i].z + xv[i].w * xv[i].w;
      ss = wave_sum(ss);
      const float rstd = rsqrtf(ss * (1.f / DM) + 1e-6f);
      u16* hr = p.h + (size_t)(row0 + r) * DM + lane * 4;
#pragma unroll
      for (int i = 0; i < 4; ++i) {
        uint2 o;
        o.x = pack2(xv[i].x * rstd * A[i].x + Sh[i].x, xv[i].y * rstd * A[i].y + Sh[i].y);
        o.y = pack2(xv[i].z * rstd * A[i].z + Sh[i].z, xv[i].w * rstd * A[i].w + Sh[i].w);
        *(uint2*)(hr + 256 * i) = o;
      }
    }
  }
#undef ROWS_LOAD
}

DI void phase_rows(const Params& p, int mode, int Mrows, int stage, int l_in, int gate_idx, const float* gpost,
                   bool write_h, int l_out, int sh_idx, const float* gpre) {
  const int tid = threadIdx.x, lane = tid & 63, wave = tid >> 6;
  const int nw = gridDim.x * 8;
  const bool xin_bf = stage >= 2, xout_bf = stage != 3;
  for (int ch = blockIdx.x * 8 + wave; ch < M_LAT / 16; ch += nw) {
    const int row0 = ch * 16;
    const void* xin = xin_bf ? (const void*)(p.xr + (size_t)row0 * DM) : (const void*)(p.x + (size_t)row0 * DM);
    void* xout = xout_bf ? (void*)(p.xr + (size_t)row0 * DM) : (void*)(p.out + (size_t)row0 * DM);
    rows_chunk(p, mode, row0, 16, row0 >> 11, xin, xin_bf, xout, xout_bf, l_in, gate_idx, gpost, write_h, l_out, sh_idx, gpre, lane);
  }
  if (Mrows > M_LAT) {
    for (int ch = blockIdx.x * 8 + wave; ch < M_CTX / 2; ch += nw) {
      const int rc = ch * 2;
      const void* xin = xin_bf ? (const void*)(p.xc + (size_t)rc * DM) : (const void*)(p.ctx + (size_t)rc * DM);
      rows_chunk(p, mode, M_LAT + rc, 2, 16, xin, xin_bf, (void*)(p.xc + (size_t)rc * DM), true, l_in, gate_idx, gpost, write_h, l_out, sh_idx, gpre, lane);
    }
  }
}

namespace pg8 {
#define PG8_LAS __attribute__((address_space(3)))
typedef unsigned short bf16_t;
typedef short bf16x8 __attribute__((ext_vector_type(8)));
typedef float f32x4 __attribute__((ext_vector_type(4)));
typedef unsigned u32x4 __attribute__((ext_vector_type(4)));
constexpr int BM = 256, BK = 64, HALF = 128, HTB = HALF * BK * 2  , STAGE_BYTES = 8 * HTB, NXCD = 8, WGM = 4;

__host__ __device__ __forceinline__ int lds_byte(int r, int c) { const int st = (r >> 4) * 2 + (c >> 5), rr = r & 15, cc = c & 31, ob = rr * 64 + cc * 2; return st * 1024 + (ob ^ (((ob >> 9) & 1) << 5)); }
__host__ __device__ __forceinline__ void stage_rc(int b, int& R, int& C) { const int st = b / 1024, sb = b % 1024, swz = sb ^ (((sb >> 9) & 1) << 5); R = (st >> 1) * 16 + swz / 64; C = (st & 1) * 32 + (swz % 64) / 2; }
__host__ __device__ __forceinline__ int perm32(int rho) { const int n = rho >> 4, i = rho & 15; return 8 * (i >> 2) + 4 * n + (i & 3); }

struct Unit { int pm, pn; };
struct Gemm { const bf16_t* A; const bf16_t* Bt; int M, N, K; };

struct StaticOrder {
    int nM, nN, nwg, G, c, wgm = WGM;
    __host__ __device__ void init(int M, int N, int G_, int c_) { nM = M / BM; nN = N / BM; nwg = nM * nN; G = G_; c = c_; }
    __host__ __device__ bool next(int i, Unit& u) const {
        const long L = (long)i * G + c; if (L >= nwg) return false;
        int wgid = (int)L; { const int q = nwg / NXCD, r = nwg % NXCD, xcd = wgid % NXCD, off = wgid / NXCD; wgid = (xcd < r ? xcd * (q + 1) : r * (q + 1) + (xcd - r) * q) + off; }
        const int nig = wgm * nN, gid = wgid / nig, fm = gid * wgm, gsz = (nM - fm) < wgm ? (nM - fm) : wgm;
        u.pm = fm + ((wgid % nig) % gsz); u.pn = (wgid % nig) / gsz; return true;
    }
    __device__ __forceinline__ void a_ready(const Unit&) const {}
    __device__ __forceinline__ void done(const Unit&) const {}
};
__device__ __forceinline__ unsigned cvt_pk_bf16(float lo, float hi) { return pack2(lo, hi); }

struct InProjLastOrder : StaticOrder {
    __host__ __device__ void init2(int G_, int c_) { init(32768, 2304, G_, c_); }
    __host__ __device__ bool next(int i, Unit& u) const {
        const long L = (long)i * G + c;
        if (L < nwg) return StaticOrder::next(i, u);
        const int j = (int)(L - nwg); if (j >= 64) return false;
        const int k = j & 3; u.pm = 128 + (j >> 2); u.pn = k < 2 ? k : k + 5; return true;
    }
};
struct EpiStoreBf16 {
    static constexpr bool PERM = true, AFTER_DRAIN = false;
    bf16_t* O; int ldc;
    __device__ __forceinline__ void operator()(const f32x4 (&acc)[2][2][4][2], const Unit& u, int wr, int wc, int fr, int fq) const {
        const int row0 = u.pm * BM + wr * 64 + fr, col0 = u.pn * BM + wc * 32 + 8 * fq;
#pragma unroll
        for (int ai = 0; ai < 2; ++ai)
#pragma unroll
            for (int m = 0; m < 4; ++m) { bf16_t* rowp = O + (size_t)(row0 + ai * HALF + m * 16) * ldc + col0;
#pragma unroll
                for (int bj = 0; bj < 2; ++bj) { const f32x4 v0 = acc[ai][bj][m][0], v1 = acc[ai][bj][m][1];
                    u32x4 w; w.x = cvt_pk_bf16(v0[0], v0[1]); w.y = cvt_pk_bf16(v0[2], v0[3]); w.z = cvt_pk_bf16(v1[0], v1[1]); w.w = cvt_pk_bf16(v1[2], v1[3]);
                    *(u32x4*)(rowp + bj * HALF) = w; } }
    }
};
struct EpiInProj {
    static constexpr bool PERM = true, AFTER_DRAIN = false;
    bf16_t* O; int ldc; const float* rope; bf16_t* vT;
    static __device__ __forceinline__ void rot(f32x4& v0, f32x4& v1, const f32x4 (&c)[4], float sg) {
        const float q0 = __shfl_xor(v0[0], 32), q1 = __shfl_xor(v0[1], 32), q2 = __shfl_xor(v0[2], 32), q3 = __shfl_xor(v0[3], 32);
        const float r0 = __shfl_xor(v1[0], 32), r1 = __shfl_xor(v1[1], 32), r2 = __shfl_xor(v1[2], 32), r3 = __shfl_xor(v1[3], 32);
        v0[0] = v0[0] * c[0][0] + sg * q0 * c[0][1]; v0[1] = v0[1] * c[0][2] + sg * q1 * c[0][3];
        v0[2] = v0[2] * c[1][0] + sg * q2 * c[1][1]; v0[3] = v0[3] * c[1][2] + sg * q3 * c[1][3];
        v1[0] = v1[0] * c[2][0] + sg * r0 * c[2][1]; v1[1] = v1[1] * c[2][2] + sg * r1 * c[2][3];
        v1[2] = v1[2] * c[3][0] + sg * r2 * c[3][1]; v1[3] = v1[3] * c[3][2] + sg * r3 * c[3][3];
    }
    __device__ __forceinline__ void emit(f32x4 v0, f32x4 v1, const Unit& u, int row, int col0, int bj, int wc, int fq, bool lat, bool dorot, const f32x4 (&c)[4], float sg) const {
        constexpr float QS = 0.125f * 1.4426950408889634f;
        if (u.pn == 7 && bj == 1) {
            const int blk = lat ? (row >> 7) : (256 + ((row - 32768) >> 7));
            const int d0 = wc * 32 + 8 * fq;
            bf16_t* vp = vT + ((size_t)(blk * 2 + (d0 >> 6)) * 64 + (d0 & 63)) * 128 + (row & 127);
#pragma unroll
            for (int j = 0; j < 4; ++j) { vp[j * 128] = f2bf(v0[j]); vp[(4 + j) * 128] = f2bf(v1[j]); }
            return;
        }
        if (dorot) rot(v0, v1, c, sg);
        if (u.pn < 7) { v0 *= QS; v1 *= QS; }
        u32x4 w; w.x = cvt_pk_bf16(v0[0], v0[1]); w.y = cvt_pk_bf16(v0[2], v0[3]); w.z = cvt_pk_bf16(v1[0], v1[1]); w.w = cvt_pk_bf16(v1[2], v1[3]);
        *(u32x4*)(O + (size_t)row * ldc + col0 + bj * HALF) = w;
    }
    __device__ __forceinline__ void operator()(const f32x4 (&acc)[2][2][4][2], const Unit& u, int wr, int wc, int fr, int fq) const {
        const int row0 = u.pm * BM + wr * 64 + fr, col0 = u.pn * BM + wc * 32 + 8 * fq;
        const bool swa = (u.pn >= 5) && (u.pn <= 7);
        if (!swa) {
#pragma unroll
            for (int ai = 0; ai < 2; ++ai)
#pragma unroll
                for (int m = 0; m < 4; ++m) { bf16_t* rowp = O + (size_t)(row0 + ai * HALF + m * 16) * ldc + col0;
#pragma unroll
                    for (int bj = 0; bj < 2; ++bj) { const f32x4 v0 = acc[ai][bj][m][0], v1 = acc[ai][bj][m][1];
                        u32x4 w; w.x = cvt_pk_bf16(v0[0], v0[1]); w.y = cvt_pk_bf16(v0[2], v0[3]); w.z = cvt_pk_bf16(v1[0], v1[1]); w.w = cvt_pk_bf16(v1[2], v1[3]);
                        *(u32x4*)(rowp + bj * HALF) = w; } }
            return;
        }
        const bool lat = u.pm < 128;
        const float sg = (fq < 2) ? -1.f : 1.f;
        if (wc & 1) {
#pragma unroll
            for (int m = 0; m < 4; ++m) {
                f32x4 c[4];
                if (lat) { const float* rp = rope + ((size_t)(16 * m + fr) * 32 + 16 + 8 * (fq & 1)) * 2;
#pragma unroll
                    for (int k = 0; k < 4; ++k) c[k] = *(const f32x4*)(rp + 4 * k); }
#pragma unroll
                for (int ai = 0; ai < 2; ++ai)
#pragma unroll
                    for (int bj = 0; bj < 2; ++bj) emit(acc[ai][bj][m][0], acc[ai][bj][m][1], u, row0 + ai * HALF + m * 16, col0, bj, wc, fq, lat, lat, c, sg);
                __builtin_amdgcn_sched_barrier(0);
            }
        } else {
#pragma unroll
            for (int ai = 0; ai < 2; ++ai) {
                f32x4 c[4];
                if (lat) { const float* rp = rope + ((size_t)((row0 + ai * HALF) & 2047) * 32 + 8 * (fq & 1)) * 2;
#pragma unroll
                    for (int k = 0; k < 4; ++k) c[k] = *(const f32x4*)(rp + 4 * k); }
#pragma unroll
                for (int m = 0; m < 4; ++m)
#pragma unroll
                    for (int bj = 0; bj < 2; ++bj) emit(acc[ai][bj][m][0], acc[ai][bj][m][1], u, row0 + ai * HALF + m * 16, col0, bj, wc, fq, lat, lat, c, sg);
                __builtin_amdgcn_sched_barrier(0);
            }
        }
    }
};
struct EpiSwiglu {
    static constexpr bool PERM = true, AFTER_DRAIN = false;
    bf16_t* O; int ldc;
    __device__ __forceinline__ void operator()(const f32x4 (&acc)[2][2][4][2], const Unit& u, int wr, int wc, int fr, int fq) const {
        const int row0 = u.pm * BM + wr * 64 + fr, col0 = u.pn * HALF + wc * 32 + 8 * fq;
#pragma unroll
        for (int ai = 0; ai < 2; ++ai)
#pragma unroll
            for (int m = 0; m < 4; ++m) { bf16_t* rowp = O + (size_t)(row0 + ai * HALF + m * 16) * ldc + col0;
                float r[8];
#pragma unroll
                for (int n = 0; n < 2; ++n)
#pragma unroll
                    for (int j = 0; j < 4; ++j) { const float g = acc[ai][0][m][n][j], up = acc[ai][1][m][n][j]; r[n * 4 + j] = g * up * __builtin_amdgcn_rcpf(1.f + __builtin_amdgcn_exp2f(g * -1.4426950408889634f)); }
                u32x4 w; w.x = cvt_pk_bf16(r[0], r[1]); w.y = cvt_pk_bf16(r[2], r[3]); w.z = cvt_pk_bf16(r[4], r[5]); w.w = cvt_pk_bf16(r[6], r[7]);
                *(u32x4*)rowp = w; }
    }
};

template <class Epi, class Sched, bool STAMP = false>
__device__ __forceinline__ void gemm_phase(PG8_LAS unsigned char* lds, const Gemm g, const Sched& S, const Epi& E, unsigned long long* stamps) {
    const int tid = threadIdx.x, wid = __builtin_amdgcn_readfirstlane(tid >> 6), lane = tid & 63, wr = wid >> 2, wc = wid & 3, fr = lane & 15, fq = lane >> 4;
    const int K = g.K, nt = K / BK;
    int ts_lo = 0, ts_hi = 0, nts = 0; const unsigned long long rt_entry = STAMP ? (unsigned long long)wall_clock64() : 0ull;
#define PG8_STAMP() do { if (STAMP && wid == 0 && nts < 64) { const unsigned long long _c = (unsigned long long)clock64(); \
        ts_lo = (lane == nts) ? (int)(unsigned)_c : ts_lo; ts_hi = (lane == nts) ? (int)(unsigned)(_c >> 32) : ts_hi; ++nts; } } while (0)
    PG8_STAMP();
    unsigned voffA[2], voffB[2];
#pragma unroll
    for (int i = 0; i < 2; ++i) { int R, C; stage_rc(tid * 16 + i * 8192, R, C); const int Rb = Epi::PERM ? ((R & ~31) + perm32(R & 31)) : R;
        voffA[i] = (unsigned)(R * K + C) * 2u; voffB[i] = (unsigned)(Rb * K + C) * 2u; }
    const size_t kstep = (size_t)(BK * 2);
    const size_t hstep = (size_t)HALF * K * 2;
    const size_t tstep = 2 * hstep;
    const unsigned ldsw = (unsigned)wid * 1024u;
    const int aoff = lds_byte(wr * 64 + fr, fq * 8), boff = lds_byte(wc * 32 + fr, fq * 8);
#define PG8_SA(b, h) (((b) * 2 + (h)) * HTB)
#define PG8_SB(b, h) ((4 + (b) * 2 + (h)) * HTB)
#define PG8_STAGE(bufoff, gbase, voff) do { _Pragma("unroll") for (int _i = 0; _i < 2; ++_i) \
        __builtin_amdgcn_global_load_lds((const unsigned*)((const char*)(gbase) + (voff)[_i]), (PG8_LAS unsigned*)(lds + (bufoff) + ldsw + _i * 8192), 16, 0, 0); } while (0)
#define PG8_LDA(dst, b, h) do { _Pragma("unroll") for (int m = 0; m < 4; ++m) _Pragma("unroll") for (int k = 0; k < 2; ++k) dst[m][k] = *(const PG8_LAS bf16x8*)(lds + PG8_SA(b, h) + aoff + m * 2048 + k * 1024); } while (0)
#define PG8_LDB(dst, b, h) do { _Pragma("unroll") for (int n = 0; n < 2; ++n) _Pragma("unroll") for (int k = 0; k < 2; ++k) dst[n][k] = *(const PG8_LAS bf16x8*)(lds + PG8_SB(b, h) + boff + n * 2048 + k * 1024); } while (0)
#define PG8_MMA(ai, bj, At, Bt) do { __builtin_amdgcn_s_setprio(1); _Pragma("unroll") for (int m = 0; m < 4; ++m) _Pragma("unroll") for (int n = 0; n < 2; ++n) _Pragma("unroll") for (int k = 0; k < 2; ++k) \
        acc[ai][bj][m][n] = __builtin_amdgcn_mfma_f32_16x16x32_bf16(Bt[n][k], At[m][k], acc[ai][bj][m][n], 0, 0, 0); __builtin_amdgcn_s_setprio(0); } while (0)
#define PG8_WAIT_V(n) asm volatile("s_waitcnt vmcnt(" #n ")" ::: "memory")
#define PG8_WAIT_L(n) asm volatile("s_waitcnt lgkmcnt(" #n ")" ::: "memory")
#define PG8_BAR __builtin_amdgcn_s_barrier()
#define PG8_SCHED __builtin_amdgcn_sched_barrier(0)
    Unit cur, nxt; int ui = 0;
    if (!S.next(0, cur)) return;
    f32x4 acc[2][2][4][2];
#pragma unroll
    for (int a = 0; a < 2; ++a)
#pragma unroll
        for (int b = 0; b < 2; ++b)
#pragma unroll
            for (int m = 0; m < 4; ++m)
#pragma unroll
                for (int n = 0; n < 2; ++n) acc[a][b][m][n] = (f32x4){0.f, 0.f, 0.f, 0.f};
    bf16x8 At[4][2], B0[2][2], B1[2][2];
    const char* cA = (const char*)g.A + (size_t)cur.pm * tstep; const char* cB = (const char*)g.Bt + (size_t)cur.pn * tstep;
    S.a_ready(cur);
    PG8_STAGE(PG8_SB(0, 0), cB, voffB); PG8_STAGE(PG8_SA(0, 0), cA, voffA); PG8_STAGE(PG8_SB(0, 1), cB + hstep, voffB); PG8_STAGE(PG8_SA(0, 1), cA + hstep, voffA);
    if (wr == 1) PG8_BAR;
    PG8_WAIT_V(4); PG8_BAR;
    PG8_STAGE(PG8_SB(1, 0), cB + kstep, voffB); PG8_STAGE(PG8_SA(1, 0), cA + kstep, voffA); PG8_STAGE(PG8_SB(1, 1), cB + hstep + kstep, voffB);
    PG8_WAIT_V(6); PG8_BAR;
    PG8_STAMP();
    for (;;) {
        const bool has_next = S.next(ui + 1, nxt);
        const char* nA = has_next ? (const char*)g.A + (size_t)nxt.pm * tstep : cA; const char* nB = has_next ? (const char*)g.Bt + (size_t)nxt.pn * tstep : cB;
        for (int t = 0; t < nt; t += 2) {
            const bool last = (t == nt - 2);
            const char* a1 = cA + (size_t)(t + 1) * kstep;
            const char* a2 = last ? nA : cA + (size_t)(t + 2) * kstep; const char* b2 = last ? nB : cB + (size_t)(t + 2) * kstep;
            const char* a3 = a2 + kstep; const char* b3 = b2 + kstep;
            if (last && has_next) S.a_ready(nxt);
            PG8_LDB(B0, 0, 0); PG8_SCHED; PG8_LDA(At, 0, 0); PG8_STAGE(PG8_SA(1, 1), a1 + hstep, voffA);
            PG8_WAIT_L(8); PG8_BAR; PG8_WAIT_L(0); PG8_MMA(0, 0, At, B0); PG8_BAR; PG8_SCHED;
            PG8_LDB(B1, 0, 1); PG8_STAGE(PG8_SB(0, 0), b2, voffB);
            PG8_BAR; PG8_WAIT_L(0); PG8_MMA(0, 1, At, B1); PG8_BAR;
            PG8_LDA(At, 0, 1); PG8_STAGE(PG8_SA(0, 0), a2, voffA);
            PG8_BAR; PG8_WAIT_L(0); PG8_MMA(1, 0, At, B0); PG8_BAR; PG8_SCHED;
            PG8_STAGE(PG8_SB(0, 1), b2 + hstep, voffB);
            PG8_WAIT_V(6); PG8_BAR; PG8_MMA(1, 1, At, B1); PG8_BAR;
            PG8_LDB(B0, 1, 0); PG8_SCHED; PG8_LDA(At, 1, 0); PG8_STAGE(PG8_SA(0, 1), a2 + hstep, voffA);
            PG8_WAIT_L(8); PG8_BAR; PG8_WAIT_L(0); PG8_MMA(0, 0, At, B0); PG8_BAR; PG8_SCHED;
            PG8_LDB(B1, 1, 1); PG8_STAGE(PG8_SB(1, 0), b3, voffB);
            PG8_BAR; PG8_WAIT_L(0); PG8_MMA(0, 1, At, B1); PG8_BAR;
            PG8_LDA(At, 1, 1); PG8_STAGE(PG8_SA(1, 0), a3, voffA);
            PG8_BAR; PG8_WAIT_L(0); PG8_MMA(1, 0, At, B0); PG8_BAR; PG8_SCHED;
            PG8_STAGE(PG8_SB(1, 1), b3 + hstep, voffB);
            PG8_WAIT_V(6); PG8_BAR; PG8_MMA(1, 1, At, B1); PG8_BAR;
        }
        PG8_STAMP();
        if constexpr (!Epi::AFTER_DRAIN) { E(acc, cur, wr, wc, fr, fq); S.done(cur); }
        PG8_STAMP();
        if (!has_next) break;
#pragma unroll
        for (int a = 0; a < 2; ++a)
#pragma unroll
            for (int b = 0; b < 2; ++b)
#pragma unroll
                for (int m = 0; m < 4; ++m)
#pragma unroll
                    for (int n = 0; n < 2; ++n) acc[a][b][m][n] = (f32x4){0.f, 0.f, 0.f, 0.f};
        cur = nxt; cA = nA; cB = nB; ++ui;
    }
    PG8_WAIT_V(0);
    if (wr == 0) PG8_BAR;
    PG8_BAR;
    if constexpr (Epi::AFTER_DRAIN) { E.fused(acc, cur, wr, wc, fr, fq, lds, wid, lane); S.done(cur); }
    PG8_STAMP();
    if (STAMP && wid == 0) { stamps[lane] = lane < nts ? (((unsigned long long)(unsigned)ts_hi << 32) | (unsigned)ts_lo) : 0ull;
        if (lane == 62) stamps[62] = rt_entry; if (lane == 63) stamps[63] = (unsigned long long)wall_clock64(); }
#undef PG8_STAMP
#undef PG8_SA
#undef PG8_SB
#undef PG8_STAGE
#undef PG8_LDA
#undef PG8_LDB
#undef PG8_MMA
#undef PG8_WAIT_V
#undef PG8_WAIT_L
#undef PG8_BAR
#undef PG8_SCHED
}
}

template <int EPI>
DI void phase_gemm(const u16* A, const u16* Bt, int M, int N, int K, u16* C, int ldc, char* smem, const float* rope = nullptr, u16* vT = nullptr) {
  pg8::Gemm g; g.A = A; g.Bt = Bt; g.M = M; g.N = N; g.K = K;
  pg8::StaticOrder S; S.init(M, N, (int)gridDim.x, (int)blockIdx.x);
  if (EPI == 2) S.wgm = 8;
  if (EPI == 3) { pg8::InProjLastOrder S2; S2.init2((int)gridDim.x, (int)blockIdx.x); S2.wgm = 8;
    pg8::EpiInProj E; E.O = C; E.ldc = ldc; E.rope = rope; E.vT = vT; pg8::gemm_phase<pg8::EpiInProj, pg8::InProjLastOrder, false>((PG8_LAS unsigned char*)smem, g, S2, E, nullptr); }
  else if (EPI == 2) { pg8::EpiInProj E; E.O = C; E.ldc = ldc; E.rope = rope; E.vT = vT; pg8::gemm_phase<pg8::EpiInProj, pg8::StaticOrder, false>((PG8_LAS unsigned char*)smem, g, S, E, nullptr); }
  else if (EPI == 0) { pg8::EpiStoreBf16 E; E.O = C; E.ldc = ldc; pg8::gemm_phase<pg8::EpiStoreBf16, pg8::StaticOrder, false>((PG8_LAS unsigned char*)smem, g, S, E, nullptr); }
  else { pg8::EpiSwiglu E; E.O = C; E.ldc = ldc; pg8::gemm_phase<pg8::EpiSwiglu, pg8::StaticOrder, false>((PG8_LAS unsigned char*)smem, g, S, E, nullptr); }
  __syncthreads();
}

DI void swa_item(const Params& p, int layer, int pi, bool ctxq, char* smem) {
  const int tid = opaque_tid(), lane = tid & 63, wave = tid >> 6, w4 = wave & 3;
  const int w4u = __builtin_amdgcn_readfirstlane(w4);
  const int l15 = lane & 15, lq = lane >> 4;
  const int hq = (pi & 3) * 2 + (wave >> 2);
  const int g = hq >> 2;
  int b, n;
  if (!ctxq) { n = (pi >> 2) & 15; b = pi >> 6; } else { n = (pi >> 2) & 1; b = pi >> 3; }
  const int qrow0 = (ctxq ? (M_LAT + b * TC + n * 128) : (b * TL + n * 128)) + w4 * 32;
  const int ctxrow0 = M_LAT + b * TC;
  bf16x8 Q[2][2];
#pragma unroll
  for (int rt = 0; rt < 2; ++rt)
#pragma unroll
    for (int ks = 0; ks < 2; ++ks)
      Q[rt][ks] = *(const bf16x8*)(p.z + (size_t)(qrow0 + rt * 16 + l15) * ZW + ZSQ + hq * 64 + ks * 32 + lq * 8);
  const float sink = p.swa_sink[layer * 8 + hq] * 1.4426950408889634f;
  float mrun[2], lrun[2];
  f32x4 O[4][2];
#pragma unroll
  for (int rt = 0; rt < 2; ++rt) {
    mrun[rt] = sink; lrun[rt] = (lq == 0) ? 1.f : 0.f;
#pragma unroll
    for (int dt = 0; dt < 4; ++dt) O[dt][rt] = f32x4{0.f, 0.f, 0.f, 0.f};
  }
  uint4 kreg0, kreg1, vreg0, vreg1;
#define SWA_LOAD_TILE(KT) do { \
    int krow0_, blk_; \
    if ((KT) < 3) { const int nk_ = n + (KT) - 1; krow0_ = b * TL + nk_ * 128; blk_ = b * 16 + nk_; } \
    else { krow0_ = ctxrow0 + ((KT) - 3) * 128; blk_ = 256 + b * 2 + ((KT) - 3); } \
    const u16* kb_ = p.z + (size_t)krow0_ * ZW + ZSK + g * 64; \
    const u16* vb_ = p.vT + (size_t)(blk_ * 2 + g) * 64 * 128; \
    kreg0 = *(const uint4*)(kb_ + (size_t)(tid >> 3) * ZW + (tid & 7) * 8); \
    kreg1 = *(const uint4*)(kb_ + (size_t)((tid + 512) >> 3) * ZW + (tid & 7) * 8); \
    vreg0 = *(const uint4*)(vb_ + (tid >> 4) * 128 + (tid & 15) * 8); \
    vreg1 = *(const uint4*)(vb_ + ((tid + 512) >> 4) * 128 + (tid & 15) * 8); \
  } while (0)
  int kt = ctxq ? 3 : (n == 0 ? 1 : 0);
  SWA_LOAD_TILE(kt);
  int buf = 0;
  while (kt < 5) {
    u16* Ks = (u16*)smem + buf * (128 * 72 + 64 * 136);
    u16* Vt = Ks + 128 * 72;
    *(uint4*)(Ks + (tid >> 3) * 72 + (tid & 7) * 8) = kreg0;
    *(uint4*)(Ks + ((tid + 512) >> 3) * 72 + (tid & 7) * 8) = kreg1;
    *(uint4*)(Vt + (tid >> 4) * 136 + (tid & 15) * 8) = vreg0;
    *(uint4*)(Vt + ((tid + 512) >> 4) * 136 + (tid & 15) * 8) = vreg1;
    __syncthreads();
    const int ktn = (kt == 1 && n == 15 && !ctxq) ? 3 : kt + 1;
    if (ktn < 5) SWA_LOAD_TILE(ktn);
#pragma unroll 1
    for (int hf = 0; hf < 2; ++hf) {
      f32x4 S[4][2];
#pragma unroll
      for (int c4 = 0; c4 < 4; ++c4) {
        const u16* kr = Ks + ((hf * 4 + c4) * 16 + l15) * 72 + lq * 8;
        const bf16x8 k0 = *(const bf16x8*)kr;
        const bf16x8 k1 = *(const bf16x8*)(kr + 32);
#pragma unroll
        for (int rt = 0; rt < 2; ++rt) {
          f32x4 s = f32x4{0.f, 0.f, 0.f, 0.f};
          s = MFMA16(k0, Q[rt][0], s);
          s = MFMA16(k1, Q[rt][1], s);
          S[c4][rt] = s;
        }
      }
      if (kt == 0 || kt == 2) {
        const bool prev = kt == 0;
#pragma unroll
        for (int rt = 0; rt < 2; ++rt) {
          const int dq = 2 * w4u + rt;
#pragma unroll
          for (int c4 = 0; c4 < 4; ++c4) {
            const int ct = hf * 4 + c4;
            if (prev ? (ct < dq) : (ct > dq)) {
              S[c4][rt] = f32x4{-1e30f, -1e30f, -1e30f, -1e30f};
            } else if (ct == dq) {
#pragma unroll
              for (int j = 0; j < 4; ++j) {
                const bool valid = prev ? (lq * 4 + j >= l15) : (lq * 4 + j <= l15);
                if (!valid) S[c4][rt][j] = -1e30f;
              }
            }
          }
        }
      }
      unsigned Pk[4][2][2];
#pragma unroll
      for (int rt = 0; rt < 2; ++rt) {
        float mx = S[0][rt][0];
#pragma unroll
        for (int c4 = 0; c4 < 4; ++c4)
#pragma unroll
          for (int j = 0; j < 4; ++j) mx = fmaxf(mx, S[c4][rt][j]);
        mx = fmaxf(mx, __shfl_xor(mx, 16));
        mx = fmaxf(mx, __shfl_xor(mx, 32));
        if (__builtin_amdgcn_ballot_w64(mx - mrun[rt] > 6.f) != 0ull) {
          const float mnew = fmaxf(mrun[rt], mx);
          const float alpha = __builtin_amdgcn_exp2f(mrun[rt] - mnew);
          mrun[rt] = mnew;
          lrun[rt] *= alpha;
#pragma unroll
          for (int dt = 0; dt < 4; ++dt) O[dt][rt] *= alpha;
        }
        const float mref = mrun[rt];
        float rs = 0.f;
#pragma unroll
        for (int c4 = 0; c4 < 4; ++c4) {
          float pv[4];
#pragma unroll
          for (int j = 0; j < 4; ++j) { pv[j] = __builtin_amdgcn_exp2f(S[c4][rt][j] - mref); rs += pv[j]; }
          Pk[c4][rt][0] = pack2(pv[0], pv[1]);
          Pk[c4][rt][1] = pack2(pv[2], pv[3]);
        }
        lrun[rt] += rs;
      }
#pragma unroll
      for (int kk = 0; kk < 2; ++kk) {
        bf16x8 pb[2];
#pragma unroll
        for (int rt = 0; rt < 2; ++rt) {
          uint4 t4 = make_uint4(Pk[2 * kk][rt][0], Pk[2 * kk][rt][1], Pk[2 * kk + 1][rt][0], Pk[2 * kk + 1][rt][1]);
          pb[rt] = __builtin_bit_cast(bf16x8, t4);
        }
#pragma unroll
        for (int dt = 0; dt < 4; ++dt) {
          const u16* vrow = Vt + (dt * 16 + l15) * 136 + lq * 4 + (hf * 4 + 2 * kk) * 16;
          const uint2 lo = *(const uint2*)(vrow);
          const uint2 hi = *(const uint2*)(vrow + 16);
          const bf16x8 va = __builtin_bit_cast(bf16x8, make_uint4(lo.x, lo.y, hi.x, hi.y));
#pragma unroll
          for (int rt = 0; rt < 2; ++rt) O[dt][rt] = MFMA16(va, pb[rt], O[dt][rt]);
        }
      }
    }
    kt = ktn; buf ^= 1;
  }
#pragma unroll
  for (int rt = 0; rt < 2; ++rt) {
    float l = lrun[rt];
    l += __shfl_xor(l, 16);
    l += __shfl_xor(l, 32);
    const float inv = 1.f / l;
    const int row = qrow0 + rt * 16 + l15;
#pragma unroll
    for (int dt = 0; dt < 4; ++dt) {
      uint2 o;
      o.x = pack2(O[dt][rt][0] * inv, O[dt][rt][1] * inv);
      o.y = pack2(O[dt][rt][2] * inv, O[dt][rt][3] * inv);
      *(uint2*)(p.cat + (size_t)row * DM + 512 + hq * 64 + dt * 16 + lq * 4) = o;
    }
  }
  __syncthreads();
}

DI void gmlp_item(const Params& p, int layer, int ci, char* smem) {
  const int tid = opaque_tid(), lane = tid & 63, wave = tid >> 6;
  const int l15 = lane & 15, lq = lane >> 4;
  u16* vT = (u16*)smem;
  float* rowss = (float*)(smem + 256 * 136 * 2);
  const int grow0 = ci * 128;
  {
    const int pr = tid >> 2, qd = tid & 3;
    const u16* zr = p.z + (size_t)(grow0 + pr) * ZW + ZGV + qd * 64;
    float v[64];
#pragma unroll
    for (int i = 0; i < 8; ++i) {
      const uint4 raw = *(const uint4*)(zr + i * 8);
      float f[8];
      unpack8(raw, f);
#pragma unroll
      for (int e = 0; e < 8; e += 2) {
        const f32x2_t gq = gelu_pk(f32x2_t{f[e], f[e + 1]});
        v[i * 8 + e] = gq.x; v[i * 8 + e + 1] = gq.y;
      }
    }
    float sm = 0.f;
#pragma unroll
    for (int e = 0; e < 64; ++e) sm += v[e];
    sm += __shfl_xor(sm, 1); sm += __shfl_xor(sm, 2);
    const float mean = sm * (1.f / 256.f);
    float q = 0.f;
#pragma unroll
    for (int e = 0; e < 64; ++e) { v[e] -= mean; q += v[e] * v[e]; }
    q += __shfl_xor(q, 1); q += __shfl_xor(q, 2);
    const float rstd = rsqrtf(q * (1.f / 256.f) + 1e-5f);
    const float* lng = p.gmlp_ln_g + layer * 256 + qd * 64;
    const float* lnb = p.gmlp_ln_b + layer * 256 + qd * 64;
#pragma unroll
    for (int e = 0; e < 64; e += 4) {
      const float4 gg = *(const float4*)(lng + e), bb = *(const float4*)(lnb + e);
      u16* dst = vT + (qd * 64 + e) * 136 + pr;
      dst[0] = f2bf(v[e] * rstd * gg.x + bb.x);
      dst[136] = f2bf(v[e + 1] * rstd * gg.y + bb.y);
      dst[272] = f2bf(v[e + 2] * rstd * gg.z + bb.z);
      dst[408] = f2bf(v[e + 3] * rstd * gg.w + bb.w);
    }
  }
  __syncthreads();
  const int g = wave & 3, half = wave >> 2;
  const float* ws = p.gmlp_ws + (size_t)(layer * 4 + g) * 128 * 128;
  f32x4 acc[4][4];
#pragma unroll
  for (int ct = 0; ct < 4; ++ct)
#pragma unroll
    for (int rt = 0; rt < 4; ++rt) acc[ct][rt] = f32x4{0.f, 0.f, 0.f, 0.f};
#pragma unroll 1
  for (int ks = 0; ks < 4; ++ks) {
    bf16x8 vf[4];
#pragma unroll
    for (int ct = 0; ct < 4; ++ct) vf[ct] = *(const bf16x8*)(vT + (g * 64 + ct * 16 + l15) * 136 + ks * 32 + lq * 8);
#pragma unroll
    for (int rt = 0; rt < 4; ++rt) {
      const float* wr = ws + (size_t)(half * 64 + rt * 16 + l15) * 128 + ks * 32 + lq * 8;
      const float4 w0 = *(const float4*)wr, w1 = *(const float4*)(wr + 4);
      uint4 pk;
      pk.x = pack2(w0.x, w0.y); pk.y = pack2(w0.z, w0.w); pk.z = pack2(w1.x, w1.y); pk.w = pack2(w1.z, w1.w);
      const bf16x8 wf = __builtin_bit_cast(bf16x8, pk);
#pragma unroll
      for (int ct = 0; ct < 4; ++ct) acc[ct][rt] = MFMA16(vf[ct], wf, acc[ct][rt]);
    }
  }
  const float* bs = p.gmlp_bs + (size_t)(layer * 4 + g) * 128;
  const float* og = p.gmlp_out_g + layer * 256;
#pragma unroll
  for (int rt = 0; rt < 4; ++rt) {
    const int pr = half * 64 + rt * 16 + l15;
    const float bias = bs[pr];
    const u16* zr = p.z + (size_t)(grow0 + pr) * ZW + ZGU + g * 64 + lq * 4;
    float ss = 0.f;
#pragma unroll
    for (int ct = 0; ct < 4; ++ct) {
      const uint2 ur = *(const uint2*)(zr + ct * 16);
      const f32x2_t u01 = gelu_pk(f32x2_t{__uint_as_float(ur.x << 16), __uint_as_float(ur.x & 0xffff0000u)});
      const f32x2_t u23 = gelu_pk(f32x2_t{__uint_as_float(ur.y << 16), __uint_as_float(ur.y & 0xffff0000u)});
      f32x4 val = acc[ct][rt];
      val[0] = u01.x * (val[0] + bias); val[1] = u01.y * (val[1] + bias);
      val[2] = u23.x * (val[2] + bias); val[3] = u23.y * (val[3] + bias);
      acc[ct][rt] = val;
      ss += val[0] * val[0] + val[1] * val[1] + val[2] * val[2] + val[3] * val[3];
    }
    ss += __shfl_xor(ss, 16); ss += __shfl_xor(ss, 32);
    if (lq == 0) rowss[g * 128 + pr] = ss;
  }
  __syncthreads();
#pragma unroll
  for (int rt = 0; rt < 4; ++rt) {
    const int pr = half * 64 + rt * 16 + l15;
    const float tot = rowss[pr] + rowss[128 + pr] + rowss[256 + pr] + rowss[384 + pr];
    const float rstd = rsqrtf(tot * (1.f / 256.f) + 1e-6f);
#pragma unroll
    for (int ct = 0; ct < 4; ++ct) {
      const int c = g * 64 + ct * 16 + lq * 4;
      const float4 gg = *(const float4*)(og + c);
      uint2 o;
      o.x = pack2(acc[ct][rt][0] * rstd * gg.x, acc[ct][rt][1] * rstd * gg.y);
      o.y = pack2(acc[ct][rt][2] * rstd * gg.z, acc[ct][rt][3] * rstd * gg.w);
      *(uint2*)(p.cat + (size_t)(grow0 + pr) * DM + 256 + c) = o;
    }
  }
  __syncthreads();
}

DI int gla_row(int b, int c, int s) { return c < 4 ? (M_LAT + b * TC + c * 64 + s) : (b * TL + (c - 4) * 64 + s); }
DI int gla_slot(int c, int dir) { return dir == 0 ? c : (c < 4 ? 3 - c : 39 - c); }

DI void gla_cum2(const Params& p, int layer, int b, int h, int c, float* cum2, int tid) {
  const int lane = tid & 63, wave = tid >> 6;
  {
    const int s = tid >> 2, d0 = (tid & 3) * 8;
    const u16* zr = p.z + (size_t)gla_row(b, c, s) * ZW + h * 32 + d0;
    float zf[8], zb[8];
    unpack8(*(const uint4*)(zr + ZGF), zf);
    unpack8(*(const uint4*)(zr + ZGB), zb);
    const float* baf = p.gla_ba + (size_t)(layer * 2 + 0) * 128 + h * 32 + d0;
    const float* bab = p.gla_ba + (size_t)(layer * 2 + 1) * 128 + h * 32 + d0;
#pragma unroll
    for (int e = 0; e < 8; ++e) {
      cum2[s * 32 + d0 + e] = logsigmoid_f(zf[e] + baf[e]) * (1.f / 16.f);
      cum2[2048 + s * 32 + d0 + e] = logsigmoid_f(zb[e] + bab[e]) * (1.f / 16.f);
    }
  }
  __syncthreads();
  {
    float v[16];
#pragma unroll
    for (int i = 0; i < 16; ++i) {
      const int dir = i >> 3, d = wave * 8 + (i & 7);
      const int s = dir ? 63 - lane : lane;
      v[i] = cum2[dir * 2048 + s * 32 + d];
    }
#pragma unroll
    for (int i = 0; i < 16; ++i) v[i] = wave_incl_scan(v[i]);
#pragma unroll
    for (int i = 0; i < 16; ++i) {
      const int dir = i >> 3, d = wave * 8 + (i & 7);
      const int s = dir ? 63 - lane : lane;
      cum2[dir * 2048 + s * 32 + d] = v[i];
    }
  }
  __syncthreads();
}

DI void gla_stage_vt(const Params& p, int b, int h, int c, u16* Vt, int tid) {
#pragma unroll
  for (int i = 0; i < 2; ++i) {
    const int cc = tid + 256 * i, s = cc >> 3, ch = cc & 7;
    const uint4 vv = *(const uint4*)(p.z + (size_t)gla_row(b, c, s) * ZW + ZV + h * 64 + ch * 8);
    u16* vt = Vt + (ch * 8) * 72 + s;
    vt[0 * 72] = (u16)(vv.x & 0xffff); vt[1 * 72] = (u16)(vv.x >> 16);
    vt[2 * 72] = (u16)(vv.y & 0xffff); vt[3 * 72] = (u16)(vv.y >> 16);
    vt[4 * 72] = (u16)(vv.z & 0xffff); vt[5 * 72] = (u16)(vv.z >> 16);
    vt[6 * 72] = (u16)(vv.w & 0xffff); vt[7 * 72] = (u16)(vv.w >> 16);
  }
}

constexpr int GLA_SUB_BYTES = 56320;

DI void gla_a_item(const Params& p, int layer, int pi, char* smem) {
  const int tid0 = opaque_tid();
  const int tid = tid0 & 255, sub = tid0 >> 8;
  const int lane = tid & 63, wave = tid >> 6, l15 = lane & 15, lq = lane >> 4;
  const int item = 2 * pi + sub;
  char* base = smem + sub * GLA_SUB_BYTES;
  float* cum2 = (float*)base;
  u16* ktT = (u16*)(base + 16384);
  u16* Vt = (u16*)(base + 16384 + 9216);
  const int c = item % NSLOT, h = (item / NSLOT) & 3, b = item / (NSLOT * 4);
  const int s = tid >> 2, d0 = (tid & 3) * 8;
  const uint4 kraw = *(const uint4*)(p.z + (size_t)gla_row(b, c, s) * ZW + ZK + h * 32 + d0);
  gla_stage_vt(p, b, h, c, Vt, tid);
  gla_cum2(p, layer, b, h, c, cum2, tid);
  {
    float* cg = p.cumbuf + (size_t)item * 4096;
#pragma unroll
    for (int i = 0; i < 4; ++i) *(float4*)(cg + (i * 256 + tid) * 4) = *(const float4*)(cum2 + (i * 256 + tid) * 4);
  }
  const size_t sidx0 = ((size_t)((b * 4 + h) * 2 + 0) * NSLOT + gla_slot(c, 0));
  const size_t sidx1 = ((size_t)((b * 4 + h) * 2 + 1) * NSLOT + gla_slot(c, 1));
  {
    float kf[8];
    unpack8(kraw, kf);
#pragma unroll
    for (int e = 0; e < 8; ++e) {
      ktT[(d0 + e) * 72 + s] = f2bf(kf[e] * __expf(cum2[63 * 32 + d0 + e] - cum2[s * 32 + d0 + e]));
      ktT[2304 + (d0 + e) * 72 + s] = f2bf(kf[e] * __expf(cum2[2048 + d0 + e] - cum2[2048 + s * 32 + d0 + e]));
    }
    if (tid < 32) p.Dd[sidx0 * 32 + tid] = __expf(cum2[63 * 32 + tid]);
    else if (tid < 64) p.Dd[sidx1 * 32 + tid - 32] = __expf(cum2[2048 + tid - 32]);
  }
  __syncthreads();
#pragma unroll
  for (int dir = 0; dir < 2; ++dir) {
    float* Lp = p.L + (dir ? sidx1 : sidx0) * 2048;
#pragma unroll
    for (int dt = 0; dt < 2; ++dt) {
      f32x4 acc = f32x4{0.f, 0.f, 0.f, 0.f};
#pragma unroll
      for (int ks = 0; ks < 2; ++ks) {
        const bf16x8 a = *(const bf16x8*)(ktT + dir * 2304 + (dt * 16 + l15) * 72 + ks * 32 + lq * 8);
        const bf16x8 bb = *(const bf16x8*)(Vt + (wave * 16 + l15) * 72 + ks * 32 + lq * 8);
        acc = MFMA16(a, bb, acc);
      }
#pragma unroll
      for (int j = 0; j < 4; ++j) Lp[(dt * 16 + lq * 4 + j) * 64 + wave * 16 + l15] = acc[j];
    }
  }
  __syncthreads();
}

DI void phase_gla_b(const Params& p) {
  const int total = NB * 4 * 2 * 2048;
  for (int idx = blockIdx.x * NT + threadIdx.x; idx < total; idx += gridDim.x * NT) {
    const int chain = idx >> 11, de = idx & 2047, d = de >> 6;
    float* Lp = p.L + (size_t)chain * NSLOT * 2048 + de;
    const float* Dp = p.Dd + (size_t)chain * NSLOT * 32 + d;
    float loc[NSLOT], dec[NSLOT];
#pragma unroll
    for (int sl = 0; sl < NSLOT; ++sl) { loc[sl] = Lp[(size_t)sl * 2048]; dec[sl] = Dp[sl * 32]; }
    float S = 0.f;
#pragma unroll
    for (int sl = 0; sl < NSLOT; ++sl) {
      Lp[(size_t)sl * 2048] = S;
      S = dec[sl] * S + loc[sl];
    }
  }
}

DI void gla_c_item(const Params& p, int layer, int pi, char* smem) {
  const int tid0 = opaque_tid();
  const int tid = tid0 & 255, sub = tid0 >> 8;
  const int lane = tid & 63, wave = tid >> 6, l15 = lane & 15, lq = lane >> 4;
  const int item = 2 * pi + sub;
  char* base = smem + sub * GLA_SUB_BYTES;
  float* cum2 = (float*)base;
  u16* qt = (u16*)(base + 16384);
  u16* kh = (u16*)(base + 16384 + 10240);
  u16* St = (u16*)(base + 16384 + 20480);
  u16* Vt = (u16*)(base + 16384 + 30720);
  const int c = item % NSLOT, h = (item / NSLOT) & 3, b = item / (NSLOT * 4);
  const int s = tid >> 2, d0 = (tid & 3) * 8;
  const u16* zr = p.z + (size_t)gla_row(b, c, s) * ZW + h * 32 + d0;
  const uint4 qraw = *(const uint4*)(zr + ZQ), kraw = *(const uint4*)(zr + ZK);
  const int sd = tid >> 3, se0 = (tid & 7) * 8;
  const float* Lp0 = p.L + ((size_t)((b * 4 + h) * 2 + 0) * NSLOT + gla_slot(c, 0)) * 2048 + sd * 64 + se0;
  const float* Lp1 = p.L + ((size_t)((b * 4 + h) * 2 + 1) * NSLOT + gla_slot(c, 1)) * 2048 + sd * 64 + se0;
  const float4 sf0 = *(const float4*)Lp0, sf1 = *(const float4*)(Lp0 + 4), sb0 = *(const float4*)Lp1, sb1 = *(const float4*)(Lp1 + 4);
  const float* cg = p.cumbuf + (size_t)item * 4096 + s * 32 + d0;
  float cvv[2][8];
  *(float4*)&cvv[0][0] = *(const float4*)cg;          *(float4*)&cvv[0][4] = *(const float4*)(cg + 4);
  *(float4*)&cvv[1][0] = *(const float4*)(cg + 2048); *(float4*)&cvv[1][4] = *(const float4*)(cg + 2052);
  gla_stage_vt(p, b, h, c, Vt, tid);
  {
    float qf[8], kf[8];
    unpack8(qraw, qf);
    unpack8(kraw, kf);
#pragma unroll
    for (int dir = 0; dir < 2; ++dir) {
      float qo[8], ko[8];
#pragma unroll
      for (int e = 0; e < 8; ++e) {
        const float cv = cvv[dir][e];
        qo[e] = qf[e] * 0.17677669529663687f * __expf(cv);
        ko[e] = kf[e] * __expf(-cv);
      }
      *(uint4*)(qt + dir * 2560 + s * 40 + d0) = make_uint4(pack2(qo[0], qo[1]), pack2(qo[2], qo[3]), pack2(qo[4], qo[5]), pack2(qo[6], qo[7]));
      *(uint4*)(kh + dir * 2560 + s * 40 + d0) = make_uint4(pack2(ko[0], ko[1]), pack2(ko[2], ko[3]), pack2(ko[4], ko[5]), pack2(ko[6], ko[7]));
    }
    St[(se0 + 0) * 40 + sd] = f2bf(sf0.x); St[(se0 + 1) * 40 + sd] = f2bf(sf0.y); St[(se0 + 2) * 40 + sd] = f2bf(sf0.z); St[(se0 + 3) * 40 + sd] = f2bf(sf0.w);
    St[(se0 + 4) * 40 + sd] = f2bf(sf1.x); St[(se0 + 5) * 40 + sd] = f2bf(sf1.y); St[(se0 + 6) * 40 + sd] = f2bf(sf1.z); St[(se0 + 7) * 40 + sd] = f2bf(sf1.w);
    u16* St1 = St + 2560;
    St1[(se0 + 0) * 40 + sd] = f2bf(sb0.x); St1[(se0 + 1) * 40 + sd] = f2bf(sb0.y); St1[(se0 + 2) * 40 + sd] = f2bf(sb0.z); St1[(se0 + 3) * 40 + sd] = f2bf(sb0.w);
    St1[(se0 + 4) * 40 + sd] = f2bf(sb1.x); St1[(se0 + 5) * 40 + sd] = f2bf(sb1.y); St1[(se0 + 6) * 40 + sd] = f2bf(sb1.z); St1[(se0 + 7) * 40 + sd] = f2bf(sb1.w);
  }
  __syncthreads();
  f32x4 oT[4], aT[4];
#pragma unroll
  for (int i = 0; i < 4; ++i) { oT[i] = f32x4{0.f, 0.f, 0.f, 0.f}; aT[i] = f32x4{0.f, 0.f, 0.f, 0.f}; }
  const int tq = 16 * wave + l15;
#pragma unroll
  for (int dir = 0; dir < 2; ++dir) {
    const bf16x8 qb = *(const bf16x8*)(qt + dir * 2560 + tq * 40 + lq * 8);
#pragma unroll
    for (int st = 0; st < 4; ++st) {
      const bf16x8 ka = *(const bf16x8*)(kh + dir * 2560 + (st * 16 + l15) * 40 + lq * 8);
      f32x4 sv = f32x4{0.f, 0.f, 0.f, 0.f};
      sv = MFMA16(ka, qb, sv);
#pragma unroll
      for (int j = 0; j < 4; ++j) {
        const int si = st * 16 + lq * 4 + j;
        const bool valid = dir ? (si >= tq) : (si <= tq);
        aT[st][j] += valid ? sv[j] : 0.f;
      }
    }
#pragma unroll
    for (int et = 0; et < 4; ++et) {
      const bf16x8 sa = *(const bf16x8*)(St + dir * 2560 + (et * 16 + l15) * 40 + lq * 8);
      oT[et] = MFMA16(sa, qb, oT[et]);
    }
  }
#pragma unroll
  for (int kk = 0; kk < 2; ++kk) {
    const uint4 t4 = make_uint4(pack2(aT[2 * kk][0], aT[2 * kk][1]), pack2(aT[2 * kk][2], aT[2 * kk][3]),
                                pack2(aT[2 * kk + 1][0], aT[2 * kk + 1][1]), pack2(aT[2 * kk + 1][2], aT[2 * kk + 1][3]));
    const bf16x8 pb = __builtin_bit_cast(bf16x8, t4);
#pragma unroll
    for (int et = 0; et < 4; ++et) {
      const u16* vrow = Vt + (et * 16 + l15) * 72 + lq * 4 + (2 * kk) * 16;
      const uint2 lo = *(const uint2*)vrow;
      const uint2 hi = *(const uint2*)(vrow + 16);
      const bf16x8 va = __builtin_bit_cast(bf16x8, make_uint4(lo.x, lo.y, hi.x, hi.y));
      oT[et] = MFMA16(va, pb, oT[et]);
    }
  }
  float ss = 0.f;
#pragma unroll
  for (int et = 0; et < 4; ++et)
#pragma unroll
    for (int j = 0; j < 4; ++j) ss += oT[et][j] * oT[et][j];
  ss += __shfl_xor(ss, 16);
  ss += __shfl_xor(ss, 32);
  const float rstd = rsqrtf(ss * (1.f / 64.f) + 1e-6f);
  const int row = gla_row(b, c, tq);
#pragma unroll
  for (int et = 0; et < 4; ++et) {
    const int e0 = et * 16 + lq * 4;
    const uint2 ogv = *(const uint2*)(p.z + (size_t)row * ZW + ZOG + h * 64 + e0);
    const float og0 = __uint_as_float(ogv.x << 16), og1 = __uint_as_float(ogv.x & 0xffff0000u);
    const float og2 = __uint_as_float(ogv.y << 16), og3 = __uint_as_float(ogv.y & 0xffff0000u);
    const float4 gn = *(const float4*)(p.gla_norm + layer * 64 + e0);
    uint2 o;
    o.x = pack2(oT[et][0] * rstd * gn.x * silu_f(og0), oT[et][1] * rstd * gn.y * silu_f(og1));
    o.y = pack2(oT[et][2] * rstd * gn.z * silu_f(og2), oT[et][3] * rstd * gn.w * silu_f(og3));
    *(uint2*)(p.cat + (size_t)row * DM + h * 64 + e0) = o;
  }
  __syncthreads();
}

DI void swa_norm_rows(const Params& p, int layer, int Mrows) {
  const int tid = threadIdx.x, lane = tid & 63, wave = tid >> 6;
  const int sub = lane >> 4, l16 = lane & 15;
  const float* g = p.swa_out_g + layer * 512 + l16 * 32;
  for (int row = (blockIdx.x * 8 + wave) * 4 + sub; row < Mrows; row += gridDim.x * 32) {
    u16* cp = p.cat + (size_t)row * DM + 512 + l16 * 32;
    uint4 raw[4];
#pragma unroll
    for (int i = 0; i < 4; ++i) raw[i] = *(const uint4*)(cp + i * 8);
    float f[32];
    float ss = 0.f;
#pragma unroll
    for (int i = 0; i < 4; ++i) {
      unpack8(raw[i], f + i * 8);
#pragma unroll
      for (int e = 0; e < 8; ++e) ss += f[i * 8 + e] * f[i * 8 + e];
    }
    ss += __shfl_xor(ss, 1); ss += __shfl_xor(ss, 2); ss += __shfl_xor(ss, 4); ss += __shfl_xor(ss, 8);
    const float rstd = rsqrtf(ss * (1.f / 512.f) + 1e-6f);
#pragma unroll
    for (int i = 0; i < 4; ++i) {
      const float4 g0 = *(const float4*)(g + i * 8), g1 = *(const float4*)(g + i * 8 + 4);
      uint4 o;
      o.x = pack2(f[i * 8 + 0] * rstd * g0.x, f[i * 8 + 1] * rstd * g0.y); o.y = pack2(f[i * 8 + 2] * rstd * g0.z, f[i * 8 + 3] * rstd * g0.w);
      o.z = pack2(f[i * 8 + 4] * rstd * g1.x, f[i * 8 + 5] * rstd * g1.y); o.w = pack2(f[i * 8 + 6] * rstd * g1.z, f[i * 8 + 7] * rstd * g1.w);
      *(uint4*)(cp + i * 8) = o;
    }
  }
}

DI void phase_mix_a(const Params& p, int layer, char* smem) {
  const bool need_ctx = layer == 0;
  const int n_swa = 1024, n_swac = need_ctx ? 128 : 0, n_gm = need_ctx ? 288 : 256, n_gla = NB * 4 * NSLOT / 2;
  const int total = n_swa + n_swac + n_gm + n_gla;
  unsigned* ctr = p.bar + XB_QCTR(layer);
  volatile unsigned* nxt = (volatile unsigned*)(smem + SMEM_BYTES) + 3;
  int item = blockIdx.x;
  while (item < total) {
    unsigned got = 0;
    if (threadIdx.x == 0) got = __hip_atomic_fetch_add(ctr, 1u, __ATOMIC_RELAXED, __HIP_MEMORY_SCOPE_AGENT);
    int it = item;
    if (it < n_swa) swa_item(p, layer, it, false, smem);
    else if ((it -= n_swa) < n_swac) swa_item(p, layer, it, true, smem);
    else if ((it -= n_swac) < n_gm) gmlp_item(p, layer, it, smem);
    else gla_a_item(p, layer, it - n_gm, smem);
    if (threadIdx.x == 0) *nxt = got + gridDim.x;
    __syncthreads();
    item = (int)*nxt;
    __syncthreads();
  }
}

DI void phase_mix_c(const Params& p, int layer, char* smem) {
  const bool need_ctx = layer == 0;
  const int n_gla = NB * 4 * NSLOT / 2;
  for (int item = blockIdx.x; item < n_gla; item += gridDim.x) {
    const int c = (2 * item) % NSLOT;
    if (!need_ctx && c < 4) continue;
    gla_c_item(p, layer, item, smem);
  }
  swa_norm_rows(p, layer, need_ctx ? M_ALL : M_LAT);
}


#define XB_TMO      128
#define XB_XCNT(j)  (256  + 64 * (j))
#define XB_XSUB(j)  (1280 + 64 * (j))
#define XB_XGEN(j)  (2304 + 64 * (j))
#define XB_TOP      3328
#define XB_TOPGEN   3392
#define XB_SPIN_CAP (1u << 22)
#define LAS __attribute__((address_space(3)))
DI unsigned xb_ld(unsigned* p) { return __hip_atomic_load(p, __ATOMIC_RELAXED, __HIP_MEMORY_SCOPE_AGENT); }
DI unsigned xb_add(unsigned* p, unsigned v) { return __hip_atomic_fetch_add(p, v, __ATOMIC_RELAXED, __HIP_MEMORY_SCOPE_AGENT); }
DI unsigned xb_xcc_id() { return (unsigned)__builtin_amdgcn_s_getreg((3 << 11) | 20) & 0xFu; }
#define XB_SPIN(cond, bar) do { unsigned _sp = 0; while (cond) { __builtin_amdgcn_s_sleep(1); \
    if ((++_sp & 255u) == 0u) { if (xb_ld(&(bar)[XB_TMO])) break; if (_sp > XB_SPIN_CAP) { atomicAdd(&(bar)[XB_TMO], 1u); break; } } } } while (0)
struct XcdBarrier { unsigned* bar; unsigned x; volatile LAS unsigned* st; };
DI XcdBarrier xcd_barrier_post(unsigned* bar, volatile LAS unsigned* st) {
  XcdBarrier b; b.bar = bar; b.x = xb_xcc_id(); b.st = st;
  if (threadIdx.x == 0) (void)xb_add(&bar[XB_XCNT(b.x)], 1u);
  return b;
}
DI void xcd_barrier_complete(unsigned* bar, unsigned x, unsigned& nloc, unsigned& nx) {
  const unsigned G = gridDim.x * gridDim.y * gridDim.z;
  unsigned sum, cnt, mine, sp = 0u;
  for (;;) {
    sum = 0u; cnt = 0u; mine = 0u;
#pragma unroll
    for (unsigned j = 0; j < 16; ++j) { const unsigned c = xb_ld(&bar[XB_XCNT(j)]); sum += c; cnt += (c > 0u) ? 1u : 0u; mine = (j == x) ? c : mine; }
    if (sum == G) break;
    __builtin_amdgcn_s_sleep(1);
    if ((++sp & 255u) == 0u) { if (xb_ld(&bar[XB_TMO])) break; if (sp > XB_SPIN_CAP) { atomicAdd(&bar[XB_TMO], 1u); break; } }
  }
  nloc = mine > 0u ? mine : 1u; nx = cnt > 0u ? cnt : 1u;
}
DI void xcd_barrier(const XcdBarrier& b) {
  asm volatile("s_waitcnt vmcnt(0)" ::: "memory");
  __syncthreads();
  if (threadIdx.x == 0) {
    unsigned* bar = b.bar;
    __builtin_amdgcn_s_waitcnt(0);
    unsigned nloc = b.st[0], nx = b.st[1];
    if (nloc == 0u) { xcd_barrier_complete(bar, b.x, nloc, nx); b.st[0] = nloc; b.st[1] = nx; }
    const unsigned old = xb_add(&bar[XB_XSUB(b.x)], 1u);
    const unsigned gen = old / nloc;
    if (old + 1u == (gen + 1u) * nloc) {
      __builtin_amdgcn_fence(__ATOMIC_RELEASE, "agent");
      asm volatile("s_waitcnt vmcnt(0)" ::: "memory");
      const unsigned og = xb_add(&bar[XB_TOP], 1u);
      const unsigned tg = og / nx;
      if (og + 1u == (tg + 1u) * nx) xb_add(&bar[XB_TOPGEN], 1u);
      else XB_SPIN(xb_ld(&bar[XB_TOPGEN]) == tg, bar);
      __builtin_amdgcn_fence(__ATOMIC_ACQUIRE, "agent");
      xb_add(&bar[XB_XGEN(b.x)], 1u);
      asm volatile("s_waitcnt vmcnt(0)" ::: "memory");
    } else {
      XB_SPIN(xb_ld(&bar[XB_XGEN(b.x)]) == gen, bar);
      __builtin_amdgcn_fence(__ATOMIC_ACQUIRE, "agent");
      asm volatile("s_waitcnt vmcnt(0)" ::: "memory");
    }
  }
  __syncthreads();
}

constexpr int N_STEPS = 2 + 2 * 9;

DI void run_step(const Params& p, int step, char* smem) {
  if (step == 0) { phase_prep(p, smem, 0); return; }
  if (step == 1) { phase_rows(p, 0, M_ALL, 0, 0, 0, nullptr, true, 0, 0, p.n1_pre); return; }
  const int l = (step - 2) / 9, ph = (step - 2) % 9;
  const int Mo = l == 0 ? M_ALL : M_LAT;
  switch (ph) {
    case 0: if (l == 0) phase_gemm<2>(p.h, p.WinT + (size_t)l * ZW * DM, M_ALL, ZW, DM, p.z, ZW, smem, p.rope, p.vT);
            else phase_gemm<3>(p.h, p.WinT + (size_t)l * ZW * DM, M_ALL, ZW, DM, p.z, ZW, smem, p.rope, p.vT);
            break;
    case 1: phase_mix_a(p, l, smem); break;
    case 2: phase_gla_b(p); break;
    case 3: phase_mix_c(p, l, smem); break;
    case 4: phase_gemm<0>(p.cat, p.WoutT + (size_t)l * DM * DM, Mo, DM, DM, p.y, DM, smem); break;
    case 5: phase_rows(p, 1, Mo, l == 0 ? 1 : 2, l, 2, p.n1_post + l * DM, true, l, 3, p.n2_pre + l * DM); break;
    case 6: phase_gemm<1>(p.h, p.WguT + (size_t)l * 2 * DFF * DM, Mo, 2 * DFF, DM, p.act, DFF, smem); break;
    case 7: phase_gemm<0>(p.act, p.WdT + (size_t)l * DM * DFF, Mo, DM, DFF, p.y, DM, smem);
            if (l == 0) phase_prep(p, smem, 1);
            break;
    case 8: phase_rows(p, 1, Mo, l == 0 ? 2 : 3, l, 5, p.n2_post + l * DM, l == 0, l + 1, 0, p.n1_pre + (l + 1 < 2 ? l + 1 : 1) * DM); break;
  }
}

template <int S>
DI void run_one(const Params& p, int step_begin, int step_end, int use_cg, const XcdBarrier& xb, char* smem) {
  if (step_begin <= S && S < step_end) {
    run_step(p, S, smem);
    if (S + 1 < step_end) {
      if (use_cg) cg::this_grid().sync();
      else xcd_barrier(xb);
    }
  }
}

__global__ void __launch_bounds__(NT, 2) fwd_kernel(Params p_unused, int step_begin, int step_end, int use_cg) {
  __shared__ __attribute__((aligned(16))) char smem[SMEM_BYTES + 16];
  uint4& xb_words = *(uint4*)(smem + SMEM_BYTES);
  const Params& p = *(const Params*)__builtin_amdgcn_kernarg_segment_ptr();
  if (threadIdx.x == 0) xb_words = make_uint4(0u, 0u, 0u, 0u);
  __syncthreads();
  XcdBarrier xb = xcd_barrier_post(p.bar, (volatile LAS unsigned*)&xb_words);
  run_one<0>(p, step_begin, step_end, use_cg, xb, smem);  run_one<1>(p, step_begin, step_end, use_cg, xb, smem);
  run_one<2>(p, step_begin, step_end, use_cg, xb, smem);  run_one<3>(p, step_begin, step_end, use_cg, xb, smem);
  run_one<4>(p, step_begin, step_end, use_cg, xb, smem);  run_one<5>(p, step_begin, step_end, use_cg, xb, smem);
  run_one<6>(p, step_begin, step_end, use_cg, xb, smem);  run_one<7>(p, step_begin, step_end, use_cg, xb, smem);
  run_one<8>(p, step_begin, step_end, use_cg, xb, smem);  run_one<9>(p, step_begin, step_end, use_cg, xb, smem);
  run_one<10>(p, step_begin, step_end, use_cg, xb, smem); run_one<11>(p, step_begin, step_end, use_cg, xb, smem);
  run_one<12>(p, step_begin, step_end, use_cg, xb, smem); run_one<13>(p, step_begin, step_end, use_cg, xb, smem);
  run_one<14>(p, step_begin, step_end, use_cg, xb, smem); run_one<15>(p, step_begin, step_end, use_cg, xb, smem);
  run_one<16>(p, step_begin, step_end, use_cg, xb, smem); run_one<17>(p, step_begin, step_end, use_cg, xb, smem);
  run_one<18>(p, step_begin, step_end, use_cg, xb, smem); run_one<19>(p, step_begin, step_end, use_cg, xb, smem);
}

extern "C" void kernel_launch(void* const* d_in, const int* in_sizes, int n_in, void* d_out, int out_size, void* d_ws,
                              size_t ws_size, hipStream_t stream) {
  static int grid_blocks = 0;
  if (!grid_blocks) {
    int dev = 0, cus = 0, per_cu = 0;
    hipGetDevice(&dev);
    hipDeviceGetAttribute(&cus, hipDeviceAttributeMultiprocessorCount, dev);
    hipOccupancyMaxActiveBlocksPerMultiprocessor(&per_cu, fwd_kernel, NT, 0);
    if (per_cu < 1) per_cu = 1;
    if (per_cu > 1) per_cu = 1;
    grid_blocks = cus * per_cu;
  }
  Params p{};
  const float** fp = (const float**)&p;
  for (int i = 0; i < 24; ++i) fp[i] = (const float*)d_in[i];
  p.out = (float*)d_out;
  char* w = (char*)d_ws;
  size_t off = 0;
  auto take = [&](size_t bytes) { char* r = w + off; off += (bytes + 255) & ~(size_t)255; return r; };
  p.WinT = (u16*)take((size_t)2 * ZW * DM * 2);
  p.WoutT = (u16*)take((size_t)2 * DM * DM * 2);
  p.WguT = (u16*)take((size_t)2 * 2 * DFF * DM * 2);
  p.WdT = (u16*)take((size_t)2 * DM * DFF * 2);
  p.mod = (float*)take((size_t)2 * 17 * 6144 * 4);
  p.rope = (float*)take((size_t)TL * 32 * 2 * 4);
  p.h = (u16*)take((size_t)M_ALL * DM * 2);
  p.z = (u16*)take((size_t)M_ALL * ZW * 2);
  p.cat = (u16*)take((size_t)M_ALL * DM * 2);
  p.act = p.z;
  p.y = p.h;
  p.xr = (u16*)take((size_t)M_LAT * DM * 2);
  p.xc = (u16*)take((size_t)M_CTX * DM * 2);
  p.L = (float*)take((size_t)NB * 4 * 2 * NSLOT * 2048 * 4);
  p.Dd = (float*)take((size_t)NB * 4 * 2 * NSLOT * 32 * 4);
  p.bar = (unsigned*)take((size_t)XCD_BAR_WORDS * 4);
  p.vT = (u16*)take((size_t)288 * 2 * 64 * 128 * 2);
  p.cumbuf = (float*)p.h;
  if (off > ws_size) { fprintf(stderr, "workspace too small: need %zu have %zu\n", off, ws_size); return; }
#if MK_ONE_LAUNCH
  int sb = 0, se = N_STEPS, use_cg = 0;
  void* args[] = {&p, &sb, &se, &use_cg};
  (void)hipMemsetAsync(p.bar, 0, (size_t)XCD_BAR_WORDS * 4, stream);
  hipError_t e = hipLaunchCooperativeKernel((void*)fwd_kernel, dim3(grid_blocks), dim3(NT), args, 0, stream);
  if (e != hipSuccess) fprintf(stderr, "cooperative launch failed: %s (grid %d)\n", hipGetErrorString(e), grid_blocks);
#else
  for (int s = 0; s < N_STEPS; ++s) fwd_kernel<<<grid_blocks, NT, 0, stream>>>(p, s, s + 1, 0);
#endif
}
```
